# Optimizing an MI355X kernel written in HIP

```python
import jax, jax.numpy as jnp
from jax import lax
import numpy as np

D_MODEL = 1024
BATCH = 8
SEQ = 4096
DEPTH = 2

HEAD_DIM = 64
C_ATT = D_MODEL // 4
C_RWKV = (D_MODEL - C_ATT) // 2
C_MLSTM = D_MODEL - C_ATT - C_RWKV
D_MIX = C_ATT + C_RWKV + C_MLSTM
H_ATT = C_ATT // HEAD_DIM
H_RWKV = C_RWKV // HEAD_DIM
H_MLSTM = C_MLSTM // HEAD_DIM
CMP_BLOCK = 32
CMP_STRIDE = 16
SLC_BLOCK = 64
N_SELECT = 16
WINDOW = 512
Q_BLOCK = 128
NEG = -1e30
FORCE = 1e9
RANK_W = 64
RANK_A = 64
RANK_G = 128
RWKV_GN_EPS = 64e-5
MLSTM_CHUNK = 64
CONV_WIDTH = 4
D_FF = -(-8 * D_MODEL // (3 * 256)) * 256
NORM_EPS = 1e-6
NSA_SIZES = (C_ATT, HEAD_DIM, HEAD_DIM, HEAD_DIM, HEAD_DIM, HEAD_DIM, HEAD_DIM, 3 * H_ATT)
RWKV_SIZES = (C_RWKV, C_RWKV, C_RWKV, RANK_W, RANK_A, RANK_G)
MLSTM_SIZES = (2 * C_MLSTM, C_MLSTM, C_MLSTM, H_MLSTM, H_MLSTM)
NSA_IN = sum(NSA_SIZES)
RWKV_IN = sum(RWKV_SIZES)
MLSTM_IN = sum(MLSTM_SIZES)
D_IN = NSA_IN + RWKV_IN + MLSTM_IN

kernel_name = "hybrid_nsa_rwkv7_mlstm_block"


def split_cols(t, sizes):
    points = np.cumsum(np.array(sizes))[:-1].tolist()
    return jnp.split(t, points, axis=-1)


def rms_norm(x, g, eps=NORM_EPS):
    x32 = x.astype(jnp.float32)
    y = x32 * lax.rsqrt(jnp.mean(x32 * x32, axis=-1, keepdims=True) + eps)
    return (y * g.astype(jnp.float32)).astype(x.dtype)


def shift_right(t):
    return jnp.pad(t, ((0, 0), (1, 0), (0, 0)))[:, :-1]


def causal_dwconv(t, w, b):
    k = w.shape[0]
    out = lax.conv_general_dilated(t, w[:, None, :], window_strides=(1,), padding=[(k - 1, 0)],
                                   dimension_numbers=("NWC", "WIO", "NWC"),
                                   feature_group_count=t.shape[-1])
    return out + b


def nsa_mixer(q, kc, vc, ks, vs, kw, vw, gts, gate_b, pe_k, pe_v, ck_w1, ck_w2, cv_w1, cv_w2):
    B, S, _ = q.shape
    f32 = jnp.float32
    q = q.reshape(B, S, H_ATT, HEAD_DIM)
    scale = HEAD_DIM ** -0.5
    pos = jnp.arange(S)
    n_cmp = (S - CMP_BLOCK) // CMP_STRIDE + 1
    cmp_start = jnp.arange(n_cmp) * CMP_STRIDE
    blk_idx = cmp_start[:, None] + jnp.arange(CMP_BLOCK)[None, :]

    def compress(t, pe, w1, w2):
        tb = t[:, blk_idx] + pe
        return jax.nn.gelu(tb.reshape(B, n_cmp, CMP_BLOCK * HEAD_DIM) @ w1) @ w2

    k_cmp = compress(kc, pe_k, ck_w1, ck_w2)
    v_cmp = compress(vc, pe_v, cv_w1, cv_w2)
    cmp_mask = (cmp_start + CMP_BLOCK - 1)[None, :] <= pos[:, None]
    s_cmp = jnp.einsum('bshd,bnd->bhsn', q, k_cmp).astype(f32) * scale
    p_cmp = jax.nn.softmax(jnp.where(cmp_mask, s_cmp, NEG), axis=-1) * cmp_mask
    o_cmp = jnp.einsum('bhsn,bnd->bshd', p_cmp.astype(q.dtype), v_cmp)
    n_slc = S // SLC_BLOCK
    n_sel = min(N_SELECT, n_slc)
    slc_start = jnp.arange(n_slc) * SLC_BLOCK
    overlap = ((cmp_start[:, None] < slc_start[None, :] + SLC_BLOCK)
               & (cmp_start[:, None] + CMP_BLOCK > slc_start[None, :])).astype(f32)
    imp = jnp.einsum('bhsn,nj->bsj', p_cmp, overlap)
    cur = pos // SLC_BLOCK
    j = jnp.arange(n_slc)
    forced = (j[None, :] == 0) | (j[None, :] == cur[:, None]) | (j[None, :] == cur[:, None] - 1)
    valid = j[None, :] <= cur[:, None]
    score = jnp.where(forced, FORCE, jnp.where(valid, imp, NEG))
    _, sel_idx = lax.top_k(score, n_sel)
    ks_blk = ks.reshape(B, n_slc, SLC_BLOCK, HEAD_DIM)
    vs_blk = vs.reshape(B, n_slc, SLC_BLOCK, HEAD_DIM)
    kw_pad = jnp.pad(kw, ((0, 0), (WINDOW, 0), (0, 0)))
    vw_pad = jnp.pad(vw, ((0, 0), (WINDOW, 0), (0, 0)))
    span = WINDOW + Q_BLOCK
    b_ix = jnp.arange(B)[:, None, None]

    def block(i):
        q0 = i * Q_BLOCK
        qb = lax.dynamic_slice_in_dim(q, q0, Q_BLOCK, axis=1)
        idx = lax.dynamic_slice_in_dim(sel_idx, q0, Q_BLOCK, axis=1)
        qpos = q0 + jnp.arange(Q_BLOCK)
        kg = ks_blk[b_ix, idx]
        vg = vs_blk[b_ix, idx]
        kpos = idx[..., None] * SLC_BLOCK + jnp.arange(SLC_BLOCK)
        m_s = kpos <= qpos[None, :, None, None]
        s_s = jnp.einsum('bqhd,bqnkd->bhqnk', qb, kg).astype(f32) * scale
        s_s = jnp.where(m_s[:, None], s_s, NEG).reshape(B, H_ATT, Q_BLOCK, n_sel * SLC_BLOCK)
        p_s = jax.nn.softmax(s_s, axis=-1).reshape(B, H_ATT, Q_BLOCK, n_sel, SLC_BLOCK)
        o_s = jnp.einsum('bhqnk,bqnkd->bqhd', p_s.astype(qb.dtype), vg)
        kwb = lax.dynamic_slice_in_dim(kw_pad, q0, span, axis=1)
        vwb = lax.dynamic_slice_in_dim(vw_pad, q0, span, axis=1)
        wpos = q0 - WINDOW + jnp.arange(span)
        m_w = ((wpos[None, :] <= qpos[:, None]) & (wpos[None, :] > qpos[:, None] - WINDOW)
               & (wpos[None, :] >= 0))
        s_w = jnp.einsum('bqhd,bkd->bhqk', qb, kwb).astype(f32) * scale
        p_w = jax.nn.softmax(jnp.where(m_w, s_w, NEG), axis=-1)
        o_w = jnp.einsum('bhqk,bkd->bqhd', p_w.astype(qb.dtype), vwb)
        return o_s, o_w

    o_s, o_w = lax.map(block, jnp.arange(S // Q_BLOCK))
    o_s = o_s.transpose(1, 0, 2, 3, 4).reshape(B, S, H_ATT, HEAD_DIM)
    o_w = o_w.transpose(1, 0, 2, 3, 4).reshape(B, S, H_ATT, HEAD_DIM)
    g = jax.nn.sigmoid(gts + gate_b).reshape(B, S, 3, H_ATT)[..., None]
    o = g[:, :, 0] * o_cmp + g[:, :, 1] * o_s + g[:, :, 2] * o_w
    return o.reshape(B, S, C_ATT)


def rwkv7_mixer(r, k, v, xw, xa, xg, w0, w2, a0, a2, g2, k_k, k_a, r_k, ln_w, ln_b):
    B, S, _ = r.shape
    H, N = H_RWKV, HEAD_DIM
    f32 = jnp.float32
    w = -jax.nn.softplus(-(w0 + jnp.tanh(xw) @ w2)) - 0.5
    decay = jnp.exp(-jnp.exp(w.astype(f32)))
    a = jax.nn.sigmoid(a0 + xa @ a2)
    g = jax.nn.sigmoid(xg) @ g2
    heads = lambda t: t.reshape(B, S, H, N).astype(f32)
    kk = heads(k * k_k)
    kk = kk / jnp.maximum(jnp.sqrt(jnp.sum(kk * kk, axis=-1, keepdims=True)), 1e-12)
    k = k * (1 + (a - 1) * k_a)
    rh, kh, vh, ah, wh = heads(r), heads(k), heads(v), heads(a), heads(decay)

    def step(state, inp):
        r_t, w_t, k_t, v_t, kk_t, a_t = inp
        sa = jnp.einsum('bhij,bhj->bhi', state, -kk_t)
        state = (state * w_t[:, :, None, :] + sa[..., None] * (kk_t * a_t)[:, :, None, :]
                 + v_t[..., None] * k_t[:, :, None, :])
        return state, jnp.einsum('bhij,bhj->bhi', state, r_t)

    xs = tuple(t.transpose(1, 0, 2, 3) for t in (rh, wh, kh, vh, kk, ah))
    _, y = lax.scan(step, jnp.zeros((B, H, N, N), f32), xs)
    y = y.transpose(1, 0, 2, 3)
    mu = jnp.mean(y, axis=-1, keepdims=True)
    var = jnp.mean((y - mu) ** 2, axis=-1, keepdims=True)
    y = ((y - mu) * lax.rsqrt(var + RWKV_GN_EPS)).reshape(B, S, C_RWKV) * ln_w + ln_b
    bonus = jnp.sum(rh * kh * r_k.astype(f32), axis=-1, keepdims=True) * vh
    y = y + bonus.reshape(B, S, C_RWKV)
    return (y * g).astype(r.dtype)


def mlstm_mixer(q, k, v, o, ig, fg, ig_b, fg_b, norm_g):
    B, S, _ = q.shape
    H, Dh, L = H_MLSTM, HEAD_DIM, MLSTM_CHUNK
    nc = S // L
    f32 = jnp.float32
    chunks = lambda t: t.reshape(B, nc, L, H, Dh).transpose(0, 3, 1, 2, 4).astype(f32)
    gate = lambda t: t.astype(f32).reshape(B, nc, L, H).transpose(0, 3, 1, 2)
    qc, kc, vc = chunks(q), chunks(k) * (Dh ** -0.5), chunks(v)
    log_i = gate(ig + ig_b)
    log_f = jax.nn.log_sigmoid(gate(fg + fg_b))
    b = jnp.cumsum(log_f, axis=-1)
    g_tot = b[..., -1]
    u = g_tot[..., None] - b + log_i

    def step(carry, inp):
        C, n, m = carry
        g_c, u_c, k_c, v_c = inp
        m_new = jnp.maximum(g_c + m, jnp.max(u_c, axis=-1))
        dec = jnp.exp(g_c + m - m_new)
        wgt = jnp.exp(u_c - m_new[..., None])
        C_new = dec[..., None, None] * C + jnp.einsum('bhs,bhsd,bhse->bhde', wgt, v_c, k_c)
        n_new = dec[..., None] * n + jnp.einsum('bhs,bhse->bhe', wgt, k_c)
        return (C_new, n_new, m_new), (C, n, m)

    front = lambda t: jnp.moveaxis(t, 2, 0)
    init = (jnp.zeros((B, H, Dh, Dh), f32), jnp.zeros((B, H, Dh), f32), jnp.zeros((B, H), f32))
    _, (C0, n0, m0) = lax.scan(step, init, (front(g_tot), front(u), front(kc), front(vc)))
    C0, n0, m0 = jnp.moveaxis(C0, 0, 2), jnp.moveaxis(n0, 0, 2), jnp.moveaxis(m0, 0, 2)
    a_inter = b + m0[..., None]
    causal = jnp.tril(jnp.ones((L, L), dtype=bool))
    D = jnp.where(causal, b[..., :, None] - b[..., None, :] + log_i[..., None, :], -jnp.inf)
    m_t = jnp.maximum(a_inter, jnp.max(D, axis=-1))
    w_inter = jnp.exp(a_inter - m_t)
    s = jnp.exp(D - m_t[..., None]) * jnp.einsum('bhcjd,bhcsd->bhcjs', qc, kc)
    num = (w_inter[..., None] * jnp.einsum('bhcde,bhcje->bhcjd', C0, qc)
           + jnp.einsum('bhcjs,bhcsd->bhcjd', s, vc))
    den = w_inter * jnp.einsum('bhce,bhcje->bhcj', n0, qc) + jnp.sum(s, axis=-1)
    h = num / jnp.maximum(jnp.abs(den), jnp.exp(-m_t))[..., None]
    h = h * lax.rsqrt(jnp.mean(h * h, axis=-1, keepdims=True) + NORM_EPS)
    h = h.transpose(0, 2, 3, 1, 4).reshape(B, S, C_MLSTM) * norm_g.astype(f32)
    return (jax.nn.sigmoid(o.astype(f32)) * h).astype(q.dtype)


def hybrid_mixer(h, w_in, w_out, nsa_pe_k, nsa_pe_v, nsa_ck_w1, nsa_ck_w2, nsa_cv_w1, nsa_cv_w2,
                 nsa_gate_b, nsa_out_g, rw_mu, rw_w0, rw_w2, rw_a0, rw_a2, rw_g2, rw_kk, rw_ka,
                 rw_rk, rw_ln_w, rw_ln_b, ml_conv_w, ml_conv_b, ml_ig_b, ml_fg_b, ml_norm_g):
    proj = h @ w_in
    p_nsa, p_rw, p_ml = split_cols(proj, (NSA_IN, RWKV_IN, MLSTM_IN))
    q, kc, vc, ks, vs, kw, vw, gts = split_cols(p_nsa, NSA_SIZES)
    o_nsa = nsa_mixer(q, kc, vc, ks, vs, kw, vw, gts, nsa_gate_b, nsa_pe_k, nsa_pe_v,
                      nsa_ck_w1, nsa_ck_w2, nsa_cv_w1, nsa_cv_w2)
    o_nsa = rms_norm(o_nsa, nsa_out_g)
    p_rw = p_rw + rw_mu * (shift_right(p_rw) - p_rw)
    r, k, v, xw, xa, xg = split_cols(p_rw, RWKV_SIZES)
    o_rw = rwkv7_mixer(r, k, v, xw, xa, xg, rw_w0, rw_w2, rw_a0, rw_a2, rw_g2, rw_kk, rw_ka,
                       rw_rk, rw_ln_w, rw_ln_b)
    qk, mv, mo, ig, fg = split_cols(p_ml, MLSTM_SIZES)
    qk = jax.nn.silu(causal_dwconv(qk, ml_conv_w, ml_conv_b))
    mq, mk = jnp.split(qk, 2, axis=-1)
    o_ml = mlstm_mixer(mq, mk, mv, mo, ig, fg, ml_ig_b, ml_fg_b, ml_norm_g)
    return jnp.concatenate([o_nsa, o_rw, o_ml], axis=-1) @ w_out


def swiglu(h, w_gate, w_up, w_down):
    return (jax.nn.silu(h @ w_gate) * (h @ w_up)) @ w_down


def setup_inputs(seed: int = 0) -> dict:
    key = jax.random.key(seed)
    keys = jax.random.split(key, 40)
    counter = [0]

    def nxt():
        kk = keys[counter[0]]
        counter[0] += 1
        return kk

    f32 = jnp.float32
    L = DEPTH
    nrm = lambda shape, s: s * jax.random.normal(nxt(), shape, f32)
    gain = lambda shape: 1.0 + 0.05 * jax.random.normal(nxt(), shape, f32)
    unif = lambda shape, lo, hi: jax.random.uniform(nxt(), shape, f32, lo, hi)
    return {
        "x": nrm((BATCH, SEQ, D_MODEL), 1.0),
        "c": nrm((BATCH, D_MODEL), 1.0),
        "w_mod": nrm((L, D_MODEL, 6 * D_MODEL), 0.3 * D_MODEL ** -0.5),
        "b_mod": nrm((L, 6 * D_MODEL), 0.02),
        "g_pre_mix": gain((L, D_MODEL)),
        "g_post_mix": gain((L, D_MODEL)),
        "g_pre_ffn": gain((L, D_MODEL)),
        "g_post_ffn": gain((L, D_MODEL)),
        "w_in": nrm((L, D_MODEL, D_IN), D_MODEL ** -0.5),
        "w_out": nrm((L, D_MIX, D_MODEL), D_MIX ** -0.5),
        "nsa_pe_k": nrm((L, CMP_BLOCK, HEAD_DIM), 0.1),
        "nsa_pe_v": nrm((L, CMP_BLOCK, HEAD_DIM), 0.1),
        "nsa_ck_w1": nrm((L, CMP_BLOCK * HEAD_DIM, HEAD_DIM), (CMP_BLOCK * HEAD_DIM) ** -0.5),
        "nsa_ck_w2": nrm((L, HEAD_DIM, HEAD_DIM), HEAD_DIM ** -0.5),
        "nsa_cv_w1": nrm((L, CMP_BLOCK * HEAD_DIM, HEAD_DIM), (CMP_BLOCK * HEAD_DIM) ** -0.5),
        "nsa_cv_w2": nrm((L, HEAD_DIM, HEAD_DIM), HEAD_DIM ** -0.5),
        "nsa_gate_b": nrm((L, 3 * H_ATT), 0.1),
        "nsa_out_g": gain((L, C_ATT)),
        "rw_mu": unif((L, RWKV_IN), 0.0, 1.0),
        "rw_w0": unif((L, C_RWKV), -6.5, -1.0),
        "rw_w2": nrm((L, RANK_W, C_RWKV), 0.1 * RANK_W ** -0.5),
        "rw_a0": nrm((L, C_RWKV), 0.1),
        "rw_a2": nrm((L, RANK_A, C_RWKV), 0.1 * RANK_A ** -0.5),
        "rw_g2": nrm((L, RANK_G, C_RWKV), RANK_G ** -0.5),
        "rw_kk": 0.85 + 0.05 * jax.random.normal(nxt(), (L, C_RWKV), f32),
        "rw_ka": gain((L, C_RWKV)),
        "rw_rk": nrm((L, H_RWKV, HEAD_DIM), 0.1),
        "rw_ln_w": gain((L, C_RWKV)),
        "rw_ln_b": nrm((L, C_RWKV), 0.02),
        "ml_conv_w": nrm((L, CONV_WIDTH, 2 * C_MLSTM), CONV_WIDTH ** -0.5),
        "ml_conv_b": nrm((L, 2 * C_MLSTM), 0.02),
        "ml_ig_b": nrm((L, H_MLSTM), 0.1),
        "ml_fg_b": unif((L, H_MLSTM), 3.0, 6.0),
        "ml_norm_g": gain((L, C_MLSTM)),
        "ffn_w_gate": nrm((L, D_MODEL, D_FF), D_MODEL ** -0.5),
        "ffn_w_up": nrm((L, D_MODEL, D_FF), D_MODEL ** -0.5),
        "ffn_w_down": nrm((L, D_FF, D_MODEL), D_FF ** -0.5),
    }


def reference(x, c, w_mod, b_mod, g_pre_mix, g_post_mix, g_pre_ffn, g_post_ffn, w_in, w_out,
              nsa_pe_k, nsa_pe_v, nsa_ck_w1, nsa_ck_w2, nsa_cv_w1, nsa_cv_w2, nsa_gate_b, nsa_out_g,
              rw_mu, rw_w0, rw_w2, rw_a0, rw_a2, rw_g2, rw_kk, rw_ka, rw_rk, rw_ln_w, rw_ln_b,
              ml_conv_w, ml_conv_b, ml_ig_b, ml_fg_b, ml_norm_g, ffn_w_gate, ffn_w_up, ffn_w_down):
    cs = jax.nn.silu(c)
    for l in range(DEPTH):
        mod = cs @ w_mod[l] + b_mod[l]
        sh1, sc1, gt1, sh2, sc2, gt2 = [m[:, None, :] for m in jnp.split(mod, 6, axis=-1)]
        h = rms_norm(x, g_pre_mix[l]) * (1 + sc1) + sh1
        y = hybrid_mixer(h, w_in[l], w_out[l], nsa_pe_k[l], nsa_pe_v[l], nsa_ck_w1[l], nsa_ck_w2[l],
                         nsa_cv_w1[l], nsa_cv_w2[l], nsa_gate_b[l], nsa_out_g[l], rw_mu[l], rw_w0[l],
                         rw_w2[l], rw_a0[l], rw_a2[l], rw_g2[l], rw_kk[l], rw_ka[l], rw_rk[l],
                         rw_ln_w[l], rw_ln_b[l], ml_conv_w[l], ml_conv_b[l], ml_ig_b[l], ml_fg_b[l],
                         ml_norm_g[l])
        x = x + gt1 * rms_norm(y, g_post_mix[l])
        h = rms_norm(x, g_pre_ffn[l]) * (1 + sc2) + sh2
        y = swiglu(h, ffn_w_gate[l], ffn_w_up[l], ffn_w_down[l])
        x = x + gt2 * rms_norm(y, g_post_ffn[l])
    return x
```

```cpp
#include <hip/hip_runtime.h>
#include <cstdio>
#include <cstdint>

typedef _Float16 h16;

constexpr int D = 1024, NB = 8, S = 4096, M = NB * S, DEPTH = 2;
constexpr int HD = 64;
constexpr int C_ATT = 256, C_RW = 384, C_ML = 384;
constexpr int H_ATT = 4, H_RW = 6, H_ML = 6;
constexpr int NSA_IN = 652, RW_IN = 1408, ML_IN = 1548, D_IN = 3608;
constexpr int DFF = 2816;
constexpr int NCMP = 255, NSLC = 64;
constexpr int PITCH = 3296;
constexpr int PC_VC = 0, PC_KS = 64, PC_VS = 128, PC_KW = 192, PC_VW = 256;
constexpr int PC_R = 320, PC_K = 704, PC_V = 1088, PC_XW = 1472, PC_XA = 1536, PC_XG = 1600;
constexpr int PC_MQ = 1728, PC_MK = 2112, PC_MV = 2496, PC_MO = 2880;
constexpr int PC_GTS = 3264, PC_IG = 3276, PC_FG = 3282;
constexpr int QKP = 320;
constexpr float QSCALE_Q = 0.125f * 1.4426950408889634f;

constexpr size_t MiB = 1u << 20;
constexpr size_t WS_MOD = 0;
constexpr size_t WS_QK32 = 4 * MiB;
constexpr size_t WS_P16 = 44 * MiB;
constexpr size_t WS_H16 = 250 * MiB;
constexpr size_t WS_Y32 = 314 * MiB;
constexpr size_t WS_XB16 = 184 * MiB;
constexpr size_t WS_ACT = 4 * MiB;
constexpr size_t WS_END = 442 * MiB;

__device__ __forceinline__ float wave_sum(float v) {
#pragma unroll
    for (int o = 32; o > 0; o >>= 1) v += __shfl_xor(v, o);
    return v;
}
__device__ __forceinline__ float wave_max(float v) {
#pragma unroll
    for (int o = 32; o > 0; o >>= 1) v = fmaxf(v, __shfl_xor(v, o));
    return v;
}
__device__ __forceinline__ float sigmoidf_(float x) { return 1.f / (1.f + expf(-x)); }
__device__ __forceinline__ float siluf_(float x) { return x * sigmoidf_(x); }
__device__ __forceinline__ float softplusf_(float x) { return fmaxf(x, 0.f) + log1pf(expf(-fabsf(x))); }
__device__ __forceinline__ float gelu_tanh(float x) { return 0.5f * x * (1.f + tanhf(0.7978845608028654f * (x + 0.044715f * x * x * x))); }

#include <hip/hip_cooperative_groups.h>
namespace cg = cooperative_groups;

namespace pg8 {
#define PG8_LAS __attribute__((address_space(3)))
typedef short s16x8 __attribute__((ext_vector_type(8)));
typedef _Float16 f16x8 __attribute__((ext_vector_type(8)));
typedef float f32x4 __attribute__((ext_vector_type(4)));
typedef unsigned u32x4 __attribute__((ext_vector_type(4)));
typedef unsigned u32x2 __attribute__((ext_vector_type(2)));
constexpr int BM = 256, BK = 64, HALF = 128, HTB = HALF * BK * 2  , STAGE_BYTES = 8 * HTB, NXCD = 8, WGM = 8;

__host__ __device__ __forceinline__ int lds_byte(int r, int c) { const int st = (r >> 4) * 2 + (c >> 5), rr = r & 15, cc = c & 31, ob = rr * 64 + cc * 2; return st * 1024 + (ob ^ (((ob >> 9) & 1) << 5)); }
__host__ __device__ __forceinline__ void stage_rc(int b, int& R, int& C) { const int st = b / 1024, sb = b % 1024, swz = sb ^ (((sb >> 9) & 1) << 5); R = (st >> 1) * 16 + swz / 64; C = (st & 1) * 32 + (swz % 64) / 2; }
__host__ __device__ __forceinline__ int perm32(int rho) { const int n = rho >> 4, i = rho & 15; return 8 * (i >> 2) + 4 * n + (i & 3); }

struct Unit { int pm, pn; };
struct Gemm { const h16* A; const h16* Bt; int M, N, K; };

struct StaticOrder {
    int nM, nN, nwg, G, c;
    __host__ __device__ void init(int M, int N, int G_, int c_) { nM = M / BM; nN = N / BM; nwg = nM * nN; G = G_; c = c_; }
    __host__ __device__ bool next(int i, Unit& u) const {
        const long L = (long)i * G + c; if (L >= nwg) return false;
        int wgid = (int)L; { const int q = nwg / NXCD, r = nwg % NXCD, xcd = wgid % NXCD, off = wgid / NXCD; wgid = (xcd < r ? xcd * (q + 1) : r * (q + 1) + (xcd - r) * q) + off; }
        const int nig = WGM * nN, gid = wgid / nig, fm = gid * WGM, gsz = (nM - fm) < WGM ? (nM - fm) : WGM;
        u.pm = fm + ((wgid % nig) % gsz); u.pn = (wgid % nig) / gsz; return true;
    }
    __device__ __forceinline__ void a_ready(const Unit&) const {}
    __device__ __forceinline__ void done(const Unit&) const {}
};

__device__ __forceinline__ unsigned pk_f16(float lo, float hi) { typedef _Float16 h2 __attribute__((ext_vector_type(2))); h2 v = {(_Float16)lo, (_Float16)hi}; return __builtin_bit_cast(unsigned, v); }

struct EpiProj {
    static constexpr bool PERM = true, AFTER_DRAIN = false;
    h16* QK; h16* P; h16* VT;
    __device__ __forceinline__ void operator()(const f32x4 (&acc)[2][2][4][2], const Unit& u, int wr, int wc, int fr, int fq) const {
        const int row0 = u.pm * BM + wr * 64 + fr;
#pragma unroll
        for (int bj = 0; bj < 2; ++bj) {
            const int colt = u.pn * BM + bj * HALF + wc * 32 + 8 * fq;
            if (colt < 320) {
                const float qs = colt < 256 ? QSCALE_Q : 1.f;
#pragma unroll
                for (int ai = 0; ai < 2; ++ai)
#pragma unroll
                    for (int m = 0; m < 4; ++m) { const f32x4 v0 = acc[ai][bj][m][0], v1 = acc[ai][bj][m][1];
                        u32x4 w; w.x = pk_f16(v0[0] * qs, v0[1] * qs); w.y = pk_f16(v0[2] * qs, v0[3] * qs); w.z = pk_f16(v1[0] * qs, v1[1] * qs); w.w = pk_f16(v1[2] * qs, v1[3] * qs);
                        *(u32x4*)(QK + (size_t)(row0 + ai * HALF + m * 16) * QKP + colt) = w; }
            } else if ((colt >= 448 && colt < 512) || (colt >= 576 && colt < 640)) {
                const int br = colt >= 576 ? 1 : 0, d0 = colt - (br ? 576 : 448);
#pragma unroll
                for (int ai = 0; ai < 2; ++ai)
#pragma unroll
                    for (int m = 0; m < 4; ++m) { const int row = row0 + ai * HALF + m * 16, bb = row / S, tl = row % S;
                        h16* vp = VT + (((size_t)bb * 2 + br) * 64 + d0) * S + tl;
#pragma unroll
                        for (int e = 0; e < 4; ++e) { vp[(size_t)e * S] = (h16)acc[ai][bj][m][0][e]; vp[(size_t)(4 + e) * S] = (h16)acc[ai][bj][m][1][e]; } }
            } else {
#pragma unroll
                for (int ai = 0; ai < 2; ++ai)
#pragma unroll
                    for (int m = 0; m < 4; ++m) { const f32x4 v0 = acc[ai][bj][m][0], v1 = acc[ai][bj][m][1];
                        u32x4 w; w.x = pk_f16(v0[0], v0[1]); w.y = pk_f16(v0[2], v0[3]); w.z = pk_f16(v1[0], v1[1]); w.w = pk_f16(v1[2], v1[3]);
                        *(u32x4*)(P + (size_t)(row0 + ai * HALF + m * 16) * PITCH + (colt - 320)) = w; }
            }
        }
    }
};
struct EpiF16 {
    static constexpr bool PERM = true, AFTER_DRAIN = false;
    h16* C; int ldc;
    __device__ __forceinline__ void operator()(const f32x4 (&acc)[2][2][4][2], const Unit& u, int wr, int wc, int fr, int fq) const {
        const int row0 = u.pm * BM + wr * 64 + fr;
#pragma unroll
        for (int ai = 0; ai < 2; ++ai)
#pragma unroll
            for (int m = 0; m < 4; ++m)
#pragma unroll
                for (int bj = 0; bj < 2; ++bj) { const f32x4 v0 = acc[ai][bj][m][0], v1 = acc[ai][bj][m][1];
                    u32x4 w; w.x = pk_f16(v0[0], v0[1]); w.y = pk_f16(v0[2], v0[3]); w.z = pk_f16(v1[0], v1[1]); w.w = pk_f16(v1[2], v1[3]);
                    *(u32x4*)(C + (size_t)(row0 + ai * HALF + m * 16) * ldc + u.pn * BM + bj * HALF + wc * 32 + 8 * fq) = w; }
    }
};
struct EpiSwiglu {
    static constexpr bool PERM = true, AFTER_DRAIN = false;
    h16* C; int ldc;
    __device__ __forceinline__ void operator()(const f32x4 (&acc)[2][2][4][2], const Unit& u, int wr, int wc, int fr, int fq) const {
        const int row0 = u.pm * BM + wr * 64 + fr;
#pragma unroll
        for (int ai = 0; ai < 2; ++ai)
#pragma unroll
            for (int m = 0; m < 4; ++m) { float o[8];
#pragma unroll
                for (int n = 0; n < 2; ++n)
#pragma unroll
                    for (int e = 0; e < 4; ++e) { const float gt = acc[ai][0][m][n][e]; o[4 * n + e] = gt * __builtin_amdgcn_rcpf(1.f + __expf(-gt)) * acc[ai][1][m][n][e]; }
                u32x4 w; w.x = pk_f16(o[0], o[1]); w.y = pk_f16(o[2], o[3]); w.z = pk_f16(o[4], o[5]); w.w = pk_f16(o[6], o[7]);
                *(u32x4*)(C + (size_t)(row0 + ai * HALF + m * 16) * ldc + u.pn * HALF + wc * 32 + 8 * fq) = w; }
    }
};

template <class Epi, class Sched, bool ALIGN_EPI = false, bool SP2 = false>
__device__ __forceinline__ void gemm_phase(PG8_LAS unsigned char* lds, const Gemm g, const Sched& S, const Epi& E) {
    int tid_ = threadIdx.x; asm volatile("" : "+v"(tid_)); const int tid = tid_, wid = __builtin_amdgcn_readfirstlane(tid >> 6), lane = tid & 63, wr = wid >> 2, wc = wid & 3, fr = lane & 15, fq = lane >> 4;
    const int K = g.K, nt = K / BK;
    unsigned voffA[2], voffB[2];
#pragma unroll
    for (int i = 0; i < 2; ++i) { int R, C; stage_rc(tid * 16 + i * 8192, R, C); const int Rb = Epi::PERM ? ((R & ~31) + perm32(R & 31)) : R;
        voffA[i] = (unsigned)(R * K + C) * 2u; voffB[i] = (unsigned)(Rb * K + C) * 2u; }
    const size_t kstep = (size_t)(BK * 2);
    const size_t hstep = (size_t)HALF * K * 2;
    const size_t tstep = 2 * hstep;
    const unsigned ldsw = (unsigned)wid * 1024u;
    const int aoff = lds_byte(wr * 64 + fr, fq * 8), boff = lds_byte(wc * 32 + fr, fq * 8);
#define PG8_SA(b, h) (((b) * 2 + (h)) * HTB)
#define PG8_SB(b, h) ((4 + (b) * 2 + (h)) * HTB)
#define PG8_STAGE(bufoff, gbase, voff) do { _Pragma("unroll") for (int _i = 0; _i < 2; ++_i) \
        __builtin_amdgcn_global_load_lds((const unsigned*)((const char*)(gbase) + (voff)[_i]), (PG8_LAS unsigned*)(lds + (bufoff) + ldsw + _i * 8192), 16, 0, 0); } while (0)
#define PG8_LDA(dst, b, h) do { _Pragma("unroll") for (int m = 0; m < 4; ++m) _Pragma("unroll") for (int k = 0; k < 2; ++k) dst[m][k] = *(const PG8_LAS s16x8*)(lds + PG8_SA(b, h) + aoff + m * 2048 + k * 1024); } while (0)
#define PG8_LDB(dst, b, h) do { _Pragma("unroll") for (int n = 0; n < 2; ++n) _Pragma("unroll") for (int k = 0; k < 2; ++k) dst[n][k] = *(const PG8_LAS s16x8*)(lds + PG8_SB(b, h) + boff + n * 2048 + k * 1024); } while (0)
#define PG8_MMA(ai, bj, At, Bt) do { __builtin_amdgcn_s_setprio(1); _Pragma("unroll") for (int m = 0; m < 4; ++m) _Pragma("unroll") for (int n = 0; n < 2; ++n) _Pragma("unroll") for (int k = 0; k < 2; ++k) \
        acc[ai][bj][m][n] = __builtin_amdgcn_mfma_f32_16x16x32_f16(__builtin_bit_cast(f16x8, Bt[n][k]), __builtin_bit_cast(f16x8, At[m][k]), acc[ai][bj][m][n], 0, 0, 0); __builtin_amdgcn_s_setprio(0); } while (0)
#define PG8_WAIT_V(n) asm volatile("s_waitcnt vmcnt(" #n ")" ::: "memory")
#define PG8_WAIT_L(n) asm volatile("s_waitcnt lgkmcnt(" #n ")" ::: "memory")
#define PG8_BAR __builtin_amdgcn_s_barrier()
#define PG8_SCHED __builtin_amdgcn_sched_barrier(0)
    Unit cur, nxt; int ui = 0;
    if (!S.next(0, cur)) return;
    f32x4 acc[2][2][4][2];
#pragma unroll
    for (int a = 0; a < 2; ++a)
#pragma unroll
        for (int b = 0; b < 2; ++b)
#pragma unroll
            for (int m = 0; m < 4; ++m)
#pragma unroll
                for (int n = 0; n < 2; ++n) acc[a][b][m][n] = (f32x4){0.f, 0.f, 0.f, 0.f};
    s16x8 At[4][2], B0[2][2], B1[2][2];
    const char* cA = (const char*)g.A + (size_t)cur.pm * tstep; const char* cB = (const char*)g.Bt + (size_t)cur.pn * tstep;
    S.a_ready(cur);
    if constexpr (SP2) {
        PG8_STAGE(PG8_SB(0, 0), cB, voffB); PG8_STAGE(PG8_SB(0, 1), cB + hstep, voffB); PG8_STAGE(PG8_SA(0, 0), cA, voffA); PG8_STAGE(PG8_SA(0, 1), cA + hstep, voffA);
        if (wr == 1) PG8_BAR;
        PG8_WAIT_V(2); PG8_BAR;
        PG8_STAGE(PG8_SB(1, 0), cB + kstep, voffB); PG8_STAGE(PG8_SA(1, 0), cA + kstep, voffA); PG8_STAGE(PG8_SB(1, 1), cB + hstep + kstep, voffB);
        PG8_WAIT_V(6); PG8_BAR;
    } else {
        PG8_STAGE(PG8_SB(0, 0), cB, voffB); PG8_STAGE(PG8_SA(0, 0), cA, voffA); PG8_STAGE(PG8_SB(0, 1), cB + hstep, voffB); PG8_STAGE(PG8_SA(0, 1), cA + hstep, voffA);
        if (wr == 1) PG8_BAR;
        PG8_WAIT_V(4); PG8_BAR;
        PG8_STAGE(PG8_SB(1, 0), cB + kstep, voffB); PG8_STAGE(PG8_SA(1, 0), cA + kstep, voffA); PG8_STAGE(PG8_SB(1, 1), cB + hstep + kstep, voffB);
        PG8_WAIT_V(6); PG8_BAR;
    }
    for (;;) {
        const bool has_next = S.next(ui + 1, nxt);
        const char* nA = has_next ? (const char*)g.A + (size_t)nxt.pm * tstep : cA; const char* nB = has_next ? (const char*)g.Bt + (size_t)nxt.pn * tstep : cB;
        for (int t = 0; t < nt; t += 2) {
            const bool last = (t == nt - 2);
            const char* a1 = cA + (size_t)(t + 1) * kstep;
            const char* a2 = last ? nA : cA + (size_t)(t + 2) * kstep; const char* b2 = last ? nB : cB + (size_t)(t + 2) * kstep;
            const char* a3 = a2 + kstep; const char* b3 = b2 + kstep;
            if (last && has_next) S.a_ready(nxt);
            if constexpr (SP2) {
            PG8_LDB(B0, 0, 0); PG8_LDB(B1, 0, 1); PG8_SCHED; PG8_LDA(At, 0, 0); PG8_STAGE(PG8_SA(1, 1), a1 + hstep, voffA);
            PG8_WAIT_V(8); PG8_WAIT_L(0); PG8_BAR; PG8_MMA(0, 0, At, B0); PG8_MMA(0, 1, At, B1); PG8_BAR; PG8_SCHED;
            PG8_LDA(At, 0, 1); PG8_STAGE(PG8_SB(0, 0), b2, voffB); PG8_STAGE(PG8_SB(0, 1), b2 + hstep, voffB); PG8_STAGE(PG8_SA(0, 0), a2, voffA);
            PG8_WAIT_V(8); PG8_WAIT_L(0); PG8_BAR; PG8_MMA(1, 0, At, B0); PG8_MMA(1, 1, At, B1); PG8_BAR; PG8_SCHED;
            PG8_LDB(B0, 1, 0); PG8_LDB(B1, 1, 1); PG8_SCHED; PG8_LDA(At, 1, 0); PG8_STAGE(PG8_SA(0, 1), a2 + hstep, voffA);
            PG8_WAIT_V(8); PG8_WAIT_L(0); PG8_BAR; PG8_MMA(0, 0, At, B0); PG8_MMA(0, 1, At, B1); PG8_BAR; PG8_SCHED;
            PG8_LDA(At, 1, 1); PG8_STAGE(PG8_SB(1, 0), b3, voffB); PG8_STAGE(PG8_SB(1, 1), b3 + hstep, voffB); PG8_STAGE(PG8_SA(1, 0), a3, voffA);
            PG8_WAIT_V(8); PG8_WAIT_L(0); PG8_BAR; PG8_MMA(1, 0, At, B0); PG8_MMA(1, 1, At, B1); PG8_BAR; PG8_SCHED;
            } else {
            PG8_LDB(B0, 0, 0); PG8_SCHED; PG8_LDA(At, 0, 0); PG8_STAGE(PG8_SA(1, 1), a1 + hstep, voffA);
            PG8_WAIT_L(8); PG8_BAR; PG8_WAIT_L(0); PG8_MMA(0, 0, At, B0); PG8_BAR; PG8_SCHED;
            PG8_LDB(B1, 0, 1); PG8_STAGE(PG8_SB(0, 0), b2, voffB);
            PG8_BAR; PG8_WAIT_L(0); PG8_MMA(0, 1, At, B1); PG8_BAR;
            PG8_LDA(At, 0, 1); PG8_STAGE(PG8_SA(0, 0), a2, voffA);
            PG8_BAR; PG8_WAIT_L(0); PG8_MMA(1, 0, At, B0); PG8_BAR; PG8_SCHED;
            PG8_STAGE(PG8_SB(0, 1), b2 + hstep, voffB);
            PG8_WAIT_V(6); PG8_BAR; PG8_MMA(1, 1, At, B1); PG8_BAR;
            PG8_LDB(B0, 1, 0); PG8_SCHED; PG8_LDA(At, 1, 0); PG8_STAGE(PG8_SA(0, 1), a2 + hstep, voffA);
            PG8_WAIT_L(8); PG8_BAR; PG8_WAIT_L(0); PG8_MMA(0, 0, At, B0); PG8_BAR; PG8_SCHED;
            PG8_LDB(B1, 1, 1); PG8_STAGE(PG8_SB(1, 0), b3, voffB);
            PG8_BAR; PG8_WAIT_L(0); PG8_MMA(0, 1, At, B1); PG8_BAR;
            PG8_LDA(At, 1, 1); PG8_STAGE(PG8_SA(1, 0), a3, voffA);
            PG8_BAR; PG8_WAIT_L(0); PG8_MMA(1, 0, At, B0); PG8_BAR; PG8_SCHED;
            PG8_STAGE(PG8_SB(1, 1), b3 + hstep, voffB);
            PG8_WAIT_V(6); PG8_BAR; PG8_MMA(1, 1, At, B1); PG8_BAR;
            }
        }
        if constexpr (ALIGN_EPI) { if (wr == 0) PG8_BAR; }
        if constexpr (!Epi::AFTER_DRAIN) { E(acc, cur, wr, wc, fr, fq); S.done(cur); }
        if (!has_next) break;
#pragma unroll
        for (int a = 0; a < 2; ++a)
#pragma unroll
            for (int b = 0; b < 2; ++b)
#pragma unroll
                for (int m = 0; m < 4; ++m)
#pragma unroll
                    for (int n = 0; n < 2; ++n) acc[a][b][m][n] = (f32x4){0.f, 0.f, 0.f, 0.f};
        cur = nxt; cA = nA; cB = nB; ++ui;
        if constexpr (ALIGN_EPI) { if (wr == 1) PG8_BAR; }
    }
    PG8_WAIT_V(0);
    if constexpr (!ALIGN_EPI) { if (wr == 0) PG8_BAR; }
    PG8_BAR;
#undef PG8_SA
#undef PG8_SB
#undef PG8_STAGE
#undef PG8_LDA
#undef PG8_LDB
#undef PG8_MMA
#undef PG8_WAIT_V
#undef PG8_WAIT_L
#undef PG8_BAR
#undef PG8_SCHED
}
}
constexpr size_t WS_WIN = 442 * MiB;
constexpr size_t WS_WOUT = 457 * MiB;
constexpr size_t WS_W1 = 461 * MiB;
constexpr size_t WS_W2 = 483 * MiB;
constexpr size_t WS_VTG = 496 * MiB;
constexpr size_t WS_CW16 = 509 * MiB;
constexpr size_t WS_END2 = 510 * MiB;
constexpr size_t WS_CBIAS = 512 * 1024;
constexpr size_t WS_KC16 = 1 * MiB;
constexpr size_t WS_VC16 = 1 * MiB + 512 * 1024;
constexpr size_t WS_W1C = 3 * MiB;
constexpr size_t WS_LRW0 = 2 * MiB;
constexpr int LRW_L0 = 384 * 64 * 2 + 384 * 128;
constexpr int NIN_PAD = 3584, NFF2 = 2 * DFF;
constexpr size_t WS_WSM = 508 * MiB;
constexpr int LDS_BYTES = 163840;
constexpr size_t WS_BAR = 400 * 1024;
constexpr int L_BARST = LDS_BYTES - 16;
constexpr size_t WS_QCTR = WS_BAR + 14336;
constexpr int L_QSLOT = LDS_BYTES - 32;
#define LAS __attribute__((address_space(3)))

struct Args { const float* in[37]; float* out; unsigned char* ws; int ph_lo, ph_hi; };

__device__ __forceinline__ int win_src_col(int nd) {
    if (nd < 320) return nd;
    const int c = nd - 320;
    if (c < 320) return c + 320;
    if (c < 3264) return c + 332;
    if (c < 3276) return c - 2624;
    if (c < 3288) return c + 320;
    return -1;
}
__device__ __forceinline__ int wsm_src_col(int r) { return r < 12 ? 640 + r : (r < 18 ? 3596 + (r - 12) : (r < 24 ? 3602 + (r - 18) : -1)); }
__device__ __forceinline__ void transpose_item(const float* cp, int ns, int K, h16* WT, int k0, int n0, LAS float* scr, int lane) {
    float tv[32];
#pragma unroll
    for (int i = 0; i < 32; ++i) { const int kk = 2 * i + (lane >> 5); tv[i] = cp ? __builtin_nontemporal_load(cp + (size_t)(k0 + kk) * ns) : 0.f; }
#pragma unroll
    for (int i = 0; i < 32; ++i) { const int kk = 2 * i + (lane >> 5); scr[kk * 33 + (lane & 31)] = tv[i]; }
    asm volatile("s_waitcnt lgkmcnt(0)" ::: "memory");
    const int c = lane & 7;
#pragma unroll
    for (int j = 0; j < 4; ++j) { const int n = (lane >> 3) + 8 * j; const LAS float* s = scr + (8 * c) * 33 + n;
        pg8::u32x4 o; o.x = pg8::pk_f16(s[0 * 33], s[1 * 33]); o.y = pg8::pk_f16(s[2 * 33], s[3 * 33]); o.z = pg8::pk_f16(s[4 * 33], s[5 * 33]); o.w = pg8::pk_f16(s[6 * 33], s[7 * 33]);
        *(pg8::u32x4*)(WT + (size_t)(n0 + n) * K + k0 + 8 * c) = o; }
    asm volatile("s_waitcnt lgkmcnt(0)" ::: "memory");
}

__device__ __forceinline__ void prologue_weights(const Args& a, LAS unsigned char* lds, int part) {
    int tid_ = threadIdx.x; asm volatile("" : "+v"(tid_)); const int tid = tid_, lane = tid & 63, wave = __builtin_amdgcn_readfirstlane(tid >> 6);
    const int G = gridDim.x, gw = blockIdx.x * 8 + wave, NGW = G * 8;
    LAS float* scr = (LAS float*)(lds + wave * 16384);
    constexpr int I_IN = 16 * (NIN_PAD / 32), I_OUT = 16 * 32, I_W1 = 16 * (NFF2 / 32), I_W2 = (DFF / 64) * 32, I_L = I_IN + I_OUT + I_W1 + I_W2;
    for (int it = gw; it < 2 * I_L; it += NGW) {
        const int l = it / I_L; int r = it % I_L;
        if ((part == 0) != (l == 0 && r < I_IN)) continue;
        if (r < I_IN) { const int nblk = NIN_PAD / 32, kb = r / nblk, nb = r % nblk; const int sc = win_src_col(nb * 32 + (lane & 31));
            transpose_item(sc >= 0 ? a.in[8] + (size_t)l * D * D_IN + sc : nullptr, D_IN, D, (h16*)(a.ws + WS_WIN) + (size_t)l * NIN_PAD * D, kb * 64, nb * 32, scr, lane); continue; }
        r -= I_IN;
        if (r < I_OUT) { const int kb = r / 32, nb = r % 32;
            transpose_item(a.in[9] + (size_t)l * D * D + nb * 32 + (lane & 31), D, D, (h16*)(a.ws + WS_WOUT) + (size_t)l * D * D, kb * 64, nb * 32, scr, lane); continue; }
        r -= I_OUT;
        if (r < I_W1) { const int nblk = NFF2 / 32, kb = r / nblk, nb = r % nblk; const int nd = nb * 32 + (lane & 31);
            const float* src = (((nd >> 7) & 1) ? a.in[35] : a.in[34]) + (size_t)l * D * DFF + (128 * (nd >> 8) + (nd & 127));
            transpose_item(src, DFF, D, (h16*)(a.ws + WS_W1) + (size_t)l * NFF2 * D, kb * 64, nb * 32, scr, lane); continue; }
        r -= I_W1;
        { const int kb = r / 32, nb = r % 32;
            transpose_item(a.in[36] + (size_t)l * DFF * D + nb * 32 + (lane & 31), D, DFF, (h16*)(a.ws + WS_W2) + (size_t)l * D * DFF, kb * 64, nb * 32, scr, lane); }
    }
}
__device__ __forceinline__ void phase_prologue(const Args& a, LAS unsigned char* lds) {
    int tid_ = threadIdx.x; asm volatile("" : "+v"(tid_)); const int tid = tid_, lane = tid & 63, wave = __builtin_amdgcn_readfirstlane(tid >> 6);
    const int G = gridDim.x, gw = blockIdx.x * 8 + wave, NGW = G * 8;
    LAS float* scr = (LAS float*)(lds + wave * 16384);
    prologue_weights(a, lds, 0);
    for (int i = blockIdx.x * 512 + tid; i < 2 * 5 * 768; i += G * 512) {
        const int l = i / 3840, r = i % 3840; ((h16*)(a.ws + WS_CW16))[i] = (h16)(r < 3072 ? a.in[29][l * 3072 + r] : a.in[30][l * 768 + (r - 3072)]); }
    for (int it = gw; it < 2 * 16; it += NGW) {
        const int l = it >> 4, kb = it & 15; const int sc = wsm_src_col(lane & 31);
        transpose_item(sc >= 0 ? a.in[8] + (size_t)l * D * D_IN + sc : nullptr, D_IN, D, (h16*)(a.ws + WS_WSM) + (size_t)l * 32 * D, kb * 64, 0, scr, lane); }
    for (int it = gw; it < 4 * 64; it += NGW) {
        const int mat = it >> 6, r = it & 63, l = mat >> 1, kv = mat & 1, kb = r >> 1, nb = r & 1;
        transpose_item((kv ? a.in[14] : a.in[12]) + (size_t)l * 2048 * 64 + nb * 32 + (lane & 31), 64, 2048, (h16*)(a.ws + WS_W1C) + (size_t)mat * 64 * 2048, kb * 64, nb * 32, scr, lane);
    }
    for (int it = gw; it < 2 * 48; it += NGW) {
        const int l = it / 48, r = it % 48;
        h16* dst = (h16*)(a.ws + WS_LRW0) + (size_t)l * LRW_L0;
        if (r < 12) transpose_item(a.in[20] + (size_t)l * 64 * C_RW + r * 32 + (lane & 31), C_RW, 64, dst, 0, r * 32, scr, lane);
        else if (r < 24) transpose_item(a.in[22] + (size_t)l * 64 * C_RW + (r - 12) * 32 + (lane & 31), C_RW, 64, dst + 384 * 64, 0, (r - 12) * 32, scr, lane);
        else { const int kb = (r - 24) / 12, nb = (r - 24) % 12; transpose_item(a.in[23] + (size_t)l * 128 * C_RW + nb * 32 + (lane & 31), C_RW, 128, dst + 2 * 384 * 64, kb * 64, nb * 32, scr, lane); }
    }
    if (blockIdx.x >= G - 4) {
        const int u = G - 1 - (int)blockIdx.x, l = u >> 1, kv = u & 1; const float* pe = (kv ? a.in[11] : a.in[10]) + l * 2048 + wave * 256; const float* w1 = (kv ? a.in[14] : a.in[12]) + (size_t)l * 2048 * 64 + (size_t)wave * 256 * 64 + lane;
        float sacc = 0.f;
#pragma unroll 1
        for (int k = 0; k < 256; k += 16) { float wv[16];
#pragma unroll
            for (int j = 0; j < 16; ++j) wv[j] = w1[(size_t)(k + j) * 64];
#pragma unroll
            for (int j = 0; j < 16; ++j) sacc += pe[k + j] * wv[j]; }
        LAS float* bred = (LAS float*)(lds + 8 * 16384);
        bred[wave * 64 + lane] = sacc;
        __syncthreads();
        if (wave == 0) { float t = 0.f;
#pragma unroll
            for (int j = 0; j < 8; ++j) t += bred[j * 64 + lane];
            ((float*)(a.ws + WS_CBIAS))[u * 64 + lane] = t; }
    }
    __syncthreads();
    LAS float* cs = (LAS float*)lds;
    LAS float* red = (LAS float*)(lds + 32768);
    for (int i = tid; i < NB * D; i += 512) { const float v = a.in[1][i]; cs[i] = v / (1.f + __expf(-v)); }
    __syncthreads();
    float* MOD = (float*)(a.ws + WS_MOD);
    for (int u = blockIdx.x; u < 2 * 96; u += G) {
        const int l = u / 96, col = (u % 96) * 64 + (tid & 63), ks = tid >> 6;
        const float* w = a.in[2] + (size_t)l * D * 6 * D + col;
        float acc[8];
#pragma unroll
        for (int b = 0; b < 8; ++b) acc[b] = 0.f;
#pragma unroll 1
        for (int k = ks * 128; k < ks * 128 + 128; k += 16) { float wv[16];
#pragma unroll
            for (int j = 0; j < 16; ++j) wv[j] = w[(size_t)(k + j) * 6 * D];
#pragma unroll
            for (int j = 0; j < 16; ++j)
#pragma unroll
                for (int b = 0; b < 8; ++b) acc[b] += cs[b * D + k + j] * wv[j]; }
#pragma unroll
        for (int b = 0; b < 8; ++b) red[(ks * 8 + b) * 64 + (tid & 63)] = acc[b];
        __syncthreads();
        { const int b = tid >> 6; float s = a.in[3][l * 6 * D + col];
#pragma unroll
          for (int k2 = 0; k2 < 8; ++k2) s += red[(k2 * 8 + b) * 64 + (tid & 63)];
          MOD[((size_t)l * NB + b) * 6 * D + col] = s; }
        __syncthreads();
    }
}

template <bool XH> struct XRaw;
template <> struct XRaw<false> { pg8::f32x4 x[2][2]; };
template <> struct XRaw<true> { pg8::u32x4 x[2]; };
__device__ __forceinline__ void x_load(XRaw<false>& R, const void* base, size_t off) {
#pragma unroll
    for (int j = 0; j < 2; ++j) { const float* p = (const float*)base + off + j * 512; R.x[j][0] = __builtin_nontemporal_load((const pg8::f32x4*)p); R.x[j][1] = __builtin_nontemporal_load((const pg8::f32x4*)(p + 4)); }
}
__device__ __forceinline__ void x_load(XRaw<true>& R, const void* base, size_t off) {
#pragma unroll
    for (int j = 0; j < 2; ++j) R.x[j] = __builtin_nontemporal_load((const pg8::u32x4*)((const h16*)base + off + j * 512));
}
__device__ __forceinline__ float h_lo(unsigned w) { return (float)__builtin_bit_cast(_Float16, (unsigned short)(w & 0xffffu)); }
__device__ __forceinline__ float h_hi(unsigned w) { return (float)__builtin_bit_cast(_Float16, (unsigned short)(w >> 16)); }
__device__ __forceinline__ void h_unpack(const pg8::u32x4 w, float (&o)[8]) { o[0] = h_lo(w.x); o[1] = h_hi(w.x); o[2] = h_lo(w.y); o[3] = h_hi(w.y); o[4] = h_lo(w.z); o[5] = h_hi(w.z); o[6] = h_lo(w.w); o[7] = h_hi(w.w); }
__device__ __forceinline__ void x_unpack(const XRaw<false>& R, int j, float (&o)[8]) {
#pragma unroll
    for (int e = 0; e < 4; ++e) { o[e] = R.x[j][0][e]; o[4 + e] = R.x[j][1][e]; } }
__device__ __forceinline__ void x_unpack(const XRaw<true>& R, int j, float (&o)[8]) { h_unpack(R.x[j], o); }
template <bool XI, bool HASY> struct PostRaw { XRaw<XI> x; pg8::u32x4 y[2]; };
template <bool XI, bool HASY>
__device__ __forceinline__ void post_load(PostRaw<XI, HASY>& R, const void* xold, const h16* y, int tok, int lane) {
    const size_t off = (size_t)tok * D + lane * 8;
    if constexpr (HASY) {
#pragma unroll
        for (int j = 0; j < 2; ++j) R.y[j] = __builtin_nontemporal_load((const pg8::u32x4*)(y + off + j * 512)); }
    x_load(R.x, xold, off);
}
template <bool XI, bool XO, bool HASY, bool HASH>
__device__ __forceinline__ void post_row(const PostRaw<XI, HASY>& R, int tok, int lane, const float (&pa)[2][8], const float (&pb)[2][8], const float (&pc)[2][8], void* xnew, h16* H) {
    float v[2][8]; float s2 = 0.f;
    if constexpr (HASY) {
        float ss = 0.f;
#pragma unroll
        for (int j = 0; j < 2; ++j) { h_unpack(R.y[j], v[j]);
#pragma unroll
            for (int e = 0; e < 8; ++e) ss += v[j][e] * v[j][e]; }
        const float rstd = rsqrtf(wave_sum(ss) * (1.f / D) + 1e-6f);
#pragma unroll
        for (int j = 0; j < 2; ++j) { float xo[8]; x_unpack(R.x, j, xo);
#pragma unroll
            for (int e = 0; e < 8; ++e) { v[j][e] = xo[e] + pa[j][e] * (v[j][e] * rstd); s2 += v[j][e] * v[j][e]; }
            const size_t off = (size_t)tok * D + j * 512 + lane * 8;
            if constexpr (XO) { pg8::u32x4 w; w.x = pg8::pk_f16(v[j][0], v[j][1]); w.y = pg8::pk_f16(v[j][2], v[j][3]); w.z = pg8::pk_f16(v[j][4], v[j][5]); w.w = pg8::pk_f16(v[j][6], v[j][7]); *(pg8::u32x4*)((h16*)xnew + off) = w; }
            else { *(pg8::f32x4*)((float*)xnew + off) = (pg8::f32x4){v[j][0], v[j][1], v[j][2], v[j][3]}; *(pg8::f32x4*)((float*)xnew + off + 4) = (pg8::f32x4){v[j][4], v[j][5], v[j][6], v[j][7]}; } }
    } else {
#pragma unroll
        for (int j = 0; j < 2; ++j) { x_unpack(R.x, j, v[j]);
#pragma unroll
            for (int e = 0; e < 8; ++e) s2 += v[j][e] * v[j][e]; }
    }
    if constexpr (HASH) {
        const float r2 = rsqrtf(wave_sum(s2) * (1.f / D) + 1e-6f);
#pragma unroll
        for (int j = 0; j < 2; ++j) { pg8::u32x4 w;
            w.x = pg8::pk_f16(v[j][0] * r2 * pb[j][0] + pc[j][0], v[j][1] * r2 * pb[j][1] + pc[j][1]); w.y = pg8::pk_f16(v[j][2] * r2 * pb[j][2] + pc[j][2], v[j][3] * r2 * pb[j][3] + pc[j][3]);
            w.z = pg8::pk_f16(v[j][4] * r2 * pb[j][4] + pc[j][4], v[j][5] * r2 * pb[j][5] + pc[j][5]); w.w = pg8::pk_f16(v[j][6] * r2 * pb[j][6] + pc[j][6], v[j][7] * r2 * pb[j][7] + pc[j][7]);
            *(pg8::u32x4*)(H + (size_t)tok * D + j * 512 + lane * 8) = w; }
    }
}
template <bool XI, bool XO, bool HASY, bool HASH, int G>
__device__ __forceinline__ void phase_post(const void* xold, const h16* y, const float* gpost, const float* modl, int gt_off, void* xnew,
                                           const float* gnext, const float* modn, int sh_off, int sc_off, h16* H) {
    int tid_ = threadIdx.x; asm volatile("" : "+v"(tid_)); const int lane = tid_ & 63, gw = blockIdx.x * 8 + (tid_ >> 6), NGW = gridDim.x * 8;
    constexpr int CH = 16;
    static_assert(S % CH == 0 && CH % (2 * G) == 0, "chunking");
    for (int ch = gw; ch < M / CH; ch += NGW) {
        const int tok0 = ch * CH, b = tok0 / S;
        float pa[2][8], pb[2][8], pc[2][8];
#pragma unroll
        for (int j = 0; j < 2; ++j) { const int cc = j * 512 + lane * 8;
#pragma unroll
            for (int hf = 0; hf < 2; ++hf) {
                if constexpr (HASY) { const pg8::f32x4 gp = *(const pg8::f32x4*)(gpost + cc + 4 * hf), gt = *(const pg8::f32x4*)(modl + (size_t)b * 6 * D + gt_off + cc + 4 * hf);
#pragma unroll
                    for (int e = 0; e < 4; ++e) pa[j][4 * hf + e] = gt[e] * gp[e]; }
                if constexpr (HASH) { const float* mn = modn + (size_t)b * 6 * D;
                    const pg8::f32x4 gg = *(const pg8::f32x4*)(gnext + cc + 4 * hf), sc = *(const pg8::f32x4*)(mn + sc_off + cc + 4 * hf), sh = *(const pg8::f32x4*)(mn + sh_off + cc + 4 * hf);
#pragma unroll
                    for (int e = 0; e < 4; ++e) { pb[j][4 * hf + e] = gg[e] * (1.f + sc[e]); pc[j][4 * hf + e] = sh[e]; } }
            } }
        PostRaw<XI, HASY> R0[G], R1[G];
#pragma unroll
        for (int t = 0; t < G; ++t) post_load<XI, HASY>(R0[t], xold, y, tok0 + t, lane);
#pragma unroll 1
        for (int g = 0; g < CH / G; g += 2) {
#pragma unroll
            for (int t = 0; t < G; ++t) post_load<XI, HASY>(R1[t], xold, y, tok0 + (g + 1) * G + t, lane);
#pragma unroll
            for (int t = 0; t < G; ++t) { post_row<XI, XO, HASY, HASH>(R0[t], tok0 + g * G + t, lane, pa, pb, pc, xnew, H); }
            if (g + 2 < CH / G) {
#pragma unroll
                for (int t = 0; t < G; ++t) post_load<XI, HASY>(R0[t], xold, y, tok0 + (g + 2) * G + t, lane); }
#pragma unroll
            for (int t = 0; t < G; ++t) { post_row<XI, XO, HASY, HASH>(R1[t], tok0 + (g + 1) * G + t, lane, pa, pb, pc, xnew, H); }
        }
    }
}

namespace nsa {
typedef _Float16 f16x8 __attribute__((ext_vector_type(8)));
typedef _Float16 f16x4 __attribute__((ext_vector_type(4)));
typedef float f32x4 __attribute__((ext_vector_type(4)));
typedef unsigned u32x4 __attribute__((ext_vector_type(4)));
typedef unsigned u32x2 __attribute__((ext_vector_type(2)));
constexpr int KP = 72;
constexpr int L_KT = 0, L_VT = 36864  , L_OF = 73728, L_IMPA = L_OF  , L_IMPB = L_OF + 64 * 65 * 4, L_MASK = L_OF + 65536, L_END = L_MASK + 512;
static_assert(2 * 64 * 65 * 4 <= 65536 && L_END <= 163840 - 64, "NSA LDS map");
constexpr float QSCALE = 0.125f * 1.4426950408889634f;

struct TileRegs { u32x4 k, v; };
__device__ __forceinline__ TileRegs tile_load(const h16* kbase, int kp, const h16* vbase, int vp, int tid) {
    TileRegs r;
    r.k = *(const u32x4*)(kbase + (size_t)(tid >> 3) * kp + 8 * (tid & 7));
    r.v = *(const u32x4*)(vbase + (size_t)(tid >> 3) * vp + 8 * (tid & 7));
    return r;
}
__device__ __forceinline__ void tile_store(LAS unsigned char* lds, int buf  , const TileRegs& r, int tid) {
    LAS h16* kt = (LAS h16*)(lds + L_KT) + buf * 64 * KP;
    *(LAS u32x4*)(kt + (tid >> 3) * KP + 8 * (tid & 7)) = r.k;
    LAS h16* vt = (LAS h16*)(lds + L_VT) + buf * 64 * KP;
    *(LAS u32x4*)(vt + (tid >> 3) * KP + 8 * (tid & 7)) = r.v;
}
__device__ __forceinline__ void tile_load_async(TileRegs& r, const h16* kbase, int kp, const h16* vbase, int vp, int tid) {
    const h16* ka = kbase + (size_t)(tid >> 3) * kp + 8 * (tid & 7); const h16* va = vbase + (size_t)(tid >> 3) * vp + 8 * (tid & 7);
    asm volatile("global_load_dwordx4 %0, %1, off" : "=v"(r.k) : "v"(ka) : "memory");
    asm volatile("global_load_dwordx4 %0, %1, off" : "=v"(r.v) : "v"(va) : "memory");
}
template <int N> __device__ __forceinline__ void tile_wait(TileRegs& r) {
    if (N == 2) asm volatile("s_waitcnt vmcnt(2)" : "+v"(r.k), "+v"(r.v) :: "memory"); else asm volatile("s_waitcnt vmcnt(0)" : "+v"(r.k), "+v"(r.v) :: "memory");
}
__device__ __forceinline__ float max_x16(float v) { return fmaxf(v, __shfl_xor(v, 16)); }
__device__ __forceinline__ float max_x32(float v) { return fmaxf(v, __shfl_xor(v, 32)); }
__device__ __forceinline__ float sum_x16(float v) { return v + __shfl_xor(v, 16); }
__device__ __forceinline__ float sum_x32(float v) { return v + __shfl_xor(v, 32); }
template <int CTRL> __device__ __forceinline__ float dpp_mv(float v) { return __builtin_bit_cast(float, __builtin_amdgcn_update_dpp(0, __builtin_bit_cast(int, v), CTRL, 0xF, 0xF, true)); }
__device__ __forceinline__ float sum_quad(float v) { v += __shfl_xor(v, 1); v += __shfl_xor(v, 2); return v; }
__device__ __forceinline__ f32x4 mfma16(f16x8 a, f16x8 b, f32x4 c) { return __builtin_amdgcn_mfma_f32_16x16x32_f16(a, b, c, 0, 0, 0); }

__device__ __forceinline__ void qk_tiles(const LAS h16* kt_lds, const f16x8 (&qf)[2][2], int c, int g, f32x4 (&sc)[2][4]) {
    f16x8 kf[4][2];
#pragma unroll
    for (int kt = 0; kt < 4; ++kt) { kf[kt][0] = *(const LAS f16x8*)(kt_lds + (16 * kt + c) * KP + 8 * g); kf[kt][1] = *(const LAS f16x8*)(kt_lds + (16 * kt + c) * KP + 32 + 8 * g); }
#pragma unroll
    for (int kt = 0; kt < 4; ++kt)
#pragma unroll
        for (int qi = 0; qi < 2; ++qi) { f32x4 a = {0.f, 0.f, 0.f, 0.f}; a = mfma16(kf[kt][0], qf[qi][0], a); a = mfma16(kf[kt][1], qf[qi][1], a); sc[qi][kt] = a; }
}
__device__ __forceinline__ void pv_tiles(const LAS h16* vt_lds, const f32x4 (&p)[2][4], int c, int g, f32x4 (&o)[4][2]) {
    f16x4 vlo[2][4], vhi[2][4];
#pragma unroll
    for (int kk = 0; kk < 2; ++kk)
#pragma unroll
        for (int dt = 0; dt < 4; ++dt) { vlo[kk][dt] = *(const LAS f16x4*)(vt_lds + (16 * dt + c) * KP + 32 * kk + 4 * g); vhi[kk][dt] = *(const LAS f16x4*)(vt_lds + (16 * dt + c) * KP + 32 * kk + 16 + 4 * g); }
#pragma unroll
    for (int kk = 0; kk < 2; ++kk) {
        f16x8 bf[2];
#pragma unroll
        for (int qi = 0; qi < 2; ++qi) { const f32x4 a = p[qi][2 * kk], b = p[qi][2 * kk + 1];
            bf[qi] = (f16x8){(_Float16)a[0], (_Float16)a[1], (_Float16)a[2], (_Float16)a[3], (_Float16)b[0], (_Float16)b[1], (_Float16)b[2], (_Float16)b[3]}; }
#pragma unroll
        for (int dt = 0; dt < 4; ++dt) {
            const f16x4 v0 = vlo[kk][dt], v1 = vhi[kk][dt];
            const f16x8 a = (f16x8){v0[0], v0[1], v0[2], v0[3], v1[0], v1[1], v1[2], v1[3]};
#pragma unroll
            for (int qi = 0; qi < 2; ++qi) o[dt][qi] = mfma16(a, bf[qi], o[dt][qi]);
        }
    }
}
__device__ __forceinline__ void apply_mask(f32x4 (&sc)[4], int mode, int lim) {
    if (mode == 1) {
#pragma unroll
        for (int kt = 0; kt < 4; ++kt)
#pragma unroll
            for (int r = 0; r < 4; ++r) sc[kt][r] = (16 * kt + r <= lim) ? sc[kt][r] : -1e30f;
    } else if (mode == 2) {
#pragma unroll
        for (int kt = 0; kt < 4; ++kt)
#pragma unroll
            for (int r = 0; r < 4; ++r) sc[kt][r] = (16 * kt + r > lim) ? sc[kt][r] : -1e30f;
    }
}
typedef float f32x2 __attribute__((ext_vector_type(2)));
__device__ __forceinline__ float max3f(float a, float b, float c) { float r; asm("v_max3_f32 %0, %1, %2, %3" : "=v"(r) : "v"(a), "v"(b), "v"(c)); return r; }
__device__ __forceinline__ void softmax_step(f32x4 (&sc)[4], bool row_on, float& m, float& l, float& f_out) {
    float mx = max3f(sc[0][0], sc[0][1], sc[0][2]);
    mx = max3f(mx, sc[0][3], sc[1][0]); mx = max3f(mx, sc[1][1], sc[1][2]); mx = max3f(mx, sc[1][3], sc[2][0]); mx = max3f(mx, sc[2][1], sc[2][2]);
    mx = max3f(mx, sc[2][3], sc[3][0]); mx = max3f(mx, sc[3][1], sc[3][2]); mx = fmaxf(mx, sc[3][3]);
    mx = row_on ? mx : -1e30f;
    mx = max_x16(mx); mx = max_x32(mx);
    const float mn = fmaxf(m, mx), f = __builtin_amdgcn_exp2f(m - mn), mu = row_on ? fmaxf(mn, -1e20f) : 1e30f;
    const f32x2 mu2 = {mu, mu};
    f32x2 sum2 = {0.f, 0.f};
#pragma unroll
    for (int kt = 0; kt < 4; ++kt) {
        f32x2 a = (f32x2){sc[kt][0], sc[kt][1]} - mu2, b = (f32x2){sc[kt][2], sc[kt][3]} - mu2;
        a.x = __builtin_amdgcn_exp2f(a.x); a.y = __builtin_amdgcn_exp2f(a.y); b.x = __builtin_amdgcn_exp2f(b.x); b.y = __builtin_amdgcn_exp2f(b.y);
        sc[kt] = (f32x4){a.x, a.y, b.x, b.y}; sum2 = sum2 + a; sum2 = sum2 + b;
    }
    l = l * f + (sum2.x + sum2.y); m = mn; f_out = f;
}

struct AttnArgs { const h16* QK32; const h16* P16; const h16* KC; const h16* VCT;   const h16* VTG;   const float* gate_b; const float* out_g; h16* O16; };

__device__ __forceinline__ void attn_item(const AttnArgs& A, int b, int qt, LAS unsigned char* lds) {
    int tid_ = threadIdx.x; asm volatile("" : "+v"(tid_)); const int tid = tid_, lane = tid & 63, w = tid >> 6, c = lane & 15, g = lane >> 4;
    const size_t tok0 = (size_t)b * S + 64 * qt;
    LAS float* impa = (LAS float*)(lds + L_IMPA); LAS float* impb = (LAS float*)(lds + L_IMPB);
    LAS unsigned char* maskb = lds + L_MASK;
    LAS f32x4* ofl = (LAS f32x4*)(lds + L_OF);
    const LAS h16* KT = (const LAS h16*)(lds + L_KT); const LAS h16* VT = (const LAS h16*)(lds + L_VT);
    int tl[2]; f16x8 qf[2][2];
    const int hh = c & 3;
#pragma unroll
    for (int qi = 0; qi < 2; ++qi) {
        tl[qi] = 8 * w + 4 * qi + (c >> 2);
        const h16* qp = A.QK32 + (tok0 + tl[qi]) * QKP + hh * 64 + 8 * g;
#pragma unroll
        for (int ks = 0; ks < 2; ++ks) qf[qi][ks] = *(const f16x8*)(qp + 32 * ks);
    }
    for (int i = tid; i < 64 * 65; i += 512) { impa[i] = 0.f; impb[i] = 0.f; }
    const int nblk_c = (4 * qt + 3 + 63) >> 6;
    int nvis[2];
#pragma unroll
    for (int qi = 0; qi < 2; ++qi) { const int s = 64 * qt + tl[qi]; nvis[qi] = (s >= 31) ? ((s - 31) / 16 + 1) : 0; }
    const h16* kcb = A.KC + (size_t)b * 256 * 64; const h16* vcb = A.VCT + (size_t)b * 64 * 256;
    float m_c[2] = {-1e30f, -1e30f}, l_c[2] = {0.f, 0.f};
    f32x4 ofin[4][2];
#pragma unroll
    for (int dt = 0; dt < 4; ++dt)
#pragma unroll
        for (int qi = 0; qi < 2; ++qi) ofin[dt][qi] = (f32x4){0.f, 0.f, 0.f, 0.f};
    float glog[2][3];
#pragma unroll
    for (int qi = 0; qi < 2; ++qi) { const h16* gp = A.P16 + (tok0 + tl[qi]) * PITCH + PC_GTS; glog[qi][0] = (float)gp[hh]; glog[qi][1] = (float)gp[4 + hh]; glog[qi][2] = (float)gp[8 + hh]; }
    {
        TileRegs r[4];
#pragma unroll
        for (int u = 0; u < 4; ++u) if (u < nblk_c) r[u] = tile_load(kcb + (size_t)u * 64 * 64, 64, vcb + u * 64, 256, tid);
#pragma unroll
        for (int u = 0; u < 4; ++u) if (u < nblk_c) tile_store(lds, u, r[u], tid);
    }
    __syncthreads();
#pragma unroll 1
    for (int pass = 0; pass < 2; ++pass) {
        float inv_l[2];
        if (pass == 1) {
#pragma unroll
            for (int qi = 0; qi < 2; ++qi) { float lt = l_c[qi]; lt = sum_x16(lt); lt = sum_x32(lt); inv_l[qi] = lt > 0.f ? 1.f / lt : 0.f; }
        }
#pragma unroll 1
        for (int blk = 0; blk < nblk_c; ++blk) {
            f32x4 sc[2][4];
            qk_tiles(KT + blk * 64 * KP, qf, c, g, sc);
#pragma unroll
            for (int qi = 0; qi < 2; ++qi) {
                apply_mask(sc[qi], 1, nvis[qi] - 1 - 64 * blk - 4 * g);
                if (pass == 0) { float f; softmax_step(sc[qi], true, m_c[qi], l_c[qi], f); }
                else {
                    const float mu = fmaxf(m_c[qi], -1e20f);
#pragma unroll
                    for (int kt = 0; kt < 4; ++kt) {
#pragma unroll
                        for (int r = 0; r < 4; ++r) sc[qi][kt][r] = __builtin_amdgcn_exp2f(sc[qi][kt][r] - mu) * inv_l[qi];
                        float e0 = (sc[qi][kt][0] + sc[qi][kt][1]) + (sc[qi][kt][2] + sc[qi][kt][3]), e1 = sc[qi][kt][3];
                        e0 = sum_quad(e0); e1 = sum_quad(e1);
                        const int jj = 16 * blk + 4 * kt + g;
                        if (hh == 0) { impa[tl[qi] * 65 + jj] = e0; if (jj + 1 < 64) impb[tl[qi] * 65 + jj + 1] = e1; }
                    }
                }
            }
            if (pass == 1) pv_tiles(VT + blk * 64 * KP, sc, c, g, ofin);
        }
    }
    __syncthreads();
    {
        const int t = tid >> 3, jg = tid & 7;
        unsigned long long key[8];
#pragma unroll
        for (int i = 0; i < 8; ++i) { const int j = 8 * jg + i; const float imp = impa[t * 65 + j] + impb[t * 65 + j];
            const bool forced = (j == 0) || (j == qt) || (j == qt - 1); const float scv = forced ? 1e9f : (j <= qt ? imp : -1e30f);
            const unsigned fb = __builtin_bit_cast(unsigned, scv), ob = (fb & 0x80000000u) ? ~fb : (fb | 0x80000000u);
            key[i] = ((unsigned long long)ob << 32) | (unsigned)(63 - j); }
        __syncthreads();
        LAS unsigned long long* keys = (LAS unsigned long long*)(lds + L_IMPA);
#pragma unroll
        for (int i = 0; i < 8; ++i) keys[t * 65 + 8 * jg + i] = key[i];
        __syncthreads();
        int rank[8];
#pragma unroll
        for (int i = 0; i < 8; ++i) rank[i] = 0;
        for (int j2 = 0; j2 < 64; ++j2) { const unsigned long long k2 = keys[t * 65 + j2];
#pragma unroll
            for (int i = 0; i < 8; ++i) rank[i] += (k2 > key[i]) ? 1 : 0; }
        unsigned bits = 0;
#pragma unroll
        for (int i = 0; i < 8; ++i) bits |= ((rank[i] < 16 && (8 * jg + i) <= qt) ? 1u : 0u) << i;
        maskb[t * 8 + jg] = (unsigned char)bits;
    }
    __syncthreads();
    unsigned mlo[2], mhi[2];
#pragma unroll
    for (int qi = 0; qi < 2; ++qi) { const LAS unsigned* mp = (const LAS unsigned*)(lds + L_MASK) + 2 * tl[qi]; mlo[qi] = mp[0]; mhi[qi] = mp[1]; }
    float gsel[2], gwin[2];
#pragma unroll
    for (int qi = 0; qi < 2; ++qi) {
        const float g0 = __builtin_amdgcn_rcpf(1.f + __expf(-(glog[qi][0] + A.gate_b[hh])));
        gsel[qi] = __builtin_amdgcn_rcpf(1.f + __expf(-(glog[qi][1] + A.gate_b[4 + hh])));
        gwin[qi] = __builtin_amdgcn_rcpf(1.f + __expf(-(glog[qi][2] + A.gate_b[8 + hh])));
#pragma unroll
        for (int dt = 0; dt < 4; ++dt) ofl[(dt * 2 + qi) * 512 + tid] = ofin[dt][qi] * g0;
    }
    const h16* Pb = A.P16 + (size_t)b * S * PITCH;
    const int jw0 = qt >= 8 ? qt - 8 : 0;
#pragma unroll 1
    for (int br = 0; br < 2; ++br) {
        const bool win = br == 1;
        const int j0 = win ? jw0 : 0, nsteps = qt - j0 + 1, kcol = win ? PC_KW : PC_KS;
        const h16* Vb = A.VTG + ((size_t)b * 2 + br) * 64 * S;
        float m_b[2] = {-1e30f, -1e30f}, l_b[2] = {0.f, 0.f};
        f32x4 o_b[4][2];
#pragma unroll
        for (int dt = 0; dt < 4; ++dt)
#pragma unroll
            for (int qi = 0; qi < 2; ++qi) o_b[dt][qi] = (f32x4){0.f, 0.f, 0.f, 0.f};
        TileRegs R[4];
#define NSA_LOADG(G0) do { _Pragma("unroll") for (int u = 0; u < 4; ++u) if ((G0) + u < nsteps) R[u] = tile_load(Pb + (size_t)(j0 + (G0) + u) * 64 * PITCH + kcol, PITCH, Vb + 64 * (j0 + (G0) + u), S, tid); } while (0)
#define NSA_STOREG(G0) do { _Pragma("unroll") for (int u = 0; u < 4; ++u) if ((G0) + u < nsteps) tile_store(lds, u, R[u], tid); } while (0)
        NSA_LOADG(0); NSA_STOREG(0);
        __syncthreads();
#pragma unroll 1
        for (int g0 = 0; g0 < nsteps; g0 += 4) {
            NSA_LOADG(g0 + 4);
#pragma unroll
            for (int u = 0; u < 4; ++u) {
                if (g0 + u < nsteps) {
                    const int jb = j0 + g0 + u;
                    f32x4 sc[2][4];
                    qk_tiles(KT + u * 64 * KP, qf, c, g, sc);
                    const int mode = (jb == qt) ? 1 : ((win && jb == qt - 8) ? 2 : 0);
#pragma unroll
                    for (int qi = 0; qi < 2; ++qi) {
                        const bool selb = win ? true : ((jb < 32) ? ((mlo[qi] >> jb) & 1u) : ((mhi[qi] >> (jb - 32)) & 1u));
                        apply_mask(sc[qi], mode, tl[qi] - 4 * g);
                        float f;
                        softmax_step(sc[qi], selb, m_b[qi], l_b[qi], f);
                        if (__any(f != 1.f)) {
#pragma unroll
                            for (int dt = 0; dt < 4; ++dt) o_b[dt][qi] = o_b[dt][qi] * f; }
                    }
                    pv_tiles(VT + u * 64 * KP, sc, c, g, o_b);
                }
            }
            __syncthreads();
            if (g0 + 4 < nsteps) { NSA_STOREG(g0 + 4); __syncthreads(); }
        }
#undef NSA_LOADG
#undef NSA_STOREG
#pragma unroll
        for (int qi = 0; qi < 2; ++qi) {
            float lb = l_b[qi]; lb = sum_x16(lb); lb = sum_x32(lb);
            const float cb = (win ? gwin[qi] : gsel[qi]) / lb;
#pragma unroll
            for (int dt = 0; dt < 4; ++dt) ofl[(dt * 2 + qi) * 512 + tid] = ofl[(dt * 2 + qi) * 512 + tid] + o_b[dt][qi] * cb;
        }
    }
#pragma unroll
    for (int qi = 0; qi < 2; ++qi) {
        float ss = 0.f;
#pragma unroll
        for (int dt = 0; dt < 4; ++dt) ofin[dt][qi] = ofl[(dt * 2 + qi) * 512 + tid];
#pragma unroll
        for (int dt = 0; dt < 4; ++dt)
            ss += (ofin[dt][qi][0] * ofin[dt][qi][0] + ofin[dt][qi][1] * ofin[dt][qi][1]) + (ofin[dt][qi][2] * ofin[dt][qi][2] + ofin[dt][qi][3] * ofin[dt][qi][3]);
        ss = sum_x16(ss); ss = sum_x32(ss); ss = sum_quad(ss);
        const float rstd = rsqrtf(ss * (1.f / 256.f) + 1e-6f);
        h16* op = A.O16 + (tok0 + tl[qi]) * D + hh * 64;
#pragma unroll
        for (int dt = 0; dt < 4; ++dt) { const int d0 = 16 * dt + 4 * g; const f32x4 gg = *(const f32x4*)(A.out_g + hh * 64 + d0);
            u32x2 wv; wv.x = pg8::pk_f16(ofin[dt][qi][0] * rstd * gg[0], ofin[dt][qi][1] * rstd * gg[1]); wv.y = pg8::pk_f16(ofin[dt][qi][2] * rstd * gg[2], ofin[dt][qi][3] * rstd * gg[3]);
            *(u32x2*)(op + d0) = wv; }
    }
    __syncthreads();
}

struct CmpArgs { const h16* QK32; const h16* P16; const h16* W1T;   const float* bias;   const float* w2k; const float* w2v; h16* KC; h16* VC; };
constexpr int TP = 72;
__device__ __forceinline__ void compress_item(const CmpArgs& A, int b, int kv, int ng, LAS unsigned char* lds) {
    int tid_ = threadIdx.x; asm volatile("" : "+v"(tid_)); const int tid = tid_, lane = tid & 63, w = tid >> 6, c = lane & 15, g = lane >> 4;
    LAS h16* TOK = (LAS h16*)lds;
    LAS float* RED = (LAS float*)(lds + 272 * TP * 2);
    LAS float* HID = RED + 2 * 16 * 64;
    const int t0 = 256 * ng;
    for (int e = tid; e < 272 * 8; e += 512) {
        const int t = e >> 3, ch = e & 7; const int tok = t0 + t;
        u32x4 v = {0u, 0u, 0u, 0u};
        if (tok < S) {
            if (kv == 0) v = *(const u32x4*)(A.QK32 + ((size_t)b * S + tok) * QKP + 256 + 8 * ch);
            else v = *(const u32x4*)(A.P16 + ((size_t)b * S + tok) * PITCH + PC_VC + 8 * ch);
        }
        *(LAS u32x4*)(TOK + t * TP + 8 * ch) = v;
    }
    __syncthreads();
    {
        const int nt = w & 3, kh = w >> 2;
        const h16* wb = A.W1T + ((size_t)kv * 64 + 16 * nt + c) * 2048 + 8 * g;
        f32x4 acc = {0.f, 0.f, 0.f, 0.f};
#pragma unroll 1
        for (int k8 = 32 * kh; k8 < 32 * kh + 32; k8 += 8) {
            f16x8 bw[8];
#pragma unroll
            for (int u = 0; u < 8; ++u) bw[u] = *(const f16x8*)(wb + 32 * (k8 + u));
#pragma unroll
            for (int u = 0; u < 8; ++u) { const int ks = k8 + u;
                const f16x8 a = *(const LAS f16x8*)(TOK + (16 * c + (ks >> 1)) * TP + 32 * (ks & 1) + 8 * g);
                acc = mfma16(a, bw[u], acc); }
        }
#pragma unroll
        for (int r = 0; r < 4; ++r) RED[(kh * 16 + 4 * g + r) * 64 + 16 * nt + c] = acc[r];
    }
    __syncthreads();
    for (int e = tid; e < 1024; e += 512) { const int n = e >> 6, j = e & 63; const float x = RED[n * 64 + j] + RED[(16 + n) * 64 + j] + A.bias[kv * 64 + j];
        HID[n * 64 + j] = 0.5f * x * (1.f + tanhf(0.7978845608028654f * (x + 0.044715f * x * x * x))); }
    __syncthreads();
    const float* w2 = kv == 0 ? A.w2k : A.w2v; h16* outp = kv == 0 ? A.KC : A.VC;
    for (int e = tid; e < 1024; e += 512) { const int n = e >> 6, j = e & 63; float s = 0.f;
        for (int i = 0; i < 64; ++i) s += HID[n * 64 + i] * w2[i * 64 + j];
        const int nn = 16 * ng + n;
        const h16 ov = (nn < NCMP) ? (h16)s : (h16)0.f;
        if (kv == 0) outp[((size_t)b * 256 + nn) * 64 + j] = ov; else outp[((size_t)b * 64 + j) * 256 + nn] = ov; }
    __syncthreads();
}
}
namespace mls {
using nsa::f16x8; using nsa::f32x4; using nsa::u32x4; using nsa::u32x2; using nsa::mfma16;
constexpr int KP = 72;
#define LDS_BAR() do { asm volatile("s_waitcnt lgkmcnt(0)" ::: "memory"); __builtin_amdgcn_s_barrier(); asm volatile("" ::: "memory"); } while (0)
constexpr size_t WS_KVB = WS_Y32;
constexpr size_t WS_KSUM = WS_Y32 + 48 * MiB;
constexpr size_t WS_MUB = WS_KSUM + 1 * MiB;
constexpr size_t WS_GT = 505 * MiB;
struct Args { const h16* P16; const float *conv_w, *conv_b, *ig_b, *fg_b, *norm_g; float* KVB; float* KSUM; float* MUB; h16* O16; float* GT; const h16* CW16; };

__device__ __forceinline__ void mm64(const LAS h16* A, const LAS h16* Bt, int w, int c, int g, f32x4 (&acc)[2]) {
    const int mi = w >> 1;
    const f16x8 a0 = *(const LAS f16x8*)(A + (16 * mi + c) * KP + 8 * g), a1 = *(const LAS f16x8*)(A + (16 * mi + c) * KP + 32 + 8 * g);
#pragma unroll
    for (int n = 0; n < 2; ++n) { const int ni = 2 * (w & 1) + n;
        const f16x8 b0 = *(const LAS f16x8*)(Bt + (16 * ni + c) * KP + 8 * g), b1 = *(const LAS f16x8*)(Bt + (16 * ni + c) * KP + 32 + 8 * g);
        acc[n] = mfma16(a0, b0, acc[n]); acc[n] = mfma16(a1, b1, acc[n]); }
}
__device__ __forceinline__ float half_lo(unsigned u) { return (float)__builtin_bit_cast(_Float16, (unsigned short)(u & 0xffffu)); }
__device__ __forceinline__ float half_hi(unsigned u) { return (float)__builtin_bit_cast(_Float16, (unsigned short)(u >> 16)); }
struct ConvTaps { u32x4 x[4]; };
__device__ __forceinline__ void conv_load(ConvTaps& T, const h16* Pbatch, int tloc, int col) {
#pragma unroll
    for (int i = 0; i < 4; ++i) { const int tt = tloc - 3 + i; T.x[i] = (u32x4){0u, 0u, 0u, 0u}; if (tt >= 0) T.x[i] = *(const u32x4*)(Pbatch + (size_t)tt * PITCH + col); }
}
typedef _Float16 h16x2 __attribute__((ext_vector_type(2)));
__device__ __forceinline__ void conv_apply(const ConvTaps& T, const h16* cw16, float scale, float (&out)[8]) {
    float acc[8];
    { const u32x4 bw = *(const u32x4*)(cw16 + 4 * 768); acc[0] = half_lo(bw.x); acc[1] = half_hi(bw.x); acc[2] = half_lo(bw.y); acc[3] = half_hi(bw.y); acc[4] = half_lo(bw.z); acc[5] = half_hi(bw.z); acc[6] = half_lo(bw.w); acc[7] = half_hi(bw.w); }
#pragma unroll
    for (int i = 0; i < 4; ++i) { const u32x4 x = T.x[i], wv = *(const u32x4*)(cw16 + i * 768);
        acc[0] += half_lo(x.x) * half_lo(wv.x); acc[1] += half_hi(x.x) * half_hi(wv.x); acc[2] += half_lo(x.y) * half_lo(wv.y); acc[3] += half_hi(x.y) * half_hi(wv.y);
        acc[4] += half_lo(x.z) * half_lo(wv.z); acc[5] += half_hi(x.z) * half_hi(wv.z); acc[6] += half_lo(x.w) * half_lo(wv.w); acc[7] += half_hi(x.w) * half_hi(wv.w); }
#pragma unroll
    for (int e = 0; e < 8; ++e) out[e] = acc[e] * __builtin_amdgcn_rcpf(1.f + __expf(-acc[e])) * scale;
}
__device__ __forceinline__ void conv8(const h16* Pbatch, int tloc, int col, const h16* cw16, float scale, float (&out)[8]) {
    ConvTaps T; conv_load(T, Pbatch, tloc, col); conv_apply(T, cw16, scale, out);
}
__device__ __forceinline__ float log_sigmoid(float x) { return fminf(x, 0.f) - log1pf(__expf(-fabsf(x))); }

__device__ __forceinline__ void m1_item(const Args& A, int bh, int ck, LAS unsigned char* lds) {
    int tid_ = threadIdx.x; asm volatile("" : "+v"(tid_)); const int tid = tid_, lane = tid & 63, w = tid >> 6, c = lane & 15, g = lane >> 4;
    const int b = bh / H_ML, h = bh % H_ML;
    LAS h16* KT2 = (LAS h16*)lds;
    LAS h16* WVT = KT2 + 64 * KP;
    LAS float* WGT = (LAS float*)(lds + 2 * 64 * KP * 2);
    const h16* Pb = A.P16 + (size_t)b * S * PITCH;
    const int tloc = 64 * ck + lane;
    if (w == 0) {
        const h16* pr = Pb + (size_t)tloc * PITCH;
        const float li = (float)pr[PC_IG + h] + A.ig_b[h];
        const float lf = log_sigmoid((float)pr[PC_FG + h] + A.fg_b[h]);
        float bs = lf;
#pragma unroll
        for (int o = 1; o < 64; o <<= 1) { const float t = __shfl_up(bs, o); if (lane >= o) bs += t; }
        const float gt = __shfl(bs, 63);
        const float u = gt - bs + li;
        const float mu = wave_max(u);
        WGT[lane] = __expf(u - mu);
        if (lane == 0) { A.MUB[bh * 64 + ck] = mu; A.MUB[3072 + bh * 64 + ck] = gt; }
        const float as = li - bs; float pm = as;
#pragma unroll
        for (int o = 1; o < 64; o <<= 1) { const float t = __shfl_up(pm, o); if (lane >= o) pm = fmaxf(pm, t); }
        float* gto = A.GT + ((size_t)bh * 64 + ck) * 192; gto[lane] = bs; gto[64 + lane] = as; gto[128 + lane] = pm;
    }
    float kc[8];
    conv8(Pb, tloc, PC_MK + h * 64 + 8 * w, A.CW16 + 384 + h * 64 + 8 * w, 0.125f, kc);
    LDS_BAR();
    const float wg = WGT[lane];
    const u32x4 vv = *(const u32x4*)(Pb + (size_t)tloc * PITCH + PC_MV + h * 64 + 8 * w);
    const float v8[8] = {half_lo(vv.x), half_hi(vv.x), half_lo(vv.y), half_hi(vv.y), half_lo(vv.z), half_hi(vv.z), half_lo(vv.w), half_hi(vv.w)};
#pragma unroll
    for (int e = 0; e < 8; ++e) { KT2[(8 * w + e) * KP + lane] = (h16)kc[e]; WVT[(8 * w + e) * KP + lane] = (h16)(v8[e] * wg); }
    LDS_BAR();
    f32x4 acc[2] = {{0.f, 0.f, 0.f, 0.f}, {0.f, 0.f, 0.f, 0.f}};
    mm64(WVT, KT2, w, c, g, acc);
    float* kvo = A.KVB + ((size_t)bh * 64 + ck) * 4096;
#pragma unroll
    for (int n = 0; n < 2; ++n)
#pragma unroll
        for (int r = 0; r < 4; ++r) kvo[(16 * (w >> 1) + 4 * g + r) * 64 + 16 * (2 * (w & 1) + n) + c] = acc[n][r];
    if (w == 1) { float s = 0.f;
        for (int t = 0; t < 64; ++t) s += (float)KT2[lane * KP + t] * WGT[t];
        A.KSUM[((size_t)bh * 64 + ck) * 64 + lane] = s; }
    LDS_BAR();
}

__device__ __forceinline__ void m2_item(const Args& A, int bh, int qr) {
    int tid_ = threadIdx.x; asm volatile("" : "+v"(tid_)); const int tid = tid_;
    float* kv = A.KVB + (size_t)bh * 64 * 4096 + qr * 1024 + tid;
    float* ks = A.KSUM + (size_t)bh * 64 * 64 + tid;
    const bool don = (qr == 0 && tid < 64);
    float C0 = 0.f, C1 = 0.f, n = 0.f, m = 0.f;
#pragma unroll 1
    for (int c8 = 0; c8 < 64; c8 += 8) {
        float x0[8], x1[8], xn[8], mu[8], gt[8];
#pragma unroll
        for (int u = 0; u < 8; ++u) { x0[u] = kv[(size_t)(c8 + u) * 4096]; x1[u] = kv[(size_t)(c8 + u) * 4096 + 512]; xn[u] = don ? ks[(c8 + u) * 64] : 0.f;
            mu[u] = A.MUB[bh * 64 + c8 + u]; gt[u] = A.MUB[3072 + bh * 64 + c8 + u]; }
#pragma unroll
        for (int u = 0; u < 8; ++u) { const int ck = c8 + u;
            const float mn = fmaxf(gt[u] + m, mu[u]), dec = __expf(gt[u] + m - mn), wl = __expf(mu[u] - mn);
            kv[(size_t)ck * 4096] = C0; kv[(size_t)ck * 4096 + 512] = C1;
            if (don) ks[ck * 64] = n;
            if (qr == 0 && tid == 0) A.MUB[2 * 3072 + bh * 64 + ck] = m;
            C0 = dec * C0 + wl * x0[u]; C1 = dec * C1 + wl * x1[u]; n = dec * n + wl * xn[u]; m = mn; }
    }
}

struct M3Regs { ConvTaps q, k; u32x4 v, og; f32x4 c0, c1; float bs, as, pm, n0, m0; };
__device__ __forceinline__ void m3_load(M3Regs& R, const Args& A, int item, int tid) {
    const int bh = item >> 6, ck = item & 63, b = bh / H_ML, h = bh % H_ML, lane = tid & 63, w = tid >> 6;
    const h16* Pb = A.P16 + (size_t)b * S * PITCH; const int tloc = 64 * ck + lane;
    conv_load(R.q, Pb, tloc, PC_MQ + h * 64 + 8 * w); conv_load(R.k, Pb, tloc, PC_MK + h * 64 + 8 * w);
    R.v = *(const u32x4*)(Pb + (size_t)tloc * PITCH + PC_MV + h * 64 + 8 * w);
    const float* cp = A.KVB + ((size_t)bh * 64 + ck) * 4096 + (tid >> 3) * 64 + 8 * (tid & 7);
    R.c0 = *(const f32x4*)cp; R.c1 = *(const f32x4*)(cp + 4);
    R.og = *(const u32x4*)(A.P16 + ((size_t)b * S + 64 * ck + (tid >> 3)) * PITCH + PC_MO + h * 64 + 8 * (tid & 7));
    const float* gti = A.GT + ((size_t)bh * 64 + ck) * 192; R.bs = gti[lane]; R.as = gti[64 + lane]; R.pm = gti[128 + lane];
    R.n0 = A.KSUM[((size_t)bh * 64 + ck) * 64 + lane]; R.m0 = A.MUB[2 * 3072 + bh * 64 + ck];
}
__device__ __forceinline__ void m3_item(const Args& A, int item, int next_item, M3Regs& R, LAS unsigned char* lds) {
    int tid_ = threadIdx.x; asm volatile("" : "+v"(tid_)); const int tid = tid_, lane = tid & 63, w = tid >> 6, c = lane & 15, g = lane >> 4;
    const int bh = item >> 6, ck = item & 63, b = bh / H_ML, h = bh % H_ML;
    LAS h16* Q16 = (LAS h16*)lds;
    LAS h16* K16 = Q16 + 64 * KP;
    LAS h16* VT2 = K16 + 64 * KP;
    LAS h16* C016 = VT2 + 64 * KP;
    LAS h16* SM16 = C016 + 64 * KP;
    LAS float* HV = (LAS float*)(lds + 5 * 64 * KP * 2);
    LAS float* BJ = HV + 64 * 65; LAS float* AS = BJ + 64; LAS float* MJ = AS + 64; LAS float* WI = MJ + 64; LAS float* N0 = WI + 64; LAS float* DEN = N0 + 64;
    const float m0 = R.m0;
    if (w == 0) {
        const float bs = R.bs, mj = bs + fmaxf(m0, R.pm);
        BJ[lane] = bs; AS[lane] = R.as; MJ[lane] = mj; WI[lane] = __expf(bs + m0 - mj);
        N0[lane] = R.n0;
    }
    u32x4 og;
    {   float q8[8], k8[8];
        conv_apply(R.q, A.CW16 + h * 64 + 8 * w, 1.f, q8);
        conv_apply(R.k, A.CW16 + 384 + h * 64 + 8 * w, 0.125f, k8);
        u32x4 qo, ko;
        qo.x = pg8::pk_f16(q8[0], q8[1]); qo.y = pg8::pk_f16(q8[2], q8[3]); qo.z = pg8::pk_f16(q8[4], q8[5]); qo.w = pg8::pk_f16(q8[6], q8[7]);
        ko.x = pg8::pk_f16(k8[0], k8[1]); ko.y = pg8::pk_f16(k8[2], k8[3]); ko.z = pg8::pk_f16(k8[4], k8[5]); ko.w = pg8::pk_f16(k8[6], k8[7]);
        *(LAS u32x4*)(Q16 + lane * KP + 8 * w) = qo; *(LAS u32x4*)(K16 + lane * KP + 8 * w) = ko;
        const u32x4 vv = R.v;
        LAS unsigned short* vt = (LAS unsigned short*)VT2 + (8 * w) * KP + lane;
        vt[0 * KP] = (unsigned short)(vv.x & 0xffffu); vt[1 * KP] = (unsigned short)(vv.x >> 16); vt[2 * KP] = (unsigned short)(vv.y & 0xffffu); vt[3 * KP] = (unsigned short)(vv.y >> 16);
        vt[4 * KP] = (unsigned short)(vv.z & 0xffffu); vt[5 * KP] = (unsigned short)(vv.z >> 16); vt[6 * KP] = (unsigned short)(vv.w & 0xffffu); vt[7 * KP] = (unsigned short)(vv.w >> 16);
        const f32x4 c0 = R.c0, c1 = R.c1;
        u32x4 co; co.x = pg8::pk_f16(c0[0], c0[1]); co.y = pg8::pk_f16(c0[2], c0[3]); co.z = pg8::pk_f16(c1[0], c1[1]); co.w = pg8::pk_f16(c1[2], c1[3]);
        *(LAS u32x4*)(C016 + (tid >> 3) * KP + 8 * (tid & 7)) = co;
        og = R.og;
    }
    if (next_item >= 0) m3_load(R, A, next_item, tid);
    LDS_BAR();
    {
        f32x4 acc[2] = {{0.f, 0.f, 0.f, 0.f}, {0.f, 0.f, 0.f, 0.f}};
        mm64(Q16, K16, w, c, g, acc);
#pragma unroll
        for (int n = 0; n < 2; ++n)
#pragma unroll
            for (int r = 0; r < 4; ++r) { const int j = 16 * (w >> 1) + 4 * g + r, s = 16 * (2 * (w & 1) + n) + c;
                const float v = (s <= j) ? __expf(BJ[j] + AS[s] - MJ[j]) * acc[n][r] : 0.f;
                SM16[j * KP + s] = (h16)v; }
    }
    LDS_BAR();
    {
        const int j = tid >> 3, sg = tid & 7; float rs = 0.f, nq = 0.f;
#pragma unroll
        for (int e = 0; e < 8; ++e) { rs += (float)SM16[j * KP + 8 * sg + e]; nq += (float)Q16[j * KP + 8 * sg + e] * N0[8 * sg + e]; }
        rs += __shfl_xor(rs, 1); rs += __shfl_xor(rs, 2); rs += __shfl_xor(rs, 4);
        nq += __shfl_xor(nq, 1); nq += __shfl_xor(nq, 2); nq += __shfl_xor(nq, 4);
        if (sg == 0) DEN[j] = fmaxf(fabsf(WI[j] * nq + rs), __expf(-MJ[j]));
    }
    f32x4 a1[2] = {{0.f, 0.f, 0.f, 0.f}, {0.f, 0.f, 0.f, 0.f}}, a2[2] = {{0.f, 0.f, 0.f, 0.f}, {0.f, 0.f, 0.f, 0.f}};
    mm64(Q16, C016, w, c, g, a1);
    mm64(SM16, VT2, w, c, g, a2);
    LDS_BAR();
#pragma unroll
    for (int n = 0; n < 2; ++n)
#pragma unroll
        for (int r = 0; r < 4; ++r) { const int j = 16 * (w >> 1) + 4 * g + r, d = 16 * (2 * (w & 1) + n) + c;
            HV[j * 65 + d] = (WI[j] * a1[n][r] + a2[n][r]) * __builtin_amdgcn_rcpf(DEN[j]); }
    LDS_BAR();
    {   const int j = tid >> 3, sg = tid & 7; float hv[8], ss = 0.f;
#pragma unroll
        for (int e = 0; e < 8; ++e) { hv[e] = HV[j * 65 + 8 * sg + e]; ss += hv[e] * hv[e]; }
        ss += __shfl_xor(ss, 1); ss += __shfl_xor(ss, 2); ss += __shfl_xor(ss, 4);
        const float rstd = rsqrtf(ss * (1.f / 64.f) + 1e-6f);
        const size_t tok = (size_t)b * S + 64 * ck + j;
        const float o8[8] = {half_lo(og.x), half_hi(og.x), half_lo(og.y), half_hi(og.y), half_lo(og.z), half_hi(og.z), half_lo(og.w), half_hi(og.w)};
        const float* ng = A.norm_g + h * 64 + 8 * sg;
        float r8[8];
#pragma unroll
        for (int e = 0; e < 8; ++e) r8[e] = hv[e] * rstd * ng[e] * __builtin_amdgcn_rcpf(1.f + __expf(-o8[e]));
        u32x4 ov; ov.x = pg8::pk_f16(r8[0], r8[1]); ov.y = pg8::pk_f16(r8[2], r8[3]); ov.z = pg8::pk_f16(r8[4], r8[5]); ov.w = pg8::pk_f16(r8[6], r8[7]);
        *(u32x4*)(A.O16 + tok * D + C_ATT + C_RW + h * 64 + 8 * sg) = ov;
    }
    LDS_BAR();
}
}
namespace rwk {
using nsa::f16x8; using nsa::f16x4; using nsa::f32x4; using nsa::u32x4; using nsa::u32x2; using nsa::mfma16;
constexpr size_t WS_WE = 364 * MiB, WS_AA = 388 * MiB, WS_GG = 412 * MiB;
constexpr size_t WS_LRW = WS_LRW0; constexpr int LRW_L = LRW_L0;
__device__ __forceinline__ f32x4 mfma16k16(f16x4 a, f16x4 b, f32x4 c) { return __builtin_amdgcn_mfma_f32_16x16x16f16(a, b, c, 0, 0, 0); }
template <int CTRL> __device__ __forceinline__ float dpp_mov(float v) { return __builtin_bit_cast(float, __builtin_amdgcn_update_dpp(0, __builtin_bit_cast(int, v), CTRL, 0xF, 0xF, true)); }
__device__ __forceinline__ float wave_sum_fast(float v) {
    v += dpp_mov<0xB1>(v); v += dpp_mov<0x4E>(v); v += dpp_mov<0x141>(v); v += dpp_mov<0x140>(v);
    const int iv = __builtin_bit_cast(int, v);
    return (__builtin_bit_cast(float, __builtin_amdgcn_readlane(iv, 0)) + __builtin_bit_cast(float, __builtin_amdgcn_readlane(iv, 16))) +
           (__builtin_bit_cast(float, __builtin_amdgcn_readlane(iv, 32)) + __builtin_bit_cast(float, __builtin_amdgcn_readlane(iv, 48)));
}
__device__ __forceinline__ float hlo(unsigned u) { return (float)__builtin_bit_cast(_Float16, (unsigned short)(u & 0xffffu)); }
__device__ __forceinline__ float hhi(unsigned u) { return (float)__builtin_bit_cast(_Float16, (unsigned short)(u >> 16)); }

template <int MAT> __device__ __forceinline__ void prep_mat(const LAS h16* X, LAS h16* OT, const h16* WT, const float* biasp, h16* outp, int tile, int w, int c, int g) {
        constexpr int K = (MAT == 2) ? 128 : 64, xp = (MAT == 2) ? 136 : 72;


        f32x4 acc[3][4];
#pragma unroll
        for (int nt = 0; nt < 3; ++nt)
#pragma unroll
            for (int mt = 0; mt < 4; ++mt) acc[nt][mt] = (f32x4){0.f, 0.f, 0.f, 0.f};
        f16x8 af[K / 32][3];
#pragma unroll
        for (int ks = 0; ks < K / 32; ++ks)
#pragma unroll
            for (int nt = 0; nt < 3; ++nt) af[ks][nt] = *(const f16x8*)(WT + (size_t)(48 * w + 16 * nt + c) * K + 32 * ks + 8 * g);
#pragma unroll
        for (int ks = 0; ks < K / 32; ++ks) {
            f16x8 bf[4];
#pragma unroll
            for (int mt = 0; mt < 4; ++mt) bf[mt] = *(const LAS f16x8*)(X + (16 * mt + c) * xp + 32 * ks + 8 * g);
#pragma unroll
            for (int nt = 0; nt < 3; ++nt)
#pragma unroll
                for (int mt = 0; mt < 4; ++mt) acc[nt][mt] = mfma16(af[ks][nt], bf[mt], acc[nt][mt]);
        }

#pragma unroll
        for (int nt = 0; nt < 3; ++nt) { const int ch = 48 * w + 16 * nt + 4 * g;
            f32x4 bias = {0.f, 0.f, 0.f, 0.f}; if (MAT == 0) bias = *(const f32x4*)(biasp + ch); else if (MAT == 1) bias = *(const f32x4*)(biasp + ch);
#pragma unroll
            for (int mt = 0; mt < 4; ++mt) { float o[4];
#pragma unroll
                for (int r = 0; r < 4; ++r) { const float x = acc[nt][mt][r] + bias[r];
                    if (MAT == 0) { const float sp = fmaxf(-x, 0.f) + __logf(1.f + __expf(-fabsf(x))); o[r] = __expf(-sp - 0.5f); }
                    else if (MAT == 1) o[r] = __builtin_amdgcn_rcpf(1.f + __expf(-x)); else o[r] = x; }
                u32x2 ov; ov.x = pg8::pk_f16(o[0], o[1]); ov.y = pg8::pk_f16(o[2], o[3]);
                *(LAS u32x2*)(OT + (16 * mt + c) * 392 + ch) = ov; }
        }
        __syncthreads();
        {
            int tid2_ = threadIdx.x; asm volatile("" : "+v"(tid2_));
#pragma unroll
            for (int k = 0; k < 6; ++k) { const int e = tid2_ + 512 * k, row = e / 48, cc = e % 48;
                *(u32x4*)(outp + ((size_t)tile * 64 + row) * C_RW + 8 * cc) = *(const LAS u32x4*)(OT + row * 392 + 8 * cc); }
        }
        __syncthreads();
}
constexpr size_t WS_RN = 363 * MiB + 128 * 1024;
struct PrepArgs { const h16* P16; const float *mu, *w0, *a0, *kkp; const h16* LRW; h16 *WE, *AA, *GG; float* RN; };
__device__ __forceinline__ void prep_item(const PrepArgs& A, int tile, LAS unsigned char* lds) {
    int tid_ = threadIdx.x; asm volatile("" : "+v"(tid_)); const int tid = tid_, lane = tid & 63, w = tid >> 6, c = lane & 15, g = lane >> 4;
    LAS h16* XW = (LAS h16*)lds;
    LAS h16* XA = XW + 64 * 72;
    LAS h16* XG = XA + 64 * 72;
    {
        const int tk = tid >> 3, part = tid & 7; const size_t tok = (size_t)tile * 64 + tk; const bool hasp = (tok % S) != 0;
        const h16* pc = A.P16 + tok * PITCH; const h16* pp = pc - PITCH;
#pragma unroll
        for (int q = 0; q < 4; ++q) {
            const int col = (q == 0) ? PC_XW + 8 * part : (q == 1) ? PC_XA + 8 * part : PC_XG + 64 * (q - 2) + 8 * part;
            const int mcol = (q == 0) ? 1152 + 8 * part : (q == 1) ? 1216 + 8 * part : 1280 + 64 * (q - 2) + 8 * part;
            const u32x4 xc = *(const u32x4*)(pc + col); u32x4 xp = {0u, 0u, 0u, 0u}; if (hasp) xp = *(const u32x4*)(pp + col);
            const float cv[8] = {hlo(xc.x), hhi(xc.x), hlo(xc.y), hhi(xc.y), hlo(xc.z), hhi(xc.z), hlo(xc.w), hhi(xc.w)};
            const float pv[8] = {hlo(xp.x), hhi(xp.x), hlo(xp.y), hhi(xp.y), hlo(xp.z), hhi(xp.z), hlo(xp.w), hhi(xp.w)};
            float o[8];
#pragma unroll
            for (int e = 0; e < 8; ++e) { const float x = cv[e] + A.mu[mcol + e] * (pv[e] - cv[e]);
                o[e] = (q == 0) ? (1.f - 2.f * __builtin_amdgcn_rcpf(1.f + __expf(2.f * x))) : (q == 1) ? x : __builtin_amdgcn_rcpf(1.f + __expf(-x)); }
            u32x4 ov; ov.x = pg8::pk_f16(o[0], o[1]); ov.y = pg8::pk_f16(o[2], o[3]); ov.z = pg8::pk_f16(o[4], o[5]); ov.w = pg8::pk_f16(o[6], o[7]);
            if (q == 0) *(LAS u32x4*)(XW + tk * 72 + 8 * part) = ov; else if (q == 1) *(LAS u32x4*)(XA + tk * 72 + 8 * part) = ov; else *(LAS u32x4*)(XG + tk * 136 + 64 * (q - 2) + 8 * part) = ov;
        }
#pragma unroll
        for (int hd = 0; hd < H_RW; ++hd) {
            const int col = hd * 64 + 8 * part;
            const u32x4 xc = *(const u32x4*)(pc + PC_K + col); u32x4 xp = {0u, 0u, 0u, 0u}; if (hasp) xp = *(const u32x4*)(pp + PC_K + col);
            const float cv[8] = {hlo(xc.x), hhi(xc.x), hlo(xc.y), hhi(xc.y), hlo(xc.z), hhi(xc.z), hlo(xc.w), hhi(xc.w)};
            const float pv[8] = {hlo(xp.x), hhi(xp.x), hlo(xp.y), hhi(xp.y), hlo(xp.z), hhi(xp.z), hlo(xp.w), hhi(xp.w)};
            float ss = 0.f;
#pragma unroll
            for (int e = 0; e < 8; ++e) { const float kq = (cv[e] + A.mu[384 + col + e] * (pv[e] - cv[e])) * A.kkp[col + e]; ss += kq * kq; }
            ss += __shfl_xor(ss, 1); ss += __shfl_xor(ss, 2); ss += __shfl_xor(ss, 4);
            if (part == 0) A.RN[tok * 6 + hd] = rsqrtf(fmaxf(ss, 1e-24f));
        }
    }
    __syncthreads();
    LAS h16* OT = XG + 64 * 136;
    prep_mat<0>(XW, OT, A.LRW, A.w0, A.WE, tile, w, c, g);
    prep_mat<1>(XA, OT, A.LRW + 384 * 64, A.a0, A.AA, tile, w, c, g);
    prep_mat<2>(XG, OT, A.LRW + 2 * 384 * 64, nullptr, A.GG, tile, w, c, g);
}

struct ScanArgs { const h16* P16; const h16 *WE, *AA; const float* RN; const float *mu, *kk, *ka; h16* O16; };
constexpr int NS = 8, AP = 72, TP2 = 20;
constexpr int S_AT = 0, S_RT = 2304, S_BN = 4608, S_KN = 6912, S_BT = 9216, S_KT = 11776, S_VT = 14336, S_T = 16896, S_MAK = 17536, S_MRB = 18176, S_MRK = 18816, S_GL = 19456, S_N = S_BN  , SLOT = 19712;
constexpr int NCH = S / 16;
static_assert(NS * SLOT <= LDS_BYTES - 16, "scan slots fit the LDS allocation");
struct RawRegs { unsigned short r[16], k[16], v[16], e[16], a[16]; unsigned short pr, pk, pv; float rn; };
__device__ __forceinline__ void scan_load(const ScanArgs& A, int b, int h, int ck, int lane, RawRegs& R) {
    const int ch = h * 64 + lane; const size_t tok0 = (size_t)b * S + 16 * ck;
    const unsigned short* p0 = (const unsigned short*)A.P16 + tok0 * PITCH + ch;
    const unsigned short* we = (const unsigned short*)A.WE + tok0 * C_RW + ch; const unsigned short* aa = (const unsigned short*)A.AA + tok0 * C_RW + ch;
    R.pr = 0; R.pk = 0; R.pv = 0;
    if (ck > 0) { R.pr = p0[PC_R - PITCH]; R.pk = p0[PC_K - PITCH]; R.pv = p0[PC_V - PITCH]; }
#pragma unroll
    for (int t = 0; t < 16; ++t) { R.r[t] = p0[(size_t)t * PITCH + PC_R]; R.k[t] = p0[(size_t)t * PITCH + PC_K]; R.v[t] = p0[(size_t)t * PITCH + PC_V]; R.e[t] = we[t * C_RW]; R.a[t] = aa[t * C_RW]; }
    R.rn = A.RN[(tok0 + (lane & 15)) * 6 + h];
}
__device__ __forceinline__ float us2f(unsigned short u) { return (float)__builtin_bit_cast(_Float16, u); }
__device__ __forceinline__ void scan_item(const ScanArgs& A, int bh, LAS unsigned char* lds) {
    int tid_ = threadIdx.x; asm volatile("" : "+v"(tid_)); const int tid = tid_, lane = tid & 63, w = __builtin_amdgcn_readfirstlane(tid >> 6), c = lane & 15, g = lane >> 4;
    const int b = bh / H_RW, h = bh % H_RW, ch = h * 64 + lane;
    LAS unsigned char* sb = lds + w * SLOT;
    LAS h16* AT = (LAS h16*)(sb + S_AT); LAS h16* RT = (LAS h16*)(sb + S_RT); LAS h16* BN = (LAS h16*)(sb + S_BN); LAS h16* KN = (LAS h16*)(sb + S_KN);
    LAS h16* BT = (LAS h16*)(sb + S_BT); LAS h16* KT = (LAS h16*)(sb + S_KT); LAS h16* VT = (LAS h16*)(sb + S_VT);
    LAS h16* TM = (LAS h16*)(sb + S_T); LAS h16* MAK = (LAS h16*)(sb + S_MAK); LAS h16* MRB = (LAS h16*)(sb + S_MRB); LAS h16* MRK = (LAS h16*)(sb + S_MRK);
    LAS float* GL = (LAS float*)(sb + S_GL); LAS float* N32 = (LAS float*)(sb + S_N);
    const float mu_r = A.mu[ch], mu_k = A.mu[384 + ch], mu_v = A.mu[768 + ch], k_k = A.kk[ch], k_a = A.ka[ch];
    f32x4 X[4];
#pragma unroll
    for (int kt = 0; kt < 4; ++kt) X[kt] = (f32x4){0.f, 0.f, 0.f, 0.f};
    RawRegs R;
    scan_load(A, b, h, w, lane, R);
#pragma unroll 1
    for (int bt = 0; bt < NCH / NS; ++bt) {
        {
            float pr = us2f(R.pr), pk = us2f(R.pk), pv = us2f(R.pv);
            float cl = 0.f, G = 1.f;
            const int rnv = __builtin_bit_cast(int, R.rn);
#pragma unroll
            for (int t = 0; t < 16; ++t) {
                const float cr = us2f(R.r[t]), ckv = us2f(R.k[t]), cv = us2f(R.v[t]), e = us2f(R.e[t]), a = us2f(R.a[t]);
                const float r = cr + mu_r * (pr - cr), k = ckv + mu_k * (pk - ckv), v = cv + mu_v * (pv - cv);
                pr = cr; pk = ckv; pv = cv;
                const float Gm1 = G; cl -= e; G = __expf(cl); const float iG = __builtin_amdgcn_rcpf(G);
                const float rn = __builtin_bit_cast(float, __builtin_amdgcn_readlane(rnv, t));
                const float kkn = k * k_k * rn;
                const float k2 = k * (1.f + (a - 1.f) * k_a), be = kkn * a;
                const h16 at = (h16)(-kkn * Gm1), bt_ = (h16)(be * iG), kt_ = (h16)(k2 * iG), rt = (h16)(r * G);
                AT[t * AP + lane] = at; RT[t * AP + lane] = rt; BN[t * AP + lane] = bt_; KN[t * AP + lane] = kt_;
                BT[lane * TP2 + t] = bt_; KT[lane * TP2 + t] = kt_; VT[lane * TP2 + t] = (h16)v;
            }
            GL[lane] = G;
            if (bt + 1 < NCH / NS) scan_load(A, b, h, NS * (bt + 1) + w, lane, R);
            asm volatile("s_waitcnt lgkmcnt(0)" ::: "memory");
            f32x4 mab = {0.f, 0.f, 0.f, 0.f}, mak = mab, mrb = mab, mrk = mab;
#pragma unroll
            for (int ks = 0; ks < 2; ++ks) {
                const f16x8 fa = *(const LAS f16x8*)(AT + c * AP + 32 * ks + 8 * g), fr = *(const LAS f16x8*)(RT + c * AP + 32 * ks + 8 * g);
                const f16x8 fb = *(const LAS f16x8*)(BN + c * AP + 32 * ks + 8 * g), fk = *(const LAS f16x8*)(KN + c * AP + 32 * ks + 8 * g);
                mab = mfma16(fa, fb, mab); mak = mfma16(fa, fk, mak); mrb = mfma16(fr, fb, mrb); mrk = mfma16(fr, fk, mrk);
            }
            asm volatile("s_waitcnt lgkmcnt(0)" ::: "memory");
#pragma unroll
            for (int r = 0; r < 4; ++r) { const int t = 4 * g + r;
                N32[t * 16 + c] = (c < t) ? mab[r] : 0.f;
                MAK[t * TP2 + c] = (h16)((c < t) ? mak[r] : 0.f); MRB[t * TP2 + c] = (h16)((c <= t) ? mrb[r] : 0.f); MRK[t * TP2 + c] = (h16)((c <= t) ? mrk[r] : 0.f); }
            asm volatile("s_waitcnt lgkmcnt(0)" ::: "memory");
            {
                float Tc[16];
#pragma unroll
                for (int t = 0; t < 16; ++t) {
                    float acc = (t == c) ? 1.f : 0.f;
#pragma unroll
                    for (int s4 = 0; s4 < (t + 3) / 4; ++s4) { const f32x4 nr = *(const LAS f32x4*)(N32 + t * 16 + 4 * s4);
#pragma unroll
                        for (int e = 0; e < 4; ++e) if (4 * s4 + e < t) acc += nr[e] * Tc[4 * s4 + e]; }
                    Tc[t] = acc;
                }
                if (g == 0) {
#pragma unroll
                    for (int t = 0; t < 16; ++t) TM[t * TP2 + c] = (h16)Tc[t];
                }
            }
        }
        asm volatile("s_waitcnt lgkmcnt(0)" ::: "memory"); __builtin_amdgcn_s_barrier(); asm volatile("" ::: "memory");
        if (w < 4) {
#pragma unroll 1
            for (int sl = 0; sl < NS; ++sl) {
                const int ck = NS * bt + sl;
                const LAS unsigned char* cb = lds + sl * SLOT;
                const LAS h16* cAT = (const LAS h16*)(cb + S_AT); const LAS h16* cRT = (const LAS h16*)(cb + S_RT);
                const LAS h16* cBT = (const LAS h16*)(cb + S_BT); const LAS h16* cKT = (const LAS h16*)(cb + S_KT); const LAS h16* cVT = (const LAS h16*)(cb + S_VT);
                const LAS h16* cTM = (const LAS h16*)(cb + S_T); const LAS h16* cMAK = (const LAS h16*)(cb + S_MAK); const LAS h16* cMRB = (const LAS h16*)(cb + S_MRB); const LAS h16* cMRK = (const LAS h16*)(cb + S_MRK);
                const LAS float* cGL = (const LAS float*)(cb + S_GL);
                f16x8 xf[2];
#pragma unroll
                for (int ks = 0; ks < 2; ++ks) { const f32x4 x0 = X[2 * ks], x1 = X[2 * ks + 1];
                    xf[ks] = (f16x8){(_Float16)x0[0], (_Float16)x0[1], (_Float16)x0[2], (_Float16)x0[3], (_Float16)x1[0], (_Float16)x1[1], (_Float16)x1[2], (_Float16)x1[3]}; }
                const f16x4 vf = *(const LAS f16x4*)(cVT + (16 * w + c) * TP2 + 4 * g);
                const f16x4 makf = *(const LAS f16x4*)(cMAK + c * TP2 + 4 * g), tf = *(const LAS f16x4*)(cTM + c * TP2 + 4 * g);
                const f16x4 mrbf = *(const LAS f16x4*)(cMRB + c * TP2 + 4 * g), mrkf = *(const LAS f16x4*)(cMRK + c * TP2 + 4 * g);
                f16x8 af[2], rf[2];
#pragma unroll
                for (int ks = 0; ks < 2; ++ks) {
                    const f16x4 a0 = *(const LAS f16x4*)(cAT + c * AP + 32 * ks + 4 * g), a1 = *(const LAS f16x4*)(cAT + c * AP + 32 * ks + 16 + 4 * g);
                    const f16x4 r0 = *(const LAS f16x4*)(cRT + c * AP + 32 * ks + 4 * g), r1 = *(const LAS f16x4*)(cRT + c * AP + 32 * ks + 16 + 4 * g);
                    af[ks] = (f16x8){a0[0], a0[1], a0[2], a0[3], a1[0], a1[1], a1[2], a1[3]}; rf[ks] = (f16x8){r0[0], r0[1], r0[2], r0[3], r1[0], r1[1], r1[2], r1[3]};
                }
                f32x4 gw = {0.f, 0.f, 0.f, 0.f};
                gw = mfma16k16(makf, vf, gw); gw = mfma16(af[0], xf[0], gw); gw = mfma16(af[1], xf[1], gw);
                const f16x4 gwf = (f16x4){(_Float16)gw[0], (_Float16)gw[1], (_Float16)gw[2], (_Float16)gw[3]};
                f32x4 u = {0.f, 0.f, 0.f, 0.f}; u = mfma16k16(tf, gwf, u);
                const f16x4 uf = (f16x4){(_Float16)u[0], (_Float16)u[1], (_Float16)u[2], (_Float16)u[3]};
                f32x4 yy = {0.f, 0.f, 0.f, 0.f};
                yy = mfma16k16(mrkf, vf, yy); yy = mfma16k16(mrbf, uf, yy); yy = mfma16(rf[0], xf[0], yy); yy = mfma16(rf[1], xf[1], yy);
#pragma unroll
                for (int kt = 0; kt < 4; ++kt) {
                    const f16x4 btf = *(const LAS f16x4*)(cBT + (16 * kt + c) * TP2 + 4 * g), ktf = *(const LAS f16x4*)(cKT + (16 * kt + c) * TP2 + 4 * g);
                    const f32x4 gl = *(const LAS f32x4*)(cGL + 16 * kt + 4 * g);
                    f32x4 x = X[kt]; x = mfma16k16(btf, uf, x); x = mfma16k16(ktf, vf, x); X[kt] = x * gl;
                }
                h16* op = A.O16 + ((size_t)b * S + 16 * ck + 4 * g) * D + C_ATT + h * 64 + 16 * w + c;
#pragma unroll
                for (int r = 0; r < 4; ++r) op[(size_t)r * D] = (h16)yy[r];
            }
        }
        asm volatile("s_waitcnt lgkmcnt(0)" ::: "memory"); __builtin_amdgcn_s_barrier(); asm volatile("" ::: "memory");
    }
    asm volatile("s_waitcnt vmcnt(0)" ::: "memory");
    __syncthreads();
}

struct PostArgs { const h16* P16; const h16 *AA, *GG; const float *mu, *ka, *rk, *lnw, *lnb; h16* O16; };
struct PostRaw4 { u32x2 cr, ck, cv, qr, qk, qv, av, gv, yv; };
__device__ __forceinline__ float row_sum16(float v) { v += dpp_mov<0xB1>(v); v += dpp_mov<0x4E>(v); v += dpp_mov<0x141>(v); v += dpp_mov<0x140>(v); return v; }
__device__ __forceinline__ void post_head_load(PostRaw4& R, const PostArgs& A, size_t tok, int col) {
    const h16* pc = A.P16 + tok * PITCH + col; const bool hasp = (tok % S) != 0;
    R.cr = *(const u32x2*)(pc + PC_R); R.ck = *(const u32x2*)(pc + PC_K); R.cv = *(const u32x2*)(pc + PC_V);
    R.qr = (u32x2){0u, 0u}; R.qk = (u32x2){0u, 0u}; R.qv = (u32x2){0u, 0u};
    if (hasp) { R.qr = *(const u32x2*)(pc + PC_R - PITCH); R.qk = *(const u32x2*)(pc + PC_K - PITCH); R.qv = *(const u32x2*)(pc + PC_V - PITCH); }
    R.av = *(const u32x2*)(A.AA + tok * C_RW + col); R.gv = *(const u32x2*)(A.GG + tok * C_RW + col); R.yv = *(const u32x2*)(A.O16 + tok * D + C_ATT + col);
}
__device__ __forceinline__ void h4(const u32x2 w, float (&o)[4]) { o[0] = hlo(w.x); o[1] = hhi(w.x); o[2] = hlo(w.y); o[3] = hhi(w.y); }
__device__ __forceinline__ void post_head(const PostArgs& A, int b, int h) {
    int tid_ = threadIdx.x; asm volatile("" : "+v"(tid_)); const int lane = tid_ & 63, w = tid_ >> 6, col = h * 64 + 4 * (lane & 15);
    float mur[4], muk[4], muv[4], kaw[4], rkw[4], lw[4], lb[4];
#pragma unroll
    for (int e = 0; e < 4; ++e) { mur[e] = A.mu[col + e]; muk[e] = A.mu[384 + col + e]; muv[e] = A.mu[768 + col + e]; kaw[e] = A.ka[col + e]; rkw[e] = A.rk[col + e]; lw[e] = A.lnw[col + e]; lb[e] = A.lnb[col + e]; }
    const size_t tok0 = (size_t)b * S + 512 * w + (lane >> 4);
    PostRaw4 R0, R1;
    post_head_load(R0, A, tok0, col);
#define RWK_POST4(R, TOK) do { \
        float fr[4], fk[4], fv[4], qr[4], qk[4], qv[4], av[4], gv[4], y[4]; \
        h4(R.cr, fr); h4(R.ck, fk); h4(R.cv, fv); h4(R.qr, qr); h4(R.qk, qk); h4(R.qv, qv); h4(R.av, av); h4(R.gv, gv); h4(R.yv, y); \
        float sb = 0.f, vv[4]; \
        _Pragma("unroll") for (int e = 0; e < 4; ++e) { const float r = fr[e] + mur[e] * (qr[e] - fr[e]), k = fk[e] + muk[e] * (qk[e] - fk[e]); vv[e] = fv[e] + muv[e] * (qv[e] - fv[e]); \
            sb += r * (k * (1.f + (av[e] - 1.f) * kaw[e])) * rkw[e]; } \
        const float mean = row_sum16((y[0] + y[1]) + (y[2] + y[3])) * (1.f / 64.f); \
        float dv[4], sv = 0.f; \
        _Pragma("unroll") for (int e = 0; e < 4; ++e) { dv[e] = y[e] - mean; sv += dv[e] * dv[e]; } \
        const float rs = rsqrtf(row_sum16(sv) * (1.f / 64.f) + 64e-5f); \
        const float bon = row_sum16(sb); \
        float o[4]; \
        _Pragma("unroll") for (int e = 0; e < 4; ++e) o[e] = (dv[e] * rs * lw[e] + lb[e] + bon * vv[e]) * gv[e]; \
        u32x2 ov; ov.x = pg8::pk_f16(o[0], o[1]); ov.y = pg8::pk_f16(o[2], o[3]); \
        *(u32x2*)(A.O16 + (TOK) * D + C_ATT + col) = ov; } while (0)
#pragma unroll 1
    for (int t0 = 0; t0 < 512; t0 += 8) {
        post_head_load(R1, A, tok0 + t0 + 4, col);
        RWK_POST4(R0, tok0 + t0);
        if (t0 + 8 < 512) post_head_load(R0, A, tok0 + t0 + 8, col);
        RWK_POST4(R1, tok0 + t0 + 4);
    }
#undef RWK_POST4
}
}
__device__ __forceinline__ void skinny_item(const h16* H, const h16* Wsm, h16* P16o, int tile, LAS unsigned char* lds) {
    int tid_ = threadIdx.x; asm volatile("" : "+v"(tid_)); const int tid = tid_, lane = tid & 63, w = tid >> 6, c = lane & 15, g = lane >> 4;
    LAS float* PART = (LAS float*)lds;
    nsa::f16x8 af[4][4], bf[4][2];
#pragma unroll
    for (int ks = 0; ks < 4; ++ks) { const int k0 = 128 * w + 32 * ks + 8 * g;
#pragma unroll
        for (int mt = 0; mt < 4; ++mt) af[ks][mt] = *(const nsa::f16x8*)(H + ((size_t)tile * 64 + 16 * mt + c) * D + k0);
#pragma unroll
        for (int nt = 0; nt < 2; ++nt) bf[ks][nt] = *(const nsa::f16x8*)(Wsm + (size_t)(16 * nt + c) * D + k0); }
    nsa::f32x4 acc[4][2];
#pragma unroll
    for (int mt = 0; mt < 4; ++mt)
#pragma unroll
        for (int nt = 0; nt < 2; ++nt) acc[mt][nt] = (nsa::f32x4){0.f, 0.f, 0.f, 0.f};
#pragma unroll
    for (int ks = 0; ks < 4; ++ks)
#pragma unroll
        for (int mt = 0; mt < 4; ++mt)
#pragma unroll
            for (int nt = 0; nt < 2; ++nt) acc[mt][nt] = nsa::mfma16(bf[ks][nt], af[ks][mt], acc[mt][nt]);
#pragma unroll
    for (int mt = 0; mt < 4; ++mt)
#pragma unroll
        for (int nt = 0; nt < 2; ++nt) *(LAS nsa::f32x4*)(PART + (w * 64 + 16 * mt + c) * 32 + 16 * nt + 4 * g) = acc[mt][nt];
    __syncthreads();
    {   const int tk = tid >> 3, c4 = (tid & 7) * 4;
        nsa::f32x4 s = {0.f, 0.f, 0.f, 0.f};
#pragma unroll
        for (int ww = 0; ww < 8; ++ww) s = s + *(const LAS nsa::f32x4*)(PART + (ww * 64 + tk) * 32 + c4);
        if (c4 < 24) { pg8::u32x2 o; o.x = pg8::pk_f16(s[0], s[1]); o.y = pg8::pk_f16(s[2], s[3]); *(pg8::u32x2*)(P16o + ((size_t)tile * 64 + tk) * PITCH + PC_GTS + c4) = o; }
    }
    __syncthreads();
}
#define XB_TMO      128
#define XB_XCNT(j)  (256  + 64 * (j))
#define XB_XSUB(j)  (1280 + 64 * (j))
#define XB_XGEN(j)  (2304 + 64 * (j))
#define XB_TOP      3328
#define XB_TOPGEN   3392
#define XCD_BAR_WORDS 3456
#define XB_SPIN_CAP (1u << 18)

__device__ __forceinline__ unsigned xb_ld(unsigned* p)              { return __hip_atomic_load(p, __ATOMIC_RELAXED, __HIP_MEMORY_SCOPE_AGENT); }
__device__ __forceinline__ unsigned xb_add(unsigned* p, unsigned v) { return __hip_atomic_fetch_add(p, v, __ATOMIC_RELAXED, __HIP_MEMORY_SCOPE_AGENT); }
__device__ __forceinline__ unsigned xb_xcc_id() { return (unsigned)__builtin_amdgcn_s_getreg((3 << 11) | 20) & 0xFu; }
#define XB_SPIN(cond, bar) do { unsigned _sp = 0; while (cond) { __builtin_amdgcn_s_sleep(1); \
    if ((++_sp & 255u) == 0u) { if (xb_ld(&(bar)[XB_TMO])) break; if (_sp > XB_SPIN_CAP) { atomicAdd(&(bar)[XB_TMO], 1u); break; } } } } while (0)

struct XcdBarrier {
    unsigned* bar; unsigned x;
    volatile LAS unsigned* st;
};

__device__ __forceinline__ XcdBarrier xcd_barrier_post(unsigned* bar, volatile LAS unsigned* st) {
    XcdBarrier b; b.bar = bar; b.x = xb_xcc_id(); b.st = st;
    if (threadIdx.x == 0) (void)xb_add(&bar[XB_XCNT(b.x)], 1u);
    return b;
}
__device__ __forceinline__ void xcd_barrier_complete(unsigned* bar, unsigned x, unsigned& nloc, unsigned& nx) {
    const unsigned G = gridDim.x * gridDim.y * gridDim.z;
    unsigned sum, cnt, mine, sp = 0u;
    for (;;) {
        sum = 0u; cnt = 0u; mine = 0u;
#pragma unroll
        for (unsigned j = 0; j < 16; ++j) { const unsigned c = xb_ld(&bar[XB_XCNT(j)]); sum += c; cnt += (c > 0u) ? 1u : 0u; mine = (j == x) ? c : mine; }
        if (sum == G) break;
        __builtin_amdgcn_s_sleep(1);
        if ((++sp & 255u) == 0u) { if (xb_ld(&bar[XB_TMO])) break; if (sp > XB_SPIN_CAP) { atomicAdd(&bar[XB_TMO], 1u); break; } }
    }
    nloc = mine > 0u ? mine : 1u; nx = cnt > 0u ? cnt : 1u;
}

__device__ __forceinline__ void xcd_barrier(const XcdBarrier& b) {
    asm volatile("s_waitcnt vmcnt(0)" ::: "memory");
    __syncthreads();
    if (threadIdx.x == 0) {
        unsigned* bar = b.bar;
        __builtin_amdgcn_s_waitcnt(0);
        unsigned nloc = b.st[0], nx = b.st[1];
        if (nloc == 0u) { xcd_barrier_complete(bar, b.x, nloc, nx); b.st[0] = nloc; b.st[1] = nx; }
        const unsigned old = xb_add(&bar[XB_XSUB(b.x)], 1u);
        const unsigned gen = old / nloc;
        if (old + 1u == (gen + 1u) * nloc) {
            __builtin_amdgcn_fence(__ATOMIC_RELEASE, "agent");
            asm volatile("s_waitcnt vmcnt(0)" ::: "memory");
            const unsigned og = xb_add(&bar[XB_TOP], 1u);
            const unsigned tg = og / nx;
            if (og + 1u == (tg + 1u) * nx) xb_add(&bar[XB_TOPGEN], 1u);
            else XB_SPIN(xb_ld(&bar[XB_TOPGEN]) == tg, bar);
            __builtin_amdgcn_fence(__ATOMIC_ACQUIRE, "agent");
            xb_add(&bar[XB_XGEN(b.x)], 1u);
            asm volatile("s_waitcnt vmcnt(0)" ::: "memory");
        } else {
            XB_SPIN(xb_ld(&bar[XB_XGEN(b.x)]) == gen, bar);
            __builtin_amdgcn_fence(__ATOMIC_ACQUIRE, "agent");
            asm volatile("s_waitcnt vmcnt(0)" ::: "memory");
        }
    }
    __syncthreads();
}
constexpr int N_PHASES = 20;
__global__ void __launch_bounds__(512, 2) mk_fwd(Args a) {
    extern __shared__ __attribute__((aligned(16))) unsigned char lds_raw[];
    LAS unsigned char* lds = (LAS unsigned char*)lds_raw;
    cg::grid_group grid = cg::this_grid();
    if (threadIdx.x < 4) ((LAS unsigned*)(lds + L_BARST))[threadIdx.x] = 0u;
    __syncthreads();
    const XcdBarrier xbar = xcd_barrier_post((unsigned*)(a.ws + WS_BAR), (volatile LAS unsigned*)(lds + L_BARST));
    unsigned char* ws = a.ws;
    float* MOD = (float*)(ws + WS_MOD); h16* QK32 = (h16*)(ws + WS_QK32); h16* P16 = (h16*)(ws + WS_P16); h16* H16 = (h16*)(ws + WS_H16);
    h16* Y16 = (h16*)(ws + WS_Y32); h16* ACT = (h16*)(ws + WS_ACT); float* X = a.out;
    h16* XB16 = (h16*)(ws + WS_XB16);
    const int lo = a.ph_lo, hi = a.ph_hi;
#define IN(k) (lo <= (k) && (k) < hi)
    if (lo > 1000) grid.sync();
#define SEAM(k) do { if (IN(k) && IN((k) + 1)) { \
        xcd_barrier(xbar); \
    } } while (0)
    if (IN(0)) { phase_prologue(a, lds); } SEAM(0);
    if (IN(1)) { phase_post<false, false, false, true, 2>(a.in[0], nullptr, nullptr, MOD, 0, nullptr, a.in[4], MOD, 0, D, H16); prologue_weights(a, lds, 1); } SEAM(1);
#define LAYER(l) do { \
    const float* modl = MOD + (size_t)(l) * NB * 6 * D; constexpr int pb = 2 + 9 * (l); \
    mls::Args ma{P16, a.in[29] + (l) * 4 * 768, a.in[30] + (l) * 768, a.in[31] + (l) * H_ML, a.in[32] + (l) * H_ML, a.in[33] + (l) * C_ML, (float*)(ws + mls::WS_KVB), (float*)(ws + mls::WS_KSUM), (float*)(ws + mls::WS_MUB), H16, (float*)(ws + mls::WS_GT), (const h16*)(ws + WS_CW16) + (size_t)(l) * 5 * 768}; \
    if (IN(pb + 0)) { for (int it = blockIdx.x; it < 512; it += gridDim.x) skinny_item(H16, (const h16*)(ws + WS_WSM) + (size_t)(l) * 32 * D, P16, it, lds); \
        pg8::Gemm g{H16, (const h16*)(ws + WS_WIN) + (size_t)(l) * NIN_PAD * D, M, NIN_PAD, D}; pg8::StaticOrder So; So.init(M, NIN_PAD, gridDim.x, blockIdx.x); \
        pg8::EpiProj E{QK32, P16, (h16*)(ws + WS_VTG)}; pg8::gemm_phase<pg8::EpiProj, pg8::StaticOrder, true, true>(lds, g, So, E); } SEAM(pb + 0); \
    if (IN(pb + 1)) { nsa::CmpArgs ca{QK32, P16, (const h16*)(ws + WS_W1C) + (size_t)(l) * 2 * 64 * 2048, (const float*)(ws + WS_CBIAS) + (l) * 128, a.in[13] + (l) * 4096, a.in[15] + (l) * 4096, (h16*)(ws + WS_KC16), (h16*)(ws + WS_VC16)}; \
        for (int it = blockIdx.x; it < 256; it += gridDim.x) nsa::compress_item(ca, it >> 5, (it >> 4) & 1, it & 15, lds); \
        for (int it = blockIdx.x; it < 3072; it += gridDim.x) mls::m1_item(ma, it >> 6, it & 63, lds); \
        rwk::PrepArgs rp{P16, a.in[18] + (l) * RW_IN, a.in[19] + (l) * C_RW, a.in[21] + (l) * C_RW, a.in[24] + (l) * C_RW, (const h16*)(ws + rwk::WS_LRW) + (size_t)(l) * rwk::LRW_L, (h16*)(ws + rwk::WS_WE), (h16*)(ws + rwk::WS_AA), (h16*)(ws + rwk::WS_GG), (float*)(ws + rwk::WS_RN)}; \
        for (int it = blockIdx.x; it < 512; it += gridDim.x) rwk::prep_item(rp, it, lds); } SEAM(pb + 1); \
    if (IN(pb + 2)) { nsa::AttnArgs aa{QK32, P16, (const h16*)(ws + WS_KC16), (const h16*)(ws + WS_VC16), (const h16*)(ws + WS_VTG), a.in[16] + (l) * 12, a.in[17] + (l) * 256, H16}; \
        rwk::ScanArgs rs{P16, (const h16*)(ws + rwk::WS_WE), (const h16*)(ws + rwk::WS_AA), (const float*)(ws + rwk::WS_RN), a.in[18] + (l) * RW_IN, a.in[24] + (l) * C_RW, a.in[25] + (l) * C_RW, H16}; \
        rwk::PostArgs rq{P16, (const h16*)(ws + rwk::WS_AA), (const h16*)(ws + rwk::WS_GG), a.in[18] + (l) * RW_IN, a.in[25] + (l) * C_RW, a.in[26] + (l) * C_RW, a.in[27] + (l) * C_RW, a.in[28] + (l) * C_RW, H16}; \
        if (blockIdx.x < 48) { rwk::scan_item(rs, blockIdx.x, lds); rwk::post_head(rq, blockIdx.x / H_RW, blockIdx.x % H_RW); } \
        {     \
            volatile LAS unsigned* qs = (volatile LAS unsigned*)(lds + L_QSLOT); \
            for (int kq = 0; kq < 8; ++kq) {   \
            const int xq = (int)((xbar.x + (unsigned)kq) & 7u); unsigned* qh = (unsigned*)(ws + WS_QCTR) + 64 * ((l) * 8 + xq); unsigned* m2d = (unsigned*)(ws + WS_QCTR) + 64 * (32 + (l) * 8 + xq); int it; \
            for (;;) { __syncthreads(); if (threadIdx.x == 0) *qs = atomicAdd(qh, 1u); __syncthreads(); it = (int)*qs; if (it >= 24 + 64) break; \
                if (it < 24) { mls::m2_item(ma, xq * 6 + (it >> 2), it & 3); asm volatile("s_waitcnt vmcnt(0)" ::: "memory"); __syncthreads(); \
                               if (threadIdx.x == 0) { __builtin_amdgcn_fence(__ATOMIC_RELEASE, "agent"); asm volatile("s_waitcnt vmcnt(0)" ::: "memory"); __hip_atomic_fetch_add(m2d, 1u, __ATOMIC_RELAXED, __HIP_MEMORY_SCOPE_AGENT); } } \
                else nsa::attn_item(aa, xq, 63 - (it - 24), lds); } \
            if (it < 24 + 64 + 384) {   \
                if (threadIdx.x == 0) { while (__hip_atomic_load(m2d, __ATOMIC_RELAXED, __HIP_MEMORY_SCOPE_AGENT) < 24u) __builtin_amdgcn_s_sleep(8); } \
                __syncthreads(); __builtin_amdgcn_fence(__ATOMIC_ACQUIRE, "agent"); asm volatile("s_waitcnt vmcnt(0)" ::: "memory"); \
                mls::M3Regs mr; mls::m3_load(mr, ma, xq * 384 + (it - 88), threadIdx.x); \
                while (it < 24 + 64 + 384) { __syncthreads(); if (threadIdx.x == 0) *qs = atomicAdd(qh, 1u); __syncthreads(); const int nx = (int)*qs; \
                    mls::m3_item(ma, xq * 384 + (it - 88), nx < 24 + 64 + 384 ? xq * 384 + (nx - 88) : -1, mr, lds); it = nx; } } } } } SEAM(pb + 2); \
    if (IN(pb + 4)) { pg8::Gemm g{H16, (const h16*)(ws + WS_WOUT) + (size_t)(l) * D * D, M, D, D}; pg8::StaticOrder So; So.init(M, D, gridDim.x, blockIdx.x); \
        pg8::EpiF16 E{Y16, D}; pg8::gemm_phase<pg8::EpiF16, pg8::StaticOrder, true, true>(lds, g, So, E); } SEAM(pb + 4); \
    if (IN(pb + 5)) { phase_post<(l) != 0, true, true, true, 2>((l) == 0 ? (const void*)a.in[0] : (const void*)X, Y16, a.in[5] + (l) * D, modl, 2 * D, XB16, a.in[6] + (l) * D, modl, 3 * D, 4 * D, H16); } SEAM(pb + 5); \
    if (IN(pb + 6)) { pg8::Gemm g{H16, (const h16*)(ws + WS_W1) + (size_t)(l) * NFF2 * D, M, NFF2, D}; pg8::StaticOrder So; So.init(M, NFF2, gridDim.x, blockIdx.x); \
        pg8::EpiSwiglu E{ACT, DFF}; pg8::gemm_phase<pg8::EpiSwiglu, pg8::StaticOrder, true, true>(lds, g, So, E); } SEAM(pb + 6); \
    if (IN(pb + 7)) { pg8::Gemm g{ACT, (const h16*)(ws + WS_W2) + (size_t)(l) * D * DFF, M, D, DFF}; pg8::StaticOrder So; So.init(M, D, gridDim.x, blockIdx.x); \
        pg8::EpiF16 E{Y16, D}; pg8::gemm_phase<pg8::EpiF16, pg8::StaticOrder, true, true>(lds, g, So, E); } SEAM(pb + 7); \
    if (IN(pb + 8)) { constexpr bool last = ((l) == DEPTH - 1); \
        phase_post<true, !last, true, !last, 2>(XB16, Y16, a.in[7] + (l) * D, modl, 5 * D, X, last ? nullptr : a.in[4] + ((l) + 1) * D, MOD + (size_t)(last ? (l) : (l) + 1) * NB * 6 * D, 0, D, H16); } \
    if (!((l) == DEPTH - 1)) SEAM(pb + 8); \
    } while (0)
    LAYER(0);
    LAYER(1);
#undef LAYER
#undef SEAM
#undef IN
}

static int g_grid = 0;
static void launch_mk(const Args& a0, int lo, int hi, hipStream_t stream) {
    Args a = a0; a.ph_lo = lo; a.ph_hi = hi;
    void* args[] = {(void*)&a};
    hipError_t e = hipLaunchCooperativeKernel((const void*)mk_fwd, dim3(g_grid), dim3(512), args, LDS_BYTES, stream);
    if (e != hipSuccess) fprintf(stderr, "cooperative launch failed: %s (grid %d)\n", hipGetErrorString(e), g_grid);
}
extern "C" void kernel_launch(void* const* d_in, const int* in_sizes, int n_in, void* d_out, int out_size, void* d_ws, size_t ws_size, hipStream_t stream) {
    if (n_in != 37 || ws_size < WS_END2) { fprintf(stderr, "kernel_launch: unexpected n_in %d / ws %zu\n", n_in, ws_size); return; }
    if (!g_grid) {
        int dev = 0, cus = 0, per_cu = 0;
        hipGetDevice(&dev); hipDeviceGetAttribute(&cus, hipDeviceAttributeMultiprocessorCount, dev);
        hipFuncSetAttribute((const void*)mk_fwd, hipFuncAttributeMaxDynamicSharedMemorySize, LDS_BYTES);
        hipOccupancyMaxActiveBlocksPerMultiprocessor(&per_cu, (const void*)mk_fwd, 512, LDS_BYTES);
        if (per_cu < 1) { fprintf(stderr, "kernel_launch: occupancy query says %d blocks/CU\n", per_cu); per_cu = 1; }
        g_grid = cus * (per_cu > 1 ? 1 : per_cu);
    }
    const float* const* in = (const float* const*)d_in;
    Args a{};
    for (int i = 0; i < 37; ++i) a.in[i] = in[i];
    a.out = (float*)d_out; a.ws = (unsigned char*)d_ws;
    hipMemsetAsync((char*)d_ws + WS_BAR, 0, 32768, stream);
    launch_mk(a, 0, N_PHASES, stream);
}
```

```cpp
#include <hip/hip_runtime.h>
#include <cstdio>
#include <cstdint>

typedef _Float16 h16;

constexpr int D = 1024, NB = 8, S = 4096, M = NB * S, DEPTH = 2;
constexpr int HD = 64;
constexpr int C_ATT = 256, C_RW = 384, C_ML = 384;
constexpr int H_ATT = 4, H_RW = 6, H_ML = 6;
constexpr int NSA_IN = 652, RW_IN = 1408, ML_IN = 1548, D_IN = 3608;
constexpr int DFF = 2816;
constexpr int NCMP = 255, NSLC = 64;
constexpr int PITCH = 3296;
constexpr int PC_VC = 0, PC_KS = 64, PC_VS = 128, PC_KW = 192, PC_VW = 256;
constexpr int PC_R = 320, PC_K = 704, PC_V = 1088, PC_XW = 1472, PC_XA = 1536, PC_XG = 1600;
constexpr int PC_MQ = 1728, PC_MK = 2112, PC_MV = 2496, PC_MO = 2880;
constexpr int PC_GTS = 3264, PC_IG = 3276, PC_FG = 3282;
constexpr int QKP = 320;
constexpr float QSCALE_Q = 0.125f * 1.4426950408889634f;

constexpr size_t MiB = 1u << 20;
constexpr size_t WS_MOD = 0;
constexpr size_t WS_QK32 = 4 * MiB;
constexpr size_t WS_P16 = 44 * MiB;
constexpr size_t WS_H16 = 250 * MiB;
constexpr size_t WS_Y32 = 314 * MiB;
constexpr size_t WS_XB16 = 184 * MiB;
constexpr size_t WS_ACT = 4 * MiB;
constexpr size_t WS_END = 442 * MiB;

__device__ __forceinline__ float wave_sum(float v) {
#pragma unroll
    for (int o = 32; o > 0; o >>= 1) v += __shfl_xor(v, o);
    return v;
}
__device__ __forceinline__ float wave_max(float v) {
#pragma unroll
    for (int o = 32; o > 0; o >>= 1) v = fmaxf(v, __shfl_xor(v, o));
    return v;
}
__device__ __forceinline__ float sigmoidf_(float x) { return 1.f / (1.f + expf(-x)); }
__device__ __forceinline__ float siluf_(float x) { return x * sigmoidf_(x); }
__device__ __forceinline__ float softplusf_(float x) { return fmaxf(x, 0.f) + log1pf(expf(-fabsf(x))); }
__device__ __forceinline__ float gelu_tanh(float x) { return 0.5f * x * (1.f + tanhf(0.7978845608028654f * (x + 0.044715f * x * x * x))); }

#include <hip/hip_cooperative_groups.h>
namespace cg = cooperative_groups;

namespace pg8 {
#define PG8_LAS __attribute__((address_space(3)))
typedef short s16x8 __attribute__((ext_vector_type(8)));
typedef _Float16 f16x8 __attribute__((ext_vector_type(8)));
typedef float f32x4 __attribute__((ext_vector_type(4)));
typedef unsigned u32x4 __attribute__((ext_vector_type(4)));
typedef unsigned u32x2 __attribute__((ext_vector_type(2)));
constexpr int BM = 256, BK = 64, HALF = 128, HTB = HALF * BK * 2  , STAGE_BYTES = 8 * HTB, NXCD = 8, WGM = 8;

__host__ __device__ __forceinline__ int lds_byte(int r, int c) { const int st = (r >> 4) * 2 + (c >> 5), rr = r & 15, cc = c & 31, ob = rr * 64 + cc * 2; return st * 1024 + (ob ^ (((ob >> 9) & 1) << 5)); }
__host__ __device__ __forceinline__ void stage_rc(int b, int& R, int& C) { const int st = b / 1024, sb = b % 1024, swz = sb ^ (((sb >> 9) & 1) << 5); R = (st >> 1) * 16 + swz / 64; C = (st & 1) * 32 + (swz % 64) / 2; }
__host__ __device__ __forceinline__ int perm32(int rho) { const int n = rho >> 4, i = rho & 15; return 8 * (i >> 2) + 4 * n + (i & 3); }

struct Unit { int pm, pn; };
struct Gemm { const h16* A; const h16* Bt; int M, N, K; };

struct StaticOrder {
    int nM, nN, nwg, G, c;
    __host__ __device__ void init(int M, int N, int G_, int c_) { nM = M / BM; nN = N / BM; nwg = nM * nN; G = G_; c = c_; }
    __host__ __device__ bool next(int i, Unit& u) const {
        const long L = (long)i * G + c; if (L >= nwg) return false;
        int wgid = (int)L; { const int q = nwg / NXCD, r = nwg % NXCD, xcd = wgid % NXCD, off = wgid / NXCD; wgid = (xcd < r ? xcd * (q + 1) : r * (q + 1) + (xcd - r) * q) + off; }
        const int nig = WGM * nN, gid = wgid / nig, fm = gid * WGM, gsz = (nM - fm) < WGM ? (nM - fm) : WGM;
        u.pm = fm + ((wgid % nig) % gsz); u.pn = (wgid % nig) / gsz; return true;
    }
    __device__ __forceinline__ void a_ready(const Unit&) const {}
    __device__ __forceinline__ void done(const Unit&) const {}
};

__device__ __forceinline__ unsigned pk_f16(float lo, float hi) { typedef _Float16 h2 __attribute__((ext_vector_type(2))); h2 v = {(_Float16)lo, (_Float16)hi}; return __builtin_bit_cast(unsigned, v); }

struct EpiProj {
    static constexpr bool PERM = true, AFTER_DRAIN = false; static constexpr int NSTORE = 16;
    h16* QK; h16* P; h16* VT;
    __device__ __forceinline__ void operator()(const f32x4 (&acc)[2][2][4][2], const Unit& u, int wr, int wc, int fr, int fq) const {
        const int row0 = u.pm * BM + wr * 64 + fr;
#pragma unroll
        for (int bj = 0; bj < 2; ++bj) {
            const int colt = u.pn * BM + bj * HALF + wc * 32 + 8 * fq;
            if (colt < 320) {
                const float qs = colt < 256 ? QSCALE_Q : 1.f;
#pragma unroll
                for (int ai = 0; ai < 2; ++ai)
#pragma unroll
                    for (int m = 0; m < 4; ++m) { const f32x4 v0 = acc[ai][bj][m][0], v1 = acc[ai][bj][m][1];
                        u32x4 w; w.x = pk_f16(v0[0] * qs, v0[1] * qs); w.y = pk_f16(v0[2] * qs, v0[3] * qs); w.z = pk_f16(v1[0] * qs, v1[1] * qs); w.w = pk_f16(v1[2] * qs, v1[3] * qs);
                        *(u32x4*)(QK + (size_t)(row0 + ai * HALF + m * 16) * QKP + colt) = w; }
            } else if ((colt >= 448 && colt < 512) || (colt >= 576 && colt < 640)) {
                const int br = colt >= 576 ? 1 : 0, d0 = colt - (br ? 576 : 448);
#pragma unroll
                for (int ai = 0; ai < 2; ++ai)
#pragma unroll
                    for (int m = 0; m < 4; ++m) { const int row = row0 + ai * HALF + m * 16, bb = row / S, tl = row % S;
                        h16* vp = VT + (((size_t)bb * 2 + br) * 64 + d0) * S + tl;
#pragma unroll
                        for (int e = 0; e < 4; ++e) { vp[(size_t)e * S] = (h16)acc[ai][bj][m][0][e]; vp[(size_t)(4 + e) * S] = (h16)acc[ai][bj][m][1][e]; } }
            } else {
#pragma unroll
                for (int ai = 0; ai < 2; ++ai)
#pragma unroll
                    for (int m = 0; m < 4; ++m) { const f32x4 v0 = acc[ai][bj][m][0], v1 = acc[ai][bj][m][1];
                        u32x4 w; w.x = pk_f16(v0[0], v0[1]); w.y = pk_f16(v0[2], v0[3]); w.z = pk_f16(v1[0], v1[1]); w.w = pk_f16(v1[2], v1[3]);
                        *(u32x4*)(P + (size_t)(row0 + ai * HALF + m * 16) * PITCH + (colt - 320)) = w; }
            }
        }
    }
};
struct EpiF16 {
    static constexpr bool PERM = true, AFTER_DRAIN = false; static constexpr int NSTORE = 16;
    h16* C; int ldc;
    __device__ __forceinline__ void operator()(const f32x4 (&acc)[2][2][4][2], const Unit& u, int wr, int wc, int fr, int fq) const {
        const int row0 = u.pm * BM + wr * 64 + fr;
#pragma unroll
        for (int ai = 0; ai < 2; ++ai)
#pragma unroll
            for (int m = 0; m < 4; ++m)
#pragma unroll
                for (int bj = 0; bj < 2; ++bj) { const f32x4 v0 = acc[ai][bj][m][0], v1 = acc[ai][bj][m][1];
                    u32x4 w; w.x = pk_f16(v0[0], v0[1]); w.y = pk_f16(v0[2], v0[3]); w.z = pk_f16(v1[0], v1[1]); w.w = pk_f16(v1[2], v1[3]);
                    *(u32x4*)(C + (size_t)(row0 + ai * HALF + m * 16) * ldc + u.pn * BM + bj * HALF + wc * 32 + 8 * fq) = w; }
    }
};
struct EpiSwiglu {
    static constexpr bool PERM = true, AFTER_DRAIN = false; static constexpr int NSTORE = 8;
    h16* C; int ldc;
    __device__ __forceinline__ void operator()(const f32x4 (&acc)[2][2][4][2], const Unit& u, int wr, int wc, int fr, int fq) const {
        const int row0 = u.pm * BM + wr * 64 + fr;
#pragma unroll
        for (int ai = 0; ai < 2; ++ai)
#pragma unroll
            for (int m = 0; m < 4; ++m) { float o[8];
#pragma unroll
                for (int n = 0; n < 2; ++n)
#pragma unroll
                    for (int e = 0; e < 4; ++e) { const float gt = acc[ai][0][m][n][e]; o[4 * n + e] = gt * __builtin_amdgcn_rcpf(1.f + __expf(-gt)) * acc[ai][1][m][n][e]; }
                u32x4 w; w.x = pk_f16(o[0], o[1]); w.y = pk_f16(o[2], o[3]); w.z = pk_f16(o[4], o[5]); w.w = pk_f16(o[6], o[7]);
                *(u32x4*)(C + (size_t)(row0 + ai * HALF + m * 16) * ldc + u.pn * HALF + wc * 32 + 8 * fq) = w; }
    }
};

template <class Epi, class Sched, bool ALIGN_EPI = false, bool SP2 = false>
__device__ __forceinline__ void gemm_phase(PG8_LAS unsigned char* lds, const Gemm g, const Sched& S, const Epi& E) {
    int tid_ = threadIdx.x; asm volatile("" : "+v"(tid_)); const int tid = tid_, wid = __builtin_amdgcn_readfirstlane(tid >> 6), lane = tid & 63, wr = wid >> 2, wc = wid & 3, fr = lane & 15, fq = lane >> 4;
    const int K = g.K, nt = K / BK;
    unsigned voffA[2], voffB[2];
#pragma unroll
    for (int i = 0; i < 2; ++i) { int R, C; stage_rc(tid * 16 + i * 8192, R, C); const int Rb = Epi::PERM ? ((R & ~31) + perm32(R & 31)) : R;
        voffA[i] = (unsigned)(R * K + C) * 2u; voffB[i] = (unsigned)(Rb * K + C) * 2u; }
    const size_t kstep = (size_t)(BK * 2);
    const size_t hstep = (size_t)HALF * K * 2;
    const size_t tstep = 2 * hstep;
    const unsigned ldsw = (unsigned)wid * 1024u;
    const int aoff = lds_byte(wr * 64 + fr, fq * 8), boff = lds_byte(wc * 32 + fr, fq * 8);
#define PG8_SA(b, h) (((b) * 2 + (h)) * HTB)
#define PG8_SB(b, h) ((4 + (b) * 2 + (h)) * HTB)
#define PG8_STAGE(bufoff, gbase, voff) do { _Pragma("unroll") for (int _i = 0; _i < 2; ++_i) \
        __builtin_amdgcn_global_load_lds((const unsigned*)((const char*)(gbase) + (voff)[_i]), (PG8_LAS unsigned*)(lds + (bufoff) + ldsw + _i * 8192), 16, 0, 0); } while (0)
#define PG8_LDA(dst, b, h) do { _Pragma("unroll") for (int m = 0; m < 4; ++m) _Pragma("unroll") for (int k = 0; k < 2; ++k) dst[m][k] = *(const PG8_LAS s16x8*)(lds + PG8_SA(b, h) + aoff + m * 2048 + k * 1024); } while (0)
#define PG8_LDB(dst, b, h) do { _Pragma("unroll") for (int n = 0; n < 2; ++n) _Pragma("unroll") for (int k = 0; k < 2; ++k) dst[n][k] = *(const PG8_LAS s16x8*)(lds + PG8_SB(b, h) + boff + n * 2048 + k * 1024); } while (0)
#define PG8_MMA(ai, bj, At, Bt) do { __builtin_amdgcn_s_setprio(1); _Pragma("unroll") for (int m = 0; m < 4; ++m) _Pragma("unroll") for (int n = 0; n < 2; ++n) _Pragma("unroll") for (int k = 0; k < 2; ++k) \
        acc[ai][bj][m][n] = __builtin_amdgcn_mfma_f32_16x16x32_f16(__builtin_bit_cast(f16x8, Bt[n][k]), __builtin_bit_cast(f16x8, At[m][k]), acc[ai][bj][m][n], 0, 0, 0); __builtin_amdgcn_s_setprio(0); } while (0)
#define PG8_WAIT_V(n) asm volatile("s_waitcnt vmcnt(" #n ")" ::: "memory")
#define PG8_WAIT_VF(f, n) asm volatile("s_cmp_lg_u32 %0, 0\n\ts_cbranch_scc1 .Lpg8wv%=\n\ts_waitcnt vmcnt(8)\n.Lpg8wv%=:\n\ts_waitcnt vmcnt(%1)" :: "s"(f), "n"(n) : "memory", "scc")
#define PG8_WAIT_L(n) asm volatile("s_waitcnt lgkmcnt(" #n ")" ::: "memory")
#define PG8_BAR __builtin_amdgcn_s_barrier()
#define PG8_SCHED __builtin_amdgcn_sched_barrier(0)
    Unit cur, nxt; int ui = 0;
    if (!S.next(0, cur)) return;
    f32x4 acc[2][2][4][2];
#pragma unroll
    for (int a = 0; a < 2; ++a)
#pragma unroll
        for (int b = 0; b < 2; ++b)
#pragma unroll
            for (int m = 0; m < 4; ++m)
#pragma unroll
                for (int n = 0; n < 2; ++n) acc[a][b][m][n] = (f32x4){0.f, 0.f, 0.f, 0.f};
    s16x8 At[4][2], B0[2][2], B1[2][2];
    const char* cA = (const char*)g.A + (size_t)cur.pm * tstep; const char* cB = (const char*)g.Bt + (size_t)cur.pn * tstep;
    S.a_ready(cur);
    if constexpr (SP2) {
        PG8_STAGE(PG8_SB(0, 0), cB, voffB); PG8_STAGE(PG8_SB(0, 1), cB + hstep, voffB); PG8_STAGE(PG8_SA(0, 0), cA, voffA); PG8_STAGE(PG8_SA(0, 1), cA + hstep, voffA);
        if (wr == 1) PG8_BAR;
        PG8_WAIT_V(2); PG8_BAR;
        PG8_STAGE(PG8_SB(1, 0), cB + kstep, voffB); PG8_STAGE(PG8_SA(1, 0), cA + kstep, voffA); PG8_STAGE(PG8_SB(1, 1), cB + hstep + kstep, voffB);
        PG8_WAIT_V(6); PG8_BAR;
    } else {
        PG8_STAGE(PG8_SB(0, 0), cB, voffB); PG8_STAGE(PG8_SA(0, 0), cA, voffA); PG8_STAGE(PG8_SB(0, 1), cB + hstep, voffB); PG8_STAGE(PG8_SA(0, 1), cA + hstep, voffA);
        if (wr == 1) PG8_BAR;
        PG8_WAIT_V(4); PG8_BAR;
        PG8_STAGE(PG8_SB(1, 0), cB + kstep, voffB); PG8_STAGE(PG8_SA(1, 0), cA + kstep, voffA); PG8_STAGE(PG8_SB(1, 1), cB + hstep + kstep, voffB);
        PG8_WAIT_V(6); PG8_BAR;
    }
    for (;;) {
        const bool has_next = S.next(ui + 1, nxt);
        const char* nA = has_next ? (const char*)g.A + (size_t)nxt.pm * tstep : cA; const char* nB = has_next ? (const char*)g.Bt + (size_t)nxt.pn * tstep : cB;
        for (int t = 0; t < nt; t += 2) {
            const bool last = (t == nt - 2);
            const char* a1 = cA + (size_t)(t + 1) * kstep;
            const char* a2 = last ? nA : cA + (size_t)(t + 2) * kstep; const char* b2 = last ? nB : cB + (size_t)(t + 2) * kstep;
            const char* a3 = a2 + kstep; const char* b3 = b2 + kstep;
            if (last && has_next) S.a_ready(nxt);
            const int fe = __builtin_amdgcn_readfirstlane(((t == 0) && (ui > 0)) ? 1 : 0);
            if constexpr (SP2) {
            PG8_LDB(B0, 0, 0); PG8_LDB(B1, 0, 1); PG8_SCHED; PG8_LDA(At, 0, 0); PG8_STAGE(PG8_SA(1, 1), a1 + hstep, voffA);
            PG8_WAIT_VF(fe, 8 + Epi::NSTORE); PG8_WAIT_L(0); PG8_BAR; PG8_MMA(0, 0, At, B0); PG8_MMA(0, 1, At, B1); PG8_BAR; PG8_SCHED;
            PG8_LDA(At, 0, 1); PG8_STAGE(PG8_SB(0, 0), b2, voffB); PG8_STAGE(PG8_SB(0, 1), b2 + hstep, voffB); PG8_STAGE(PG8_SA(0, 0), a2, voffA);
            PG8_WAIT_VF(fe, 8 + Epi::NSTORE); PG8_WAIT_L(0); PG8_BAR; PG8_MMA(1, 0, At, B0); PG8_MMA(1, 1, At, B1); PG8_BAR; PG8_SCHED;
            PG8_LDB(B0, 1, 0); PG8_LDB(B1, 1, 1); PG8_SCHED; PG8_LDA(At, 1, 0); PG8_STAGE(PG8_SA(0, 1), a2 + hstep, voffA);
            PG8_WAIT_V(8); PG8_WAIT_L(0); PG8_BAR; PG8_MMA(0, 0, At, B0); PG8_MMA(0, 1, At, B1); PG8_BAR; PG8_SCHED;
            PG8_LDA(At, 1, 1); PG8_STAGE(PG8_SB(1, 0), b3, voffB); PG8_STAGE(PG8_SB(1, 1), b3 + hstep, voffB); PG8_STAGE(PG8_SA(1, 0), a3, voffA);
            PG8_WAIT_V(8); PG8_WAIT_L(0); PG8_BAR; PG8_MMA(1, 0, At, B0); PG8_MMA(1, 1, At, B1); PG8_BAR; PG8_SCHED;
            } else {
            PG8_LDB(B0, 0, 0); PG8_SCHED; PG8_LDA(At, 0, 0); PG8_STAGE(PG8_SA(1, 1), a1 + hstep, voffA);
            PG8_WAIT_L(8); PG8_BAR; PG8_WAIT_L(0); PG8_MMA(0, 0, At, B0); PG8_BAR; PG8_SCHED;
            PG8_LDB(B1, 0, 1); PG8_STAGE(PG8_SB(0, 0), b2, voffB);
            PG8_BAR; PG8_WAIT_L(0); PG8_MMA(0, 1, At, B1); PG8_BAR;
            PG8_LDA(At, 0, 1); PG8_STAGE(PG8_SA(0, 0), a2, voffA);
            PG8_BAR; PG8_WAIT_L(0); PG8_MMA(1, 0, At, B0); PG8_BAR; PG8_SCHED;
            PG8_STAGE(PG8_SB(0, 1), b2 + hstep, voffB);
            PG8_WAIT_V(6); PG8_BAR; PG8_MMA(1, 1, At, B1); PG8_BAR;
            PG8_LDB(B0, 1, 0); PG8_SCHED; PG8_LDA(At, 1, 0); PG8_STAGE(PG8_SA(0, 1), a2 + hstep, voffA);
            PG8_WAIT_L(8); PG8_BAR; PG8_WAIT_L(0); PG8_MMA(0, 0, At, B0); PG8_BAR; PG8_SCHED;
            PG8_LDB(B1, 1, 1); PG8_STAGE(PG8_SB(1, 0), b3, voffB);
            PG8_BAR; PG8_WAIT_L(0); PG8_MMA(0, 1, At, B1); PG8_BAR;
            PG8_LDA(At, 1, 1); PG8_STAGE(PG8_SA(1, 0), a3, voffA);
            PG8_BAR; PG8_WAIT_L(0); PG8_MMA(1, 0, At, B0); PG8_BAR; PG8_SCHED;
            PG8_STAGE(PG8_SB(1, 1), b3 + hstep, voffB);
            PG8_WAIT_V(6); PG8_BAR; PG8_MMA(1, 1, At, B1); PG8_BAR;
            }
        }
        if constexpr (ALIGN_EPI) { if (wr == 0) PG8_BAR; }
        if constexpr (!Epi::AFTER_DRAIN) { E(acc, cur, wr, wc, fr, fq); S.done(cur); }
        if (!has_next) break;
#pragma unroll
        for (int a = 0; a < 2; ++a)
#pragma unroll
            for (int b = 0; b < 2; ++b)
#pragma unroll
                for (int m = 0; m < 4; ++m)
#pragma unroll
                    for (int n = 0; n < 2; ++n) acc[a][b][m][n] = (f32x4){0.f, 0.f, 0.f, 0.f};
        cur = nxt; cA = nA; cB = nB; ++ui;
        if constexpr (ALIGN_EPI) { if (wr == 1) PG8_BAR; }
    }
    PG8_WAIT_V(0);
    if constexpr (!ALIGN_EPI) { if (wr == 0) PG8_BAR; }
    PG8_BAR;
#undef PG8_SA
#undef PG8_SB
#undef PG8_STAGE
#undef PG8_LDA
#undef PG8_LDB
#undef PG8_MMA
#undef PG8_WAIT_V
#undef PG8_WAIT_VF
#undef PG8_WAIT_L
#undef PG8_BAR
#undef PG8_SCHED
}
}
constexpr size_t WS_WIN = 442 * MiB;
constexpr size_t WS_WOUT = 457 * MiB;
constexpr size_t WS_W1 = 461 * MiB;
constexpr size_t WS_W2 = 483 * MiB;
constexpr size_t WS_VTG = 496 * MiB;
constexpr size_t WS_CW16 = 509 * MiB;
constexpr size_t WS_END2 = 510 * MiB;
constexpr size_t WS_CBIAS = 512 * 1024;
constexpr size_t WS_KC16 = 1 * MiB;
constexpr size_t WS_VC16 = 1 * MiB + 512 * 1024;
constexpr size_t WS_W1C = 3 * MiB;
constexpr size_t WS_LRW0 = 2 * MiB;
constexpr int LRW_L0 = 384 * 64 * 2 + 384 * 128;
constexpr int NIN_PAD = 3584, NFF2 = 2 * DFF;
constexpr size_t WS_WSM = 508 * MiB;
constexpr int LDS_BYTES = 163840;
constexpr size_t WS_BAR = 400 * 1024;
constexpr int L_BARST = LDS_BYTES - 16;
constexpr size_t WS_QCTR = WS_BAR + 14336;
constexpr int L_QSLOT = LDS_BYTES - 32;
#define LAS __attribute__((address_space(3)))

struct Args { const float* in[37]; float* out; unsigned char* ws; int ph_lo, ph_hi; };

__device__ __forceinline__ int win_src_col(int nd) {
    if (nd < 320) return nd;
    const int c = nd - 320;
    if (c < 320) return c + 320;
    if (c < 3264) return c + 332;
    if (c < 3276) return c - 2624;
    if (c < 3288) return c + 320;
    return -1;
}
__device__ __forceinline__ int wsm_src_col(int r) { return r < 12 ? 640 + r : (r < 18 ? 3596 + (r - 12) : (r < 24 ? 3602 + (r - 18) : -1)); }
__device__ __forceinline__ void transpose_item(const float* cp, int ns, int K, h16* WT, int k0, int n0, LAS float* scr, int lane) {
    float tv[32];
#pragma unroll
    for (int i = 0; i < 32; ++i) { const int kk = 2 * i + (lane >> 5); tv[i] = cp ? __builtin_nontemporal_load(cp + (size_t)(k0 + kk) * ns) : 0.f; }
#pragma unroll
    for (int i = 0; i < 32; ++i) { const int kk = 2 * i + (lane >> 5); scr[kk * 33 + (lane & 31)] = tv[i]; }
    asm volatile("s_waitcnt lgkmcnt(0)" ::: "memory");
    const int c = lane & 7;
#pragma unroll
    for (int j = 0; j < 4; ++j) { const int n = (lane >> 3) + 8 * j; const LAS float* s = scr + (8 * c) * 33 + n;
        pg8::u32x4 o; o.x = pg8::pk_f16(s[0 * 33], s[1 * 33]); o.y = pg8::pk_f16(s[2 * 33], s[3 * 33]); o.z = pg8::pk_f16(s[4 * 33], s[5 * 33]); o.w = pg8::pk_f16(s[6 * 33], s[7 * 33]);
        *(pg8::u32x4*)(WT + (size_t)(n0 + n) * K + k0 + 8 * c) = o; }
    asm volatile("s_waitcnt lgkmcnt(0)" ::: "memory");
}

__device__ __forceinline__ void prologue_weights(const Args& a, LAS unsigned char* lds, int part) {
    int tid_ = threadIdx.x; asm volatile("" : "+v"(tid_)); const int tid = tid_, lane = tid & 63, wave = __builtin_amdgcn_readfirstlane(tid >> 6);
    const int G = gridDim.x, gw = blockIdx.x * 8 + wave, NGW = G * 8;
    LAS float* scr = (LAS float*)(lds + wave * 16384);
    constexpr int I_IN = 16 * (NIN_PAD / 32), I_OUT = 16 * 32, I_W1 = 16 * (NFF2 / 32), I_W2 = (DFF / 64) * 32, I_L = I_IN + I_OUT + I_W1 + I_W2;
    for (int it = gw; it < 2 * I_L; it += NGW) {
        const int l = it / I_L; int r = it % I_L;
        if ((part == 0) != (l == 0 && r < I_IN)) continue;
        if (r < I_IN) { const int nblk = NIN_PAD / 32, kb = r / nblk, nb = r % nblk; const int sc = win_src_col(nb * 32 + (lane & 31));
            transpose_item(sc >= 0 ? a.in[8] + (size_t)l * D * D_IN + sc : nullptr, D_IN, D, (h16*)(a.ws + WS_WIN) + (size_t)l * NIN_PAD * D, kb * 64, nb * 32, scr, lane); continue; }
        r -= I_IN;
        if (r < I_OUT) { const int kb = r / 32, nb = r % 32;
            transpose_item(a.in[9] + (size_t)l * D * D + nb * 32 + (lane & 31), D, D, (h16*)(a.ws + WS_WOUT) + (size_t)l * D * D, kb * 64, nb * 32, scr, lane); continue; }
        r -= I_OUT;
        if (r < I_W1) { const int nblk = NFF2 / 32, kb = r / nblk, nb = r % nblk; const int nd = nb * 32 + (lane & 31);
            const float* src = (((nd >> 7) & 1) ? a.in[35] : a.in[34]) + (size_t)l * D * DFF + (128 * (nd >> 8) + (nd & 127));
            transpose_item(src, DFF, D, (h16*)(a.ws + WS_W1) + (size_t)l * NFF2 * D, kb * 64, nb * 32, scr, lane); continue; }
        r -= I_W1;
        { const int kb = r / 32, nb = r % 32;
            transpose_item(a.in[36] + (size_t)l * DFF * D + nb * 32 + (lane & 31), D, DFF, (h16*)(a.ws + WS_W2) + (size_t)l * D * DFF, kb * 64, nb * 32, scr, lane); }
    }
}
__device__ __forceinline__ void phase_prologue(const Args& a, LAS unsigned char* lds) {
    int tid_ = threadIdx.x; asm volatile("" : "+v"(tid_)); const int tid = tid_, lane = tid & 63, wave = __builtin_amdgcn_readfirstlane(tid >> 6);
    const int G = gridDim.x, gw = blockIdx.x * 8 + wave, NGW = G * 8;
    LAS float* scr = (LAS float*)(lds + wave * 16384);
    prologue_weights(a, lds, 0);
    for (int i = blockIdx.x * 512 + tid; i < 2 * 5 * 768; i += G * 512) {
        const int l = i / 3840, r = i % 3840; ((h16*)(a.ws + WS_CW16))[i] = (h16)(r < 3072 ? a.in[29][l * 3072 + r] : a.in[30][l * 768 + (r - 3072)]); }
    for (int it = gw; it < 2 * 16; it += NGW) {
        const int l = it >> 4, kb = it & 15; const int sc = wsm_src_col(lane & 31);
        transpose_item(sc >= 0 ? a.in[8] + (size_t)l * D * D_IN + sc : nullptr, D_IN, D, (h16*)(a.ws + WS_WSM) + (size_t)l * 32 * D, kb * 64, 0, scr, lane); }
    for (int it = gw; it < 4 * 64; it += NGW) {
        const int mat = it >> 6, r = it & 63, l = mat >> 1, kv = mat & 1, kb = r >> 1, nb = r & 1;
        transpose_item((kv ? a.in[14] : a.in[12]) + (size_t)l * 2048 * 64 + nb * 32 + (lane & 31), 64, 2048, (h16*)(a.ws + WS_W1C) + (size_t)mat * 64 * 2048, kb * 64, nb * 32, scr, lane);
    }
    for (int it = gw; it < 2 * 48; it += NGW) {
        const int l = it / 48, r = it % 48;
        h16* dst = (h16*)(a.ws + WS_LRW0) + (size_t)l * LRW_L0;
        if (r < 12) transpose_item(a.in[20] + (size_t)l * 64 * C_RW + r * 32 + (lane & 31), C_RW, 64, dst, 0, r * 32, scr, lane);
        else if (r < 24) transpose_item(a.in[22] + (size_t)l * 64 * C_RW + (r - 12) * 32 + (lane & 31), C_RW, 64, dst + 384 * 64, 0, (r - 12) * 32, scr, lane);
        else { const int kb = (r - 24) / 12, nb = (r - 24) % 12; transpose_item(a.in[23] + (size_t)l * 128 * C_RW + nb * 32 + (lane & 31), C_RW, 128, dst + 2 * 384 * 64, kb * 64, nb * 32, scr, lane); }
    }
    if (blockIdx.x >= G - 4) {
        const int u = G - 1 - (int)blockIdx.x, l = u >> 1, kv = u & 1; const float* pe = (kv ? a.in[11] : a.in[10]) + l * 2048 + wave * 256; const float* w1 = (kv ? a.in[14] : a.in[12]) + (size_t)l * 2048 * 64 + (size_t)wave * 256 * 64 + lane;
        float sacc = 0.f;
#pragma unroll 1
        for (int k = 0; k < 256; k += 16) { float wv[16];
#pragma unroll
            for (int j = 0; j < 16; ++j) wv[j] = w1[(size_t)(k + j) * 64];
#pragma unroll
            for (int j = 0; j < 16; ++j) sacc += pe[k + j] * wv[j]; }
        LAS float* bred = (LAS float*)(lds + 8 * 16384);
        bred[wave * 64 + lane] = sacc;
        __syncthreads();
        if (wave == 0) { float t = 0.f;
#pragma unroll
            for (int j = 0; j < 8; ++j) t += bred[j * 64 + lane];
            ((float*)(a.ws + WS_CBIAS))[u * 64 + lane] = t; }
    }
    __syncthreads();
    LAS float* cs = (LAS float*)lds;
    LAS float* red = (LAS float*)(lds + 32768);
    for (int i = tid; i < NB * D; i += 512) { const float v = a.in[1][i]; cs[i] = v / (1.f + __expf(-v)); }
    __syncthreads();
    float* MOD = (float*)(a.ws + WS_MOD);
    for (int u = blockIdx.x; u < 2 * 96; u += G) {
        const int l = u / 96, col = (u % 96) * 64 + (tid & 63), ks = tid >> 6;
        const float* w = a.in[2] + (size_t)l * D * 6 * D + col;
        float acc[8];
#pragma unroll
        for (int b = 0; b < 8; ++b) acc[b] = 0.f;
#pragma unroll 1
        for (int k = ks * 128; k < ks * 128 + 128; k += 16) { float wv[16];
#pragma unroll
            for (int j = 0; j < 16; ++j) wv[j] = w[(size_t)(k + j) * 6 * D];
#pragma unroll
            for (int j = 0; j < 16; ++j)
#pragma unroll
                for (int b = 0; b < 8; ++b) acc[b] += cs[b * D + k + j] * wv[j]; }
#pragma unroll
        for (int b = 0; b < 8; ++b) red[(ks * 8 + b) * 64 + (tid & 63)] = acc[b];
        __syncthreads();
        { const int b = tid >> 6; float s = a.in[3][l * 6 * D + col];
#pragma unroll
          for (int k2 = 0; k2 < 8; ++k2) s += red[(k2 * 8 + b) * 64 + (tid & 63)];
          MOD[((size_t)l * NB + b) * 6 * D + col] = s; }
        __syncthreads();
    }
}

template <bool XH> struct XRaw;
template <> struct XRaw<false> { pg8::f32x4 x[2][2]; };
template <> struct XRaw<true> { pg8::u32x4 x[2]; };
__device__ __forceinline__ void x_load(XRaw<false>& R, const void* base, size_t off) {
#pragma unroll
    for (int j = 0; j < 2; ++j) { const float* p = (const float*)base + off + j * 512; R.x[j][0] = __builtin_nontemporal_load((const pg8::f32x4*)p); R.x[j][1] = __builtin_nontemporal_load((const pg8::f32x4*)(p + 4)); }
}
__device__ __forceinline__ void x_load(XRaw<true>& R, const void* base, size_t off) {
#pragma unroll
    for (int j = 0; j < 2; ++j) R.x[j] = __builtin_nontemporal_load((const pg8::u32x4*)((const h16*)base + off + j * 512));
}
__device__ __forceinline__ float h_lo(unsigned w) { return (float)__builtin_bit_cast(_Float16, (unsigned short)(w & 0xffffu)); }
__device__ __forceinline__ float h_hi(unsigned w) { return (float)__builtin_bit_cast(_Float16, (unsigned short)(w >> 16)); }
__device__ __forceinline__ void h_unpack(const pg8::u32x4 w, float (&o)[8]) { o[0] = h_lo(w.x); o[1] = h_hi(w.x); o[2] = h_lo(w.y); o[3] = h_hi(w.y); o[4] = h_lo(w.z); o[5] = h_hi(w.z); o[6] = h_lo(w.w); o[7] = h_hi(w.w); }
__device__ __forceinline__ void x_unpack(const XRaw<false>& R, int j, float (&o)[8]) {
#pragma unroll
    for (int e = 0; e < 4; ++e) { o[e] = R.x[j][0][e]; o[4 + e] = R.x[j][1][e]; } }
__device__ __forceinline__ void x_unpack(const XRaw<true>& R, int j, float (&o)[8]) { h_unpack(R.x[j], o); }
template <bool XI, bool HASY> struct PostRaw { XRaw<XI> x; pg8::u32x4 y[2]; };
template <bool XI, bool HASY>
__device__ __forceinline__ void post_load(PostRaw<XI, HASY>& R, const void* xold, const h16* y, int tok, int lane) {
    const size_t off = (size_t)tok * D + lane * 8;
    if constexpr (HASY) {
#pragma unroll
        for (int j = 0; j < 2; ++j) R.y[j] = __builtin_nontemporal_load((const pg8::u32x4*)(y + off + j * 512)); }
    x_load(R.x, xold, off);
}
template <bool XI, bool XO, bool HASY, bool HASH>
__device__ __forceinline__ void post_row(const PostRaw<XI, HASY>& R, int tok, int lane, const float (&pa)[2][8], const float (&pb)[2][8], const float (&pc)[2][8], void* xnew, h16* H) {
    float v[2][8]; float s2 = 0.f;
    if constexpr (HASY) {
        float ss = 0.f;
#pragma unroll
        for (int j = 0; j < 2; ++j) { h_unpack(R.y[j], v[j]);
#pragma unroll
            for (int e = 0; e < 8; ++e) ss += v[j][e] * v[j][e]; }
        const float rstd = rsqrtf(wave_sum(ss) * (1.f / D) + 1e-6f);
#pragma unroll
        for (int j = 0; j < 2; ++j) { float xo[8]; x_unpack(R.x, j, xo);
#pragma unroll
            for (int e = 0; e < 8; ++e) { v[j][e] = xo[e] + pa[j][e] * (v[j][e] * rstd); s2 += v[j][e] * v[j][e]; }
            const size_t off = (size_t)tok * D + j * 512 + lane * 8;
            if constexpr (XO) { pg8::u32x4 w; w.x = pg8::pk_f16(v[j][0], v[j][1]); w.y = pg8::pk_f16(v[j][2], v[j][3]); w.z = pg8::pk_f16(v[j][4], v[j][5]); w.w = pg8::pk_f16(v[j][6], v[j][7]); *(pg8::u32x4*)((h16*)xnew + off) = w; }
            else { *(pg8::f32x4*)((float*)xnew + off) = (pg8::f32x4){v[j][0], v[j][1], v[j][2], v[j][3]}; *(pg8::f32x4*)((float*)xnew + off + 4) = (pg8::f32x4){v[j][4], v[j][5], v[j][6], v[j][7]}; } }
    } else {
#pragma unroll
        for (int j = 0; j < 2; ++j) { x_unpack(R.x, j, v[j]);
#pragma unroll
            for (int e = 0; e < 8; ++e) s2 += v[j][e] * v[j][e]; }
    }
    if constexpr (HASH) {
        const float r2 = rsqrtf(wave_sum(s2) * (1.f / D) + 1e-6f);
#pragma unroll
        for (int j = 0; j < 2; ++j) { pg8::u32x4 w;
            w.x = pg8::pk_f16(v[j][0] * r2 * pb[j][0] + pc[j][0], v[j][1] * r2 * pb[j][1] + pc[j][1]); w.y = pg8::pk_f16(v[j][2] * r2 * pb[j][2] + pc[j][2], v[j][3] * r2 * pb[j][3] + pc[j][3]);
            w.z = pg8::pk_f16(v[j][4] * r2 * pb[j][4] + pc[j][4], v[j][5] * r2 * pb[j][5] + pc[j][5]); w.w = pg8::pk_f16(v[j][6] * r2 * pb[j][6] + pc[j][6], v[j][7] * r2 * pb[j][7] + pc[j][7]);
            *(pg8::u32x4*)(H + (size_t)tok * D + j * 512 + lane * 8) = w; }
    }
}
template <bool XI, bool XO, bool HASY, bool HASH, int G>
__device__ __forceinline__ void phase_post(const void* xold, const h16* y, const float* gpost, const float* modl, int gt_off, void* xnew,
                                           const float* gnext, const float* modn, int sh_off, int sc_off, h16* H) {
    int tid_ = threadIdx.x; asm volatile("" : "+v"(tid_)); const int lane = tid_ & 63, gw = blockIdx.x * 8 + (tid_ >> 6), NGW = gridDim.x * 8;
    constexpr int CH = 16;
    static_assert(S % CH == 0 && CH % (2 * G) == 0, "chunking");
    for (int ch = gw; ch < M / CH; ch += NGW) {
        const int tok0 = ch * CH, b = tok0 / S;
        float pa[2][8], pb[2][8], pc[2][8];
#pragma unroll
        for (int j = 0; j < 2; ++j) { const int cc = j * 512 + lane * 8;
#pragma unroll
            for (int hf = 0; hf < 2; ++hf) {
                if constexpr (HASY) { const pg8::f32x4 gp = *(const pg8::f32x4*)(gpost + cc + 4 * hf), gt = *(const pg8::f32x4*)(modl + (size_t)b * 6 * D + gt_off + cc + 4 * hf);
#pragma unroll
                    for (int e = 0; e < 4; ++e) pa[j][4 * hf + e] = gt[e] * gp[e]; }
                if constexpr (HASH) { const float* mn = modn + (size_t)b * 6 * D;
                    const pg8::f32x4 gg = *(const pg8::f32x4*)(gnext + cc + 4 * hf), sc = *(const pg8::f32x4*)(mn + sc_off + cc + 4 * hf), sh = *(const pg8::f32x4*)(mn + sh_off + cc + 4 * hf);
#pragma unroll
                    for (int e = 0; e < 4; ++e) { pb[j][4 * hf + e] = gg[e] * (1.f + sc[e]); pc[j][4 * hf + e] = sh[e]; } }
            } }
        PostRaw<XI, HASY> R0[G], R1[G];
#pragma unroll
        for (int t = 0; t < G; ++t) post_load<XI, HASY>(R0[t], xold, y, tok0 + t, lane);
#pragma unroll 1
        for (int g = 0; g < CH / G; g += 2) {
#pragma unroll
            for (int t = 0; t < G; ++t) post_load<XI, HASY>(R1[t], xold, y, tok0 + (g + 1) * G + t, lane);
#pragma unroll
            for (int t = 0; t < G; ++t) { post_row<XI, XO, HASY, HASH>(R0[t], tok0 + g * G + t, lane, pa, pb, pc, xnew, H); }
            if (g + 2 < CH / G) {
#pragma unroll
                for (int t = 0; t < G; ++t) post_load<XI, HASY>(R0[t], xold, y, tok0 + (g + 2) * G + t, lane); }
#pragma unroll
            for (int t = 0; t < G; ++t) { post_row<XI, XO, HASY, HASH>(R1[t], tok0 + (g + 1) * G + t, lane, pa, pb, pc, xnew, H); }
        }
    }
}

namespace nsa {
typedef _Float16 f16x8 __attribute__((ext_vector_type(8)));
typedef _Float16 f16x4 __attribute__((ext_vector_type(4)));
typedef float f32x4 __attribute__((ext_vector_type(4)));
typedef unsigned u32x4 __attribute__((ext_vector_type(4)));
typedef unsigned u32x2 __attribute__((ext_vector_type(2)));
constexpr int KP = 72;
constexpr int L_KT = 0, L_VT = 36864  , L_OF = 73728, L_IMPA = L_OF  , L_IMPB = L_OF + 64 * 65 * 4, L_MASK = L_OF + 65536, L_END = L_MASK + 512;
static_assert(2 * 64 * 65 * 4 <= 65536 && L_END <= 163840 - 64, "NSA LDS map");
constexpr float QSCALE = 0.125f * 1.4426950408889634f;

struct TileRegs { u32x4 k, v; };
__device__ __forceinline__ TileRegs tile_load(const h16* kbase, int kp, const h16* vbase, int vp, int tid) {
    TileRegs r;
    r.k = *(const u32x4*)(kbase + (size_t)(tid >> 3) * kp + 8 * (tid & 7));
    r.v = *(const u32x4*)(vbase + (size_t)(tid >> 3) * vp + 8 * (tid & 7));
    return r;
}
__device__ __forceinline__ void tile_store(LAS unsigned char* lds, int buf  , const TileRegs& r, int tid) {
    LAS h16* kt = (LAS h16*)(lds + L_KT) + buf * 64 * KP;
    *(LAS u32x4*)(kt + (tid >> 3) * KP + 8 * (tid & 7)) = r.k;
    LAS h16* vt = (LAS h16*)(lds + L_VT) + buf * 64 * KP;
    *(LAS u32x4*)(vt + (tid >> 3) * KP + 8 * (tid & 7)) = r.v;
}
__device__ __forceinline__ void tile_load_async(TileRegs& r, const h16* kbase, int kp, const h16* vbase, int vp, int tid) {
    const h16* ka = kbase + (size_t)(tid >> 3) * kp + 8 * (tid & 7); const h16* va = vbase + (size_t)(tid >> 3) * vp + 8 * (tid & 7);
    asm volatile("global_load_dwordx4 %0, %1, off" : "=v"(r.k) : "v"(ka) : "memory");
    asm volatile("global_load_dwordx4 %0, %1, off" : "=v"(r.v) : "v"(va) : "memory");
}
template <int N> __device__ __forceinline__ void tile_wait(TileRegs& r) {
    if (N == 2) asm volatile("s_waitcnt vmcnt(2)" : "+v"(r.k), "+v"(r.v) :: "memory"); else asm volatile("s_waitcnt vmcnt(0)" : "+v"(r.k), "+v"(r.v) :: "memory");
}
__device__ __forceinline__ float max_x16(float v) { return fmaxf(v, __shfl_xor(v, 16)); }
__device__ __forceinline__ float max_x32(float v) { return fmaxf(v, __shfl_xor(v, 32)); }
__device__ __forceinline__ float sum_x16(float v) { return v + __shfl_xor(v, 16); }
__device__ __forceinline__ float sum_x32(float v) { return v + __shfl_xor(v, 32); }
template <int CTRL> __device__ __forceinline__ float dpp_mv(float v) { return __builtin_bit_cast(float, __builtin_amdgcn_update_dpp(0, __builtin_bit_cast(int, v), CTRL, 0xF, 0xF, true)); }
__device__ __forceinline__ float sum_quad(float v) { v += __shfl_xor(v, 1); v += __shfl_xor(v, 2); return v; }
__device__ __forceinline__ f32x4 mfma16(f16x8 a, f16x8 b, f32x4 c) { return __builtin_amdgcn_mfma_f32_16x16x32_f16(a, b, c, 0, 0, 0); }

__device__ __forceinline__ void qk_tiles(const LAS h16* kt_lds, const f16x8 (&qf)[2][2], int c, int g, f32x4 (&sc)[2][4]) {
    f16x8 kf[4][2];
#pragma unroll
    for (int kt = 0; kt < 4; ++kt) { kf[kt][0] = *(const LAS f16x8*)(kt_lds + (16 * kt + c) * KP + 8 * g); kf[kt][1] = *(const LAS f16x8*)(kt_lds + (16 * kt + c) * KP + 32 + 8 * g); }
#pragma unroll
    for (int kt = 0; kt < 4; ++kt)
#pragma unroll
        for (int qi = 0; qi < 2; ++qi) { f32x4 a = {0.f, 0.f, 0.f, 0.f}; a = mfma16(kf[kt][0], qf[qi][0], a); a = mfma16(kf[kt][1], qf[qi][1], a); sc[qi][kt] = a; }
}
__device__ __forceinline__ void pv_tiles(const LAS h16* vt_lds, const f32x4 (&p)[2][4], int c, int g, f32x4 (&o)[4][2]) {
    f16x4 vlo[2][4], vhi[2][4];
#pragma unroll
    for (int kk = 0; kk < 2; ++kk)
#pragma unroll
        for (int dt = 0; dt < 4; ++dt) { vlo[kk][dt] = *(const LAS f16x4*)(vt_lds + (16 * dt + c) * KP + 32 * kk + 4 * g); vhi[kk][dt] = *(const LAS f16x4*)(vt_lds + (16 * dt + c) * KP + 32 * kk + 16 + 4 * g); }
#pragma unroll
    for (int kk = 0; kk < 2; ++kk) {
        f16x8 bf[2];
#pragma unroll
        for (int qi = 0; qi < 2; ++qi) { const f32x4 a = p[qi][2 * kk], b = p[qi][2 * kk + 1];
            bf[qi] = (f16x8){(_Float16)a[0], (_Float16)a[1], (_Float16)a[2], (_Float16)a[3], (_Float16)b[0], (_Float16)b[1], (_Float16)b[2], (_Float16)b[3]}; }
#pragma unroll
        for (int dt = 0; dt < 4; ++dt) {
            const f16x4 v0 = vlo[kk][dt], v1 = vhi[kk][dt];
            const f16x8 a = (f16x8){v0[0], v0[1], v0[2], v0[3], v1[0], v1[1], v1[2], v1[3]};
#pragma unroll
            for (int qi = 0; qi < 2; ++qi) o[dt][qi] = mfma16(a, bf[qi], o[dt][qi]);
        }
    }
}
__device__ __forceinline__ void apply_mask(f32x4 (&sc)[4], int mode, int lim) {
    if (mode == 1) {
#pragma unroll
        for (int kt = 0; kt < 4; ++kt)
#pragma unroll
            for (int r = 0; r < 4; ++r) sc[kt][r] = (16 * kt + r <= lim) ? sc[kt][r] : -1e30f;
    } else if (mode == 2) {
#pragma unroll
        for (int kt = 0; kt < 4; ++kt)
#pragma unroll
            for (int r = 0; r < 4; ++r) sc[kt][r] = (16 * kt + r > lim) ? sc[kt][r] : -1e30f;
    }
}
typedef float f32x2 __attribute__((ext_vector_type(2)));
__device__ __forceinline__ float max3f(float a, float b, float c) { float r; asm("v_max3_f32 %0, %1, %2, %3" : "=v"(r) : "v"(a), "v"(b), "v"(c)); return r; }
__device__ __forceinline__ void softmax_step(f32x4 (&sc)[4], bool row_on, float& m, float& l, float& f_out) {
    float mx = max3f(sc[0][0], sc[0][1], sc[0][2]);
    mx = max3f(mx, sc[0][3], sc[1][0]); mx = max3f(mx, sc[1][1], sc[1][2]); mx = max3f(mx, sc[1][3], sc[2][0]); mx = max3f(mx, sc[2][1], sc[2][2]);
    mx = max3f(mx, sc[2][3], sc[3][0]); mx = max3f(mx, sc[3][1], sc[3][2]); mx = fmaxf(mx, sc[3][3]);
    mx = row_on ? mx : -1e30f;
    mx = max_x16(mx); mx = max_x32(mx);
    const float mn = fmaxf(m, mx), f = __builtin_amdgcn_exp2f(m - mn), mu = row_on ? fmaxf(mn, -1e20f) : 1e30f;
    const f32x2 mu2 = {mu, mu};
    f32x2 sum2 = {0.f, 0.f};
#pragma unroll
    for (int kt = 0; kt < 4; ++kt) {
        f32x2 a = (f32x2){sc[kt][0], sc[kt][1]} - mu2, b = (f32x2){sc[kt][2], sc[kt][3]} - mu2;
        a.x = __builtin_amdgcn_exp2f(a.x); a.y = __builtin_amdgcn_exp2f(a.y); b.x = __builtin_amdgcn_exp2f(b.x); b.y = __builtin_amdgcn_exp2f(b.y);
        sc[kt] = (f32x4){a.x, a.y, b.x, b.y}; sum2 = sum2 + a; sum2 = sum2 + b;
    }
    l = l * f + (sum2.x + sum2.y); m = mn; f_out = f;
}

struct AttnArgs { const h16* QK32; const h16* P16; const h16* KC; const h16* VCT;   const h16* VTG;   const float* gate_b; const float* out_g; h16* O16; };

__device__ __forceinline__ void attn_item(const AttnArgs& A, int b, int qt, LAS unsigned char* lds) {
    int tid_ = threadIdx.x; asm volatile("" : "+v"(tid_)); const int tid = tid_, lane = tid & 63, w = tid >> 6, c = lane & 15, g = lane >> 4;
    const size_t tok0 = (size_t)b * S + 64 * qt;
    LAS float* impa = (LAS float*)(lds + L_IMPA); LAS float* impb = (LAS float*)(lds + L_IMPB);
    LAS unsigned char* maskb = lds + L_MASK;
    LAS f32x4* ofl = (LAS f32x4*)(lds + L_OF);
    const LAS h16* KT = (const LAS h16*)(lds + L_KT); const LAS h16* VT = (const LAS h16*)(lds + L_VT);
    int tl[2]; f16x8 qf[2][2];
    const int hh = c & 3;
#pragma unroll
    for (int qi = 0; qi < 2; ++qi) {
        tl[qi] = 8 * w + 4 * qi + (c >> 2);
        const h16* qp = A.QK32 + (tok0 + tl[qi]) * QKP + hh * 64 + 8 * g;
#pragma unroll
        for (int ks = 0; ks < 2; ++ks) qf[qi][ks] = *(const f16x8*)(qp + 32 * ks);
    }
    for (int i = tid; i < 64 * 65; i += 512) { impa[i] = 0.f; impb[i] = 0.f; }
    const int nblk_c = (4 * qt + 3 + 63) >> 6;
    int nvis[2];
#pragma unroll
    for (int qi = 0; qi < 2; ++qi) { const int s = 64 * qt + tl[qi]; nvis[qi] = (s >= 31) ? ((s - 31) / 16 + 1) : 0; }
    const h16* kcb = A.KC + (size_t)b * 256 * 64; const h16* vcb = A.VCT + (size_t)b * 64 * 256;
    float m_c[2] = {-1e30f, -1e30f}, l_c[2] = {0.f, 0.f};
    f32x4 ofin[4][2];
#pragma unroll
    for (int dt = 0; dt < 4; ++dt)
#pragma unroll
        for (int qi = 0; qi < 2; ++qi) ofin[dt][qi] = (f32x4){0.f, 0.f, 0.f, 0.f};
    float glog[2][3];
#pragma unroll
    for (int qi = 0; qi < 2; ++qi) { const h16* gp = A.P16 + (tok0 + tl[qi]) * PITCH + PC_GTS; glog[qi][0] = (float)gp[hh]; glog[qi][1] = (float)gp[4 + hh]; glog[qi][2] = (float)gp[8 + hh]; }
    {
        TileRegs r[4];
#pragma unroll
        for (int u = 0; u < 4; ++u) if (u < nblk_c) r[u] = tile_load(kcb + (size_t)u * 64 * 64, 64, vcb + u * 64, 256, tid);
#pragma unroll
        for (int u = 0; u < 4; ++u) if (u < nblk_c) tile_store(lds, u, r[u], tid);
    }
    __syncthreads();
#pragma unroll 1
    for (int pass = 0; pass < 2; ++pass) {
        float inv_l[2];
        if (pass == 1) {
#pragma unroll
            for (int qi = 0; qi < 2; ++qi) { float lt = l_c[qi]; lt = sum_x16(lt); lt = sum_x32(lt); inv_l[qi] = lt > 0.f ? 1.f / lt : 0.f; }
        }
#pragma unroll 1
        for (int blk = 0; blk < nblk_c; ++blk) {
            f32x4 sc[2][4];
            qk_tiles(KT + blk * 64 * KP, qf, c, g, sc);
#pragma unroll
            for (int qi = 0; qi < 2; ++qi) {
                apply_mask(sc[qi], 1, nvis[qi] - 1 - 64 * blk - 4 * g);
                if (pass == 0) { float f; softmax_step(sc[qi], true, m_c[qi], l_c[qi], f); }
                else {
                    const float mu = fmaxf(m_c[qi], -1e20f);
#pragma unroll
                    for (int kt = 0; kt < 4; ++kt) {
#pragma unroll
                        for (int r = 0; r < 4; ++r) sc[qi][kt][r] = __builtin_amdgcn_exp2f(sc[qi][kt][r] - mu) * inv_l[qi];
                        float e0 = (sc[qi][kt][0] + sc[qi][kt][1]) + (sc[qi][kt][2] + sc[qi][kt][3]), e1 = sc[qi][kt][3];
                        e0 = sum_quad(e0); e1 = sum_quad(e1);
                        const int jj = 16 * blk + 4 * kt + g;
                        if (hh == 0) { impa[tl[qi] * 65 + jj] = e0; if (jj + 1 < 64) impb[tl[qi] * 65 + jj + 1] = e1; }
                    }
                }
            }
            if (pass == 1) pv_tiles(VT + blk * 64 * KP, sc, c, g, ofin);
        }
    }
    __syncthreads();
    {
        const int t = tid >> 3, jg = tid & 7;
        unsigned long long key[8];
#pragma unroll
        for (int i = 0; i < 8; ++i) { const int j = 8 * jg + i; const float imp = impa[t * 65 + j] + impb[t * 65 + j];
            const bool forced = (j == 0) || (j == qt) || (j == qt - 1); const float scv = forced ? 1e9f : (j <= qt ? imp : -1e30f);
            const unsigned fb = __builtin_bit_cast(unsigned, scv), ob = (fb & 0x80000000u) ? ~fb : (fb | 0x80000000u);
            key[i] = ((unsigned long long)ob << 32) | (unsigned)(63 - j); }
        __syncthreads();
        LAS unsigned long long* keys = (LAS unsigned long long*)(lds + L_IMPA);
#pragma unroll
        for (int i = 0; i < 8; ++i) keys[t * 65 + 8 * jg + i] = key[i];
        __syncthreads();
        int rank[8];
#pragma unroll
        for (int i = 0; i < 8; ++i) rank[i] = 0;
        for (int j2 = 0; j2 < 64; ++j2) { const unsigned long long k2 = keys[t * 65 + j2];
#pragma unroll
            for (int i = 0; i < 8; ++i) rank[i] += (k2 > key[i]) ? 1 : 0; }
        unsigned bits = 0;
#pragma unroll
        for (int i = 0; i < 8; ++i) bits |= ((rank[i] < 16 && (8 * jg + i) <= qt) ? 1u : 0u) << i;
        maskb[t * 8 + jg] = (unsigned char)bits;
    }
    __syncthreads();
    unsigned mlo[2], mhi[2];
#pragma unroll
    for (int qi = 0; qi < 2; ++qi) { const LAS unsigned* mp = (const LAS unsigned*)(lds + L_MASK) + 2 * tl[qi]; mlo[qi] = mp[0]; mhi[qi] = mp[1]; }
    float gsel[2], gwin[2];
#pragma unroll
    for (int qi = 0; qi < 2; ++qi) {
        const float g0 = __builtin_amdgcn_rcpf(1.f + __expf(-(glog[qi][0] + A.gate_b[hh])));
        gsel[qi] = __builtin_amdgcn_rcpf(1.f + __expf(-(glog[qi][1] + A.gate_b[4 + hh])));
        gwin[qi] = __builtin_amdgcn_rcpf(1.f + __expf(-(glog[qi][2] + A.gate_b[8 + hh])));
#pragma unroll
        for (int dt = 0; dt < 4; ++dt) ofl[(dt * 2 + qi) * 512 + tid] = ofin[dt][qi] * g0;
    }
    const h16* Pb = A.P16 + (size_t)b * S * PITCH;
    const int jw0 = qt >= 8 ? qt - 8 : 0;
#pragma unroll 1
    for (int br = 0; br < 2; ++br) {
        const bool win = br == 1;
        const int j0 = win ? jw0 : 0, nsteps = qt - j0 + 1, kcol = win ? PC_KW : PC_KS;
        const h16* Vb = A.VTG + ((size_t)b * 2 + br) * 64 * S;
        float m_b[2] = {-1e30f, -1e30f}, l_b[2] = {0.f, 0.f};
        f32x4 o_b[4][2];
#pragma unroll
        for (int dt = 0; dt < 4; ++dt)
#pragma unroll
            for (int qi = 0; qi < 2; ++qi) o_b[dt][qi] = (f32x4){0.f, 0.f, 0.f, 0.f};
        TileRegs R[4];
#define NSA_LOADG(G0) do { _Pragma("unroll") for (int u = 0; u < 4; ++u) if ((G0) + u < nsteps) R[u] = tile_load(Pb + (size_t)(j0 + (G0) + u) * 64 * PITCH + kcol, PITCH, Vb + 64 * (j0 + (G0) + u), S, tid); } while (0)
#define NSA_STOREG(G0) do { _Pragma("unroll") for (int u = 0; u < 4; ++u) if ((G0) + u < nsteps) tile_store(lds, u, R[u], tid); } while (0)
        NSA_LOADG(0); NSA_STOREG(0);
        __syncthreads();
#pragma unroll 1
        for (int g0 = 0; g0 < nsteps; g0 += 4) {
            NSA_LOADG(g0 + 4);
#pragma unroll
            for (int u = 0; u < 4; ++u) {
                if (g0 + u < nsteps) {
                    const int jb = j0 + g0 + u;
                    f32x4 sc[2][4];
                    qk_tiles(KT + u * 64 * KP, qf, c, g, sc);
                    const int mode = (jb == qt) ? 1 : ((win && jb == qt - 8) ? 2 : 0);
#pragma unroll
                    for (int qi = 0; qi < 2; ++qi) {
                        const bool selb = win ? true : ((jb < 32) ? ((mlo[qi] >> jb) & 1u) : ((mhi[qi] >> (jb - 32)) & 1u));
                        apply_mask(sc[qi], mode, tl[qi] - 4 * g);
                        float f;
                        softmax_step(sc[qi], selb, m_b[qi], l_b[qi], f);
                        if (__any(f != 1.f)) {
#pragma unroll
                            for (int dt = 0; dt < 4; ++dt) o_b[dt][qi] = o_b[dt][qi] * f; }
                    }
                    pv_tiles(VT + u * 64 * KP, sc, c, g, o_b);
                }
            }
            __syncthreads();
            if (g0 + 4 < nsteps) { NSA_STOREG(g0 + 4); __syncthreads(); }
        }
#undef NSA_LOADG
#undef NSA_STOREG
#pragma unroll
        for (int qi = 0; qi < 2; ++qi) {
            float lb = l_b[qi]; lb = sum_x16(lb); lb = sum_x32(lb);
            const float cb = (win ? gwin[qi] : gsel[qi]) / lb;
#pragma unroll
            for (int dt = 0; dt < 4; ++dt) ofl[(dt * 2 + qi) * 512 + tid] = ofl[(dt * 2 + qi) * 512 + tid] + o_b[dt][qi] * cb;
        }
    }
#pragma unroll
    for (int qi = 0; qi < 2; ++qi) {
        float ss = 0.f;
#pragma unroll
        for (int dt = 0; dt < 4; ++dt) ofin[dt][qi] = ofl[(dt * 2 + qi) * 512 + tid];
#pragma unroll
        for (int dt = 0; dt < 4; ++dt)
            ss += (ofin[dt][qi][0] * ofin[dt][qi][0] + ofin[dt][qi][1] * ofin[dt][qi][1]) + (ofin[dt][qi][2] * ofin[dt][qi][2] + ofin[dt][qi][3] * ofin[dt][qi][3]);
        ss = sum_x16(ss); ss = sum_x32(ss); ss = sum_quad(ss);
        const float rstd = rsqrtf(ss * (1.f / 256.f) + 1e-6f);
        h16* op = A.O16 + (tok0 + tl[qi]) * D + hh * 64;
#pragma unroll
        for (int dt = 0; dt < 4; ++dt) { const int d0 = 16 * dt + 4 * g; const f32x4 gg = *(const f32x4*)(A.out_g + hh * 64 + d0);
            u32x2 wv; wv.x = pg8::pk_f16(ofin[dt][qi][0] * rstd * gg[0], ofin[dt][qi][1] * rstd * gg[1]); wv.y = pg8::pk_f16(ofin[dt][qi][2] * rstd * gg[2], ofin[dt][qi][3] * rstd * gg[3]);
            *(u32x2*)(op + d0) = wv; }
    }
    __syncthreads();
}

struct CmpArgs { const h16* QK32; const h16* P16; const h16* W1T;   const float* bias;   const float* w2k; const float* w2v; h16* KC; h16* VC; };
constexpr int TP = 72;
__device__ __forceinline__ void compress_item(const CmpArgs& A, int b, int kv, int ng, LAS unsigned char* lds) {
    int tid_ = threadIdx.x; asm volatile("" : "+v"(tid_)); const int tid = tid_, lane = tid & 63, w = tid >> 6, c = lane & 15, g = lane >> 4;
    LAS h16* TOK = (LAS h16*)lds;
    LAS float* RED = (LAS float*)(lds + 272 * TP * 2);
    LAS float* HID = RED + 2 * 16 * 64;
    const int t0 = 256 * ng;
    for (int e = tid; e < 272 * 8; e += 512) {
        const int t = e >> 3, ch = e & 7; const int tok = t0 + t;
        u32x4 v = {0u, 0u, 0u, 0u};
        if (tok < S) {
            if (kv == 0) v = *(const u32x4*)(A.QK32 + ((size_t)b * S + tok) * QKP + 256 + 8 * ch);
            else v = *(const u32x4*)(A.P16 + ((size_t)b * S + tok) * PITCH + PC_VC + 8 * ch);
        }
        *(LAS u32x4*)(TOK + t * TP + 8 * ch) = v;
    }
    __syncthreads();
    {
        const int nt = w & 3, kh = w >> 2;
        const h16* wb = A.W1T + ((size_t)kv * 64 + 16 * nt + c) * 2048 + 8 * g;
        f32x4 acc = {0.f, 0.f, 0.f, 0.f};
#pragma unroll 1
        for (int k8 = 32 * kh; k8 < 32 * kh + 32; k8 += 8) {
            f16x8 bw[8];
#pragma unroll
            for (int u = 0; u < 8; ++u) bw[u] = *(const f16x8*)(wb + 32 * (k8 + u));
#pragma unroll
            for (int u = 0; u < 8; ++u) { const int ks = k8 + u;
                const f16x8 a = *(const LAS f16x8*)(TOK + (16 * c + (ks >> 1)) * TP + 32 * (ks & 1) + 8 * g);
                acc = mfma16(a, bw[u], acc); }
        }
#pragma unroll
        for (int r = 0; r < 4; ++r) RED[(kh * 16 + 4 * g + r) * 64 + 16 * nt + c] = acc[r];
    }
    __syncthreads();
    for (int e = tid; e < 1024; e += 512) { const int n = e >> 6, j = e & 63; const float x = RED[n * 64 + j] + RED[(16 + n) * 64 + j] + A.bias[kv * 64 + j];
        HID[n * 64 + j] = 0.5f * x * (1.f + tanhf(0.7978845608028654f * (x + 0.044715f * x * x * x))); }
    __syncthreads();
    const float* w2 = kv == 0 ? A.w2k : A.w2v; h16* outp = kv == 0 ? A.KC : A.VC;
    for (int e = tid; e < 1024; e += 512) { const int n = e >> 6, j = e & 63; float s = 0.f;
        for (int i = 0; i < 64; ++i) s += HID[n * 64 + i] * w2[i * 64 + j];
        const int nn = 16 * ng + n;
        const h16 ov = (nn < NCMP) ? (h16)s : (h16)0.f;
        if (kv == 0) outp[((size_t)b * 256 + nn) * 64 + j] = ov; else outp[((size_t)b * 64 + j) * 256 + nn] = ov; }
    __syncthreads();
}
}
namespace mls {
using nsa::f16x8; using nsa::f32x4; using nsa::u32x4; using nsa::u32x2; using nsa::mfma16;
constexpr int KP = 72;
#define LDS_BAR() do { asm volatile("s_waitcnt lgkmcnt(0)" ::: "memory"); __builtin_amdgcn_s_barrier(); asm volatile("" ::: "memory"); } while (0)
constexpr size_t WS_KVB = WS_Y32;
constexpr size_t WS_KSUM = WS_Y32 + 48 * MiB;
constexpr size_t WS_MUB = WS_KSUM + 1 * MiB;
constexpr size_t WS_GT = 505 * MiB;
struct Args { const h16* P16; const float *conv_w, *conv_b, *ig_b, *fg_b, *norm_g; float* KVB; float* KSUM; float* MUB; h16* O16; float* GT; const h16* CW16; };

__device__ __forceinline__ void mm64(const LAS h16* A, const LAS h16* Bt, int w, int c, int g, f32x4 (&acc)[2]) {
    const int mi = w >> 1;
    const f16x8 a0 = *(const LAS f16x8*)(A + (16 * mi + c) * KP + 8 * g), a1 = *(const LAS f16x8*)(A + (16 * mi + c) * KP + 32 + 8 * g);
#pragma unroll
    for (int n = 0; n < 2; ++n) { const int ni = 2 * (w & 1) + n;
        const f16x8 b0 = *(const LAS f16x8*)(Bt + (16 * ni + c) * KP + 8 * g), b1 = *(const LAS f16x8*)(Bt + (16 * ni + c) * KP + 32 + 8 * g);
        acc[n] = mfma16(a0, b0, acc[n]); acc[n] = mfma16(a1, b1, acc[n]); }
}
__device__ __forceinline__ float half_lo(unsigned u) { return (float)__builtin_bit_cast(_Float16, (unsigned short)(u & 0xffffu)); }
__device__ __forceinline__ float half_hi(unsigned u) { return (float)__builtin_bit_cast(_Float16, (unsigned short)(u >> 16)); }
struct ConvTaps { u32x4 x[4]; };
__device__ __forceinline__ void conv_load(ConvTaps& T, const h16* Pbatch, int tloc, int col) {
#pragma unroll
    for (int i = 0; i < 4; ++i) { const int tt = tloc - 3 + i; T.x[i] = (u32x4){0u, 0u, 0u, 0u}; if (tt >= 0) T.x[i] = *(const u32x4*)(Pbatch + (size_t)tt * PITCH + col); }
}
typedef _Float16 h16x2 __attribute__((ext_vector_type(2)));
__device__ __forceinline__ void conv_apply(const ConvTaps& T, const h16* cw16, float scale, float (&out)[8]) {
    float acc[8];
    { const u32x4 bw = *(const u32x4*)(cw16 + 4 * 768); acc[0] = half_lo(bw.x); acc[1] = half_hi(bw.x); acc[2] = half_lo(bw.y); acc[3] = half_hi(bw.y); acc[4] = half_lo(bw.z); acc[5] = half_hi(bw.z); acc[6] = half_lo(bw.w); acc[7] = half_hi(bw.w); }
#pragma unroll
    for (int i = 0; i < 4; ++i) { const u32x4 x = T.x[i], wv = *(const u32x4*)(cw16 + i * 768);
        acc[0] += half_lo(x.x) * half_lo(wv.x); acc[1] += half_hi(x.x) * half_hi(wv.x); acc[2] += half_lo(x.y) * half_lo(wv.y); acc[3] += half_hi(x.y) * half_hi(wv.y);
        acc[4] += half_lo(x.z) * half_lo(wv.z); acc[5] += half_hi(x.z) * half_hi(wv.z); acc[6] += half_lo(x.w) * half_lo(wv.w); acc[7] += half_hi(x.w) * half_hi(wv.w); }
#pragma unroll
    for (int e = 0; e < 8; ++e) out[e] = acc[e] * __builtin_amdgcn_rcpf(1.f + __expf(-acc[e])) * scale;
}
__device__ __forceinline__ void conv8(const h16* Pbatch, int tloc, int col, const h16* cw16, float scale, float (&out)[8]) {
    ConvTaps T; conv_load(T, Pbatch, tloc, col); conv_apply(T, cw16, scale, out);
}
__device__ __forceinline__ float log_sigmoid(float x) { return fminf(x, 0.f) - log1pf(__expf(-fabsf(x))); }

__device__ __forceinline__ void m1_item(const Args& A, int bh, int ck, LAS unsigned char* lds) {
    int tid_ = threadIdx.x; asm volatile("" : "+v"(tid_)); const int tid = tid_, lane = tid & 63, w = tid >> 6, c = lane & 15, g = lane >> 4;
    const int b = bh / H_ML, h = bh % H_ML;
    LAS h16* KT2 = (LAS h16*)lds;
    LAS h16* WVT = KT2 + 64 * KP;
    LAS float* WGT = (LAS float*)(lds + 2 * 64 * KP * 2);
    const h16* Pb = A.P16 + (size_t)b * S * PITCH;
    const int tloc = 64 * ck + lane;
    if (w == 0) {
        const h16* pr = Pb + (size_t)tloc * PITCH;
        const float li = (float)pr[PC_IG + h] + A.ig_b[h];
        const float lf = log_sigmoid((float)pr[PC_FG + h] + A.fg_b[h]);
        float bs = lf;
#pragma unroll
        for (int o = 1; o < 64; o <<= 1) { const float t = __shfl_up(bs, o); if (lane >= o) bs += t; }
        const float gt = __shfl(bs, 63);
        const float u = gt - bs + li;
        const float mu = wave_max(u);
        WGT[lane] = __expf(u - mu);
        if (lane == 0) { A.MUB[bh * 64 + ck] = mu; A.MUB[3072 + bh * 64 + ck] = gt; }
        const float as = li - bs; float pm = as;
#pragma unroll
        for (int o = 1; o < 64; o <<= 1) { const float t = __shfl_up(pm, o); if (lane >= o) pm = fmaxf(pm, t); }
        float* gto = A.GT + ((size_t)bh * 64 + ck) * 192; gto[lane] = bs; gto[64 + lane] = as; gto[128 + lane] = pm;
    }
    float kc[8];
    conv8(Pb, tloc, PC_MK + h * 64 + 8 * w, A.CW16 + 384 + h * 64 + 8 * w, 0.125f, kc);
    LDS_BAR();
    const float wg = WGT[lane];
    const u32x4 vv = *(const u32x4*)(Pb + (size_t)tloc * PITCH + PC_MV + h * 64 + 8 * w);
    const float v8[8] = {half_lo(vv.x), half_hi(vv.x), half_lo(vv.y), half_hi(vv.y), half_lo(vv.z), half_hi(vv.z), half_lo(vv.w), half_hi(vv.w)};
#pragma unroll
    for (int e = 0; e < 8; ++e) { KT2[(8 * w + e) * KP + lane] = (h16)kc[e]; WVT[(8 * w + e) * KP + lane] = (h16)(v8[e] * wg); }
    LDS_BAR();
    f32x4 acc[2] = {{0.f, 0.f, 0.f, 0.f}, {0.f, 0.f, 0.f, 0.f}};
    mm64(WVT, KT2, w, c, g, acc);
    float* kvo = A.KVB + ((size_t)bh * 64 + ck) * 4096;
#pragma unroll
    for (int n = 0; n < 2; ++n)
#pragma unroll
        for (int r = 0; r < 4; ++r) kvo[(16 * (w >> 1) + 4 * g + r) * 64 + 16 * (2 * (w & 1) + n) + c] = acc[n][r];
    if (w == 1) { float s = 0.f;
        for (int t = 0; t < 64; ++t) s += (float)KT2[lane * KP + t] * WGT[t];
        A.KSUM[((size_t)bh * 64 + ck) * 64 + lane] = s; }
    LDS_BAR();
}

__device__ __forceinline__ void m2_item(const Args& A, int bh, int qr) {
    int tid_ = threadIdx.x; asm volatile("" : "+v"(tid_)); const int tid = tid_;
    float* kv = A.KVB + (size_t)bh * 64 * 4096 + qr * 1024 + tid;
    float* ks = A.KSUM + (size_t)bh * 64 * 64 + tid;
    const bool don = (qr == 0 && tid < 64);
    float C0 = 0.f, C1 = 0.f, n = 0.f, m = 0.f;
#pragma unroll 1
    for (int c8 = 0; c8 < 64; c8 += 8) {
        float x0[8], x1[8], xn[8], mu[8], gt[8];
#pragma unroll
        for (int u = 0; u < 8; ++u) { x0[u] = kv[(size_t)(c8 + u) * 4096]; x1[u] = kv[(size_t)(c8 + u) * 4096 + 512]; xn[u] = don ? ks[(c8 + u) * 64] : 0.f;
            mu[u] = A.MUB[bh * 64 + c8 + u]; gt[u] = A.MUB[3072 + bh * 64 + c8 + u]; }
#pragma unroll
        for (int u = 0; u < 8; ++u) { const int ck = c8 + u;
            const float mn = fmaxf(gt[u] + m, mu[u]), dec = __expf(gt[u] + m - mn), wl = __expf(mu[u] - mn);
            kv[(size_t)ck * 4096] = C0; kv[(size_t)ck * 4096 + 512] = C1;
            if (don) ks[ck * 64] = n;
            if (qr == 0 && tid == 0) A.MUB[2 * 3072 + bh * 64 + ck] = m;
            C0 = dec * C0 + wl * x0[u]; C1 = dec * C1 + wl * x1[u]; n = dec * n + wl * xn[u]; m = mn; }
    }
}

struct M3Regs { ConvTaps q, k; u32x4 v, og; f32x4 c0, c1; float bs, as, pm, n0, m0; };
__device__ __forceinline__ void m3_load(M3Regs& R, const Args& A, int item, int tid) {
    const int bh = item >> 6, ck = item & 63, b = bh / H_ML, h = bh % H_ML, lane = tid & 63, w = tid >> 6;
    const h16* Pb = A.P16 + (size_t)b * S * PITCH; const int tloc = 64 * ck + lane;
    conv_load(R.q, Pb, tloc, PC_MQ + h * 64 + 8 * w); conv_load(R.k, Pb, tloc, PC_MK + h * 64 + 8 * w);
    R.v = *(const u32x4*)(Pb + (size_t)tloc * PITCH + PC_MV + h * 64 + 8 * w);
    const float* cp = A.KVB + ((size_t)bh * 64 + ck) * 4096 + (tid >> 3) * 64 + 8 * (tid & 7);
    R.c0 = *(const f32x4*)cp; R.c1 = *(const f32x4*)(cp + 4);
    R.og = *(const u32x4*)(A.P16 + ((size_t)b * S + 64 * ck + (tid >> 3)) * PITCH + PC_MO + h * 64 + 8 * (tid & 7));
    const float* gti = A.GT + ((size_t)bh * 64 + ck) * 192; R.bs = gti[lane]; R.as = gti[64 + lane]; R.pm = gti[128 + lane];
    R.n0 = A.KSUM[((size_t)bh * 64 + ck) * 64 + lane]; R.m0 = A.MUB[2 * 3072 + bh * 64 + ck];
}
__device__ __forceinline__ void m3_item(const Args& A, int item, int next_item, M3Regs& R, LAS unsigned char* lds) {
    int tid_ = threadIdx.x; asm volatile("" : "+v"(tid_)); const int tid = tid_, lane = tid & 63, w = tid >> 6, c = lane & 15, g = lane >> 4;
    const int bh = item >> 6, ck = item & 63, b = bh / H_ML, h = bh % H_ML;
    LAS h16* Q16 = (LAS h16*)lds;
    LAS h16* K16 = Q16 + 64 * KP;
    LAS h16* VT2 = K16 + 64 * KP;
    LAS h16* C016 = VT2 + 64 * KP;
    LAS h16* SM16 = C016 + 64 * KP;
    LAS float* HV = (LAS float*)(lds + 5 * 64 * KP * 2);
    LAS float* BJ = HV + 64 * 65; LAS float* AS = BJ + 64; LAS float* MJ = AS + 64; LAS float* WI = MJ + 64; LAS float* N0 = WI + 64; LAS float* DEN = N0 + 64;
    const float m0 = R.m0;
    if (w == 0) {
        const float bs = R.bs, mj = bs + fmaxf(m0, R.pm);
        BJ[lane] = bs; AS[lane] = R.as; MJ[lane] = mj; WI[lane] = __expf(bs + m0 - mj);
        N0[lane] = R.n0;
    }
    u32x4 og;
    {   float q8[8], k8[8];
        conv_apply(R.q, A.CW16 + h * 64 + 8 * w, 1.f, q8);
        conv_apply(R.k, A.CW16 + 384 + h * 64 + 8 * w, 0.125f, k8);
        u32x4 qo, ko;
        qo.x = pg8::pk_f16(q8[0], q8[1]); qo.y = pg8::pk_f16(q8[2], q8[3]); qo.z = pg8::pk_f16(q8[4], q8[5]); qo.w = pg8::pk_f16(q8[6], q8[7]);
        ko.x = pg8::pk_f16(k8[0], k8[1]); ko.y = pg8::pk_f16(k8[2], k8[3]); ko.z = pg8::pk_f16(k8[4], k8[5]); ko.w = pg8::pk_f16(k8[6], k8[7]);
        *(LAS u32x4*)(Q16 + lane * KP + 8 * w) = qo; *(LAS u32x4*)(K16 + lane * KP + 8 * w) = ko;
        const u32x4 vv = R.v;
        LAS unsigned short* vt = (LAS unsigned short*)VT2 + (8 * w) * KP + lane;
        vt[0 * KP] = (unsigned short)(vv.x & 0xffffu); vt[1 * KP] = (unsigned short)(vv.x >> 16); vt[2 * KP] = (unsigned short)(vv.y & 0xffffu); vt[3 * KP] = (unsigned short)(vv.y >> 16);
        vt[4 * KP] = (unsigned short)(vv.z & 0xffffu); vt[5 * KP] = (unsigned short)(vv.z >> 16); vt[6 * KP] = (unsigned short)(vv.w & 0xffffu); vt[7 * KP] = (unsigned short)(vv.w >> 16);
        const f32x4 c0 = R.c0, c1 = R.c1;
        u32x4 co; co.x = pg8::pk_f16(c0[0], c0[1]); co.y = pg8::pk_f16(c0[2], c0[3]); co.z = pg8::pk_f16(c1[0], c1[1]); co.w = pg8::pk_f16(c1[2], c1[3]);
        *(LAS u32x4*)(C016 + (tid >> 3) * KP + 8 * (tid & 7)) = co;
        og = R.og;
    }
    if (next_item >= 0) m3_load(R, A, next_item, tid);
    LDS_BAR();
    {
        f32x4 acc[2] = {{0.f, 0.f, 0.f, 0.f}, {0.f, 0.f, 0.f, 0.f}};
        mm64(Q16, K16, w, c, g, acc);
#pragma unroll
        for (int n = 0; n < 2; ++n)
#pragma unroll
            for (int r = 0; r < 4; ++r) { const int j = 16 * (w >> 1) + 4 * g + r, s = 16 * (2 * (w & 1) + n) + c;
                const float v = (s <= j) ? __expf(BJ[j] + AS[s] - MJ[j]) * acc[n][r] : 0.f;
                SM16[j * KP + s] = (h16)v; }
    }
    LDS_BAR();
    {
        const int j = tid >> 3, sg = tid & 7; float rs = 0.f, nq = 0.f;
#pragma unroll
        for (int e = 0; e < 8; ++e) { rs += (float)SM16[j * KP + 8 * sg + e]; nq += (float)Q16[j * KP + 8 * sg + e] * N0[8 * sg + e]; }
        rs += __shfl_xor(rs, 1); rs += __shfl_xor(rs, 2); rs += __shfl_xor(rs, 4);
        nq += __shfl_xor(nq, 1); nq += __shfl_xor(nq, 2); nq += __shfl_xor(nq, 4);
        if (sg == 0) DEN[j] = fmaxf(fabsf(WI[j] * nq + rs), __expf(-MJ[j]));
    }
    f32x4 a1[2] = {{0.f, 0.f, 0.f, 0.f}, {0.f, 0.f, 0.f, 0.f}}, a2[2] = {{0.f, 0.f, 0.f, 0.f}, {0.f, 0.f, 0.f, 0.f}};
    mm64(Q16, C016, w, c, g, a1);
    mm64(SM16, VT2, w, c, g, a2);
    LDS_BAR();
#pragma unroll
    for (int n = 0; n < 2; ++n)
#pragma unroll
        for (int r = 0; r < 4; ++r) { const int j = 16 * (w >> 1) + 4 * g + r, d = 16 * (2 * (w & 1) + n) + c;
            HV[j * 65 + d] = (WI[j] * a1[n][r] + a2[n][r]) * __builtin_amdgcn_rcpf(DEN[j]); }
    LDS_BAR();
    {   const int j = tid >> 3, sg = tid & 7; float hv[8], ss = 0.f;
#pragma unroll
        for (int e = 0; e < 8; ++e) { hv[e] = HV[j * 65 + 8 * sg + e]; ss += hv[e] * hv[e]; }
        ss += __shfl_xor(ss, 1); ss += __shfl_xor(ss, 2); ss += __shfl_xor(ss, 4);
        const float rstd = rsqrtf(ss * (1.f / 64.f) + 1e-6f);
        const size_t tok = (size_t)b * S + 64 * ck + j;
        const float o8[8] = {half_lo(og.x), half_hi(og.x), half_lo(og.y), half_hi(og.y), half_lo(og.z), half_hi(og.z), half_lo(og.w), half_hi(og.w)};
        const float* ng = A.norm_g + h * 64 + 8 * sg;
        float r8[8];
#pragma unroll
        for (int e = 0; e < 8; ++e) r8[e] = hv[e] * rstd * ng[e] * __builtin_amdgcn_rcpf(1.f + __expf(-o8[e]));
        u32x4 ov; ov.x = pg8::pk_f16(r8[0], r8[1]); ov.y = pg8::pk_f16(r8[2], r8[3]); ov.z = pg8::pk_f16(r8[4], r8[5]); ov.w = pg8::pk_f16(r8[6], r8[7]);
        *(u32x4*)(A.O16 + tok * D + C_ATT + C_RW + h * 64 + 8 * sg) = ov;
    }
    LDS_BAR();
}
}
namespace rwk {
using nsa::f16x8; using nsa::f16x4; using nsa::f32x4; using nsa::u32x4; using nsa::u32x2; using nsa::mfma16;
constexpr size_t WS_WE = 364 * MiB, WS_AA = 388 * MiB, WS_GG = 412 * MiB;
constexpr size_t WS_LRW = WS_LRW0; constexpr int LRW_L = LRW_L0;
__device__ __forceinline__ f32x4 mfma16k16(f16x4 a, f16x4 b, f32x4 c) { return __builtin_amdgcn_mfma_f32_16x16x16f16(a, b, c, 0, 0, 0); }
template <int CTRL> __device__ __forceinline__ float dpp_mov(float v) { return __builtin_bit_cast(float, __builtin_amdgcn_update_dpp(0, __builtin_bit_cast(int, v), CTRL, 0xF, 0xF, true)); }
__device__ __forceinline__ float wave_sum_fast(float v) {
    v += dpp_mov<0xB1>(v); v += dpp_mov<0x4E>(v); v += dpp_mov<0x141>(v); v += dpp_mov<0x140>(v);
    const int iv = __builtin_bit_cast(int, v);
    return (__builtin_bit_cast(float, __builtin_amdgcn_readlane(iv, 0)) + __builtin_bit_cast(float, __builtin_amdgcn_readlane(iv, 16))) +
           (__builtin_bit_cast(float, __builtin_amdgcn_readlane(iv, 32)) + __builtin_bit_cast(float, __builtin_amdgcn_readlane(iv, 48)));
}
__device__ __forceinline__ float hlo(unsigned u) { return (float)__builtin_bit_cast(_Float16, (unsigned short)(u & 0xffffu)); }
__device__ __forceinline__ float hhi(unsigned u) { return (float)__builtin_bit_cast(_Float16, (unsigned short)(u >> 16)); }

template <int MAT> __device__ __forceinline__ void prep_mat(const LAS h16* X, LAS h16* OT, const h16* WT, const float* biasp, h16* outp, int tile, int w, int c, int g) {
        constexpr int K = (MAT == 2) ? 128 : 64, xp = (MAT == 2) ? 136 : 72;


        f32x4 acc[3][4];
#pragma unroll
        for (int nt = 0; nt < 3; ++nt)
#pragma unroll
            for (int mt = 0; mt < 4; ++mt) acc[nt][mt] = (f32x4){0.f, 0.f, 0.f, 0.f};
        f16x8 af[K / 32][3];
#pragma unroll
        for (int ks = 0; ks < K / 32; ++ks)
#pragma unroll
            for (int nt = 0; nt < 3; ++nt) af[ks][nt] = *(const f16x8*)(WT + (size_t)(48 * w + 16 * nt + c) * K + 32 * ks + 8 * g);
#pragma unroll
        for (int ks = 0; ks < K / 32; ++ks) {
            f16x8 bf[4];
#pragma unroll
            for (int mt = 0; mt < 4; ++mt) bf[mt] = *(const LAS f16x8*)(X + (16 * mt + c) * xp + 32 * ks + 8 * g);
#pragma unroll
            for (int nt = 0; nt < 3; ++nt)
#pragma unroll
                for (int mt = 0; mt < 4; ++mt) acc[nt][mt] = mfma16(af[ks][nt], bf[mt], acc[nt][mt]);
        }

#pragma unroll
        for (int nt = 0; nt < 3; ++nt) { const int ch = 48 * w + 16 * nt + 4 * g;
            f32x4 bias = {0.f, 0.f, 0.f, 0.f}; if (MAT == 0) bias = *(const f32x4*)(biasp + ch); else if (MAT == 1) bias = *(const f32x4*)(biasp + ch);
#pragma unroll
            for (int mt = 0; mt < 4; ++mt) { float o[4];
#pragma unroll
                for (int r = 0; r < 4; ++r) { const float x = acc[nt][mt][r] + bias[r];
                    if (MAT == 0) { const float sp = fmaxf(-x, 0.f) + __logf(1.f + __expf(-fabsf(x))); o[r] = __expf(-sp - 0.5f); }
                    else if (MAT == 1) o[r] = __builtin_amdgcn_rcpf(1.f + __expf(-x)); else o[r] = x; }
                u32x2 ov; ov.x = pg8::pk_f16(o[0], o[1]); ov.y = pg8::pk_f16(o[2], o[3]);
                *(LAS u32x2*)(OT + (16 * mt + c) * 392 + ch) = ov; }
        }
        __syncthreads();
        {
            int tid2_ = threadIdx.x; asm volatile("" : "+v"(tid2_));
#pragma unroll
            for (int k = 0; k < 6; ++k) { const int e = tid2_ + 512 * k, row = e / 48, cc = e % 48;
                *(u32x4*)(outp + ((size_t)tile * 64 + row) * C_RW + 8 * cc) = *(const LAS u32x4*)(OT + row * 392 + 8 * cc); }
        }
        __syncthreads();
}
constexpr size_t WS_RN = 363 * MiB + 128 * 1024;
struct PrepArgs { const h16* P16; const float *mu, *w0, *a0, *kkp; const h16* LRW; h16 *WE, *AA, *GG; float* RN; };
__device__ __forceinline__ void prep_item(const PrepArgs& A, int tile, LAS unsigned char* lds) {
    int tid_ = threadIdx.x; asm volatile("" : "+v"(tid_)); const int tid = tid_, lane = tid & 63, w = tid >> 6, c = lane & 15, g = lane >> 4;
    LAS h16* XW = (LAS h16*)lds;
    LAS h16* XA = XW + 64 * 72;
    LAS h16* XG = XA + 64 * 72;
    {
        const int tk = tid >> 3, part = tid & 7; const size_t tok = (size_t)tile * 64 + tk; const bool hasp = (tok % S) != 0;
        const h16* pc = A.P16 + tok * PITCH; const h16* pp = pc - PITCH;
#pragma unroll
        for (int q = 0; q < 4; ++q) {
            const int col = (q == 0) ? PC_XW + 8 * part : (q == 1) ? PC_XA + 8 * part : PC_XG + 64 * (q - 2) + 8 * part;
            const int mcol = (q == 0) ? 1152 + 8 * part : (q == 1) ? 1216 + 8 * part : 1280 + 64 * (q - 2) + 8 * part;
            const u32x4 xc = *(const u32x4*)(pc + col); u32x4 xp = {0u, 0u, 0u, 0u}; if (hasp) xp = *(const u32x4*)(pp + col);
            const float cv[8] = {hlo(xc.x), hhi(xc.x), hlo(xc.y), hhi(xc.y), hlo(xc.z), hhi(xc.z), hlo(xc.w), hhi(xc.w)};
            const float pv[8] = {hlo(xp.x), hhi(xp.x), hlo(xp.y), hhi(xp.y), hlo(xp.z), hhi(xp.z), hlo(xp.w), hhi(xp.w)};
            float o[8];
#pragma unroll
            for (int e = 0; e < 8; ++e) { const float x = cv[e] + A.mu[mcol + e] * (pv[e] - cv[e]);
                o[e] = (q == 0) ? (1.f - 2.f * __builtin_amdgcn_rcpf(1.f + __expf(2.f * x))) : (q == 1) ? x : __builtin_amdgcn_rcpf(1.f + __expf(-x)); }
            u32x4 ov; ov.x = pg8::pk_f16(o[0], o[1]); ov.y = pg8::pk_f16(o[2], o[3]); ov.z = pg8::pk_f16(o[4], o[5]); ov.w = pg8::pk_f16(o[6], o[7]);
            if (q == 0) *(LAS u32x4*)(XW + tk * 72 + 8 * part) = ov; else if (q == 1) *(LAS u32x4*)(XA + tk * 72 + 8 * part) = ov; else *(LAS u32x4*)(XG + tk * 136 + 64 * (q - 2) + 8 * part) = ov;
        }
#pragma unroll
        for (int hd = 0; hd < H_RW; ++hd) {
            const int col = hd * 64 + 8 * part;
            const u32x4 xc = *(const u32x4*)(pc + PC_K + col); u32x4 xp = {0u, 0u, 0u, 0u}; if (hasp) xp = *(const u32x4*)(pp + PC_K + col);
            const float cv[8] = {hlo(xc.x), hhi(xc.x), hlo(xc.y), hhi(xc.y), hlo(xc.z), hhi(xc.z), hlo(xc.w), hhi(xc.w)};
            const float pv[8] = {hlo(xp.x), hhi(xp.x), hlo(xp.y), hhi(xp.y), hlo(xp.z), hhi(xp.z), hlo(xp.w), hhi(xp.w)};
            float ss = 0.f;
#pragma unroll
            for (int e = 0; e < 8; ++e) { const float kq = (cv[e] + A.mu[384 + col + e] * (pv[e] - cv[e])) * A.kkp[col + e]; ss += kq * kq; }
            ss += __shfl_xor(ss, 1); ss += __shfl_xor(ss, 2); ss += __shfl_xor(ss, 4);
            if (part == 0) A.RN[tok * 6 + hd] = rsqrtf(fmaxf(ss, 1e-24f));
        }
    }
    __syncthreads();
    LAS h16* OT = XG + 64 * 136;
    prep_mat<0>(XW, OT, A.LRW, A.w0, A.WE, tile, w, c, g);
    prep_mat<1>(XA, OT, A.LRW + 384 * 64, A.a0, A.AA, tile, w, c, g);
    prep_mat<2>(XG, OT, A.LRW + 2 * 384 * 64, nullptr, A.GG, tile, w, c, g);
}

struct ScanArgs { const h16* P16; const h16 *WE, *AA; const float* RN; const float *mu, *kk, *ka; h16* O16; };
constexpr int NS = 8, AP = 72, TP2 = 20;
constexpr int S_AT = 0, S_RT = 2304, S_BN = 4608, S_KN = 6912, S_BT = 9216, S_KT = 11776, S_VT = 14336, S_T = 16896, S_MAK = 17536, S_MRB = 18176, S_MRK = 18816, S_GL = 19456, S_N = S_BN  , SLOT = 19712;
constexpr int NCH = S / 16;
static_assert(NS * SLOT <= LDS_BYTES - 16, "scan slots fit the LDS allocation");
struct RawRegs { unsigned short r[16], k[16], v[16], e[16], a[16]; unsigned short pr, pk, pv; float rn; };
__device__ __forceinline__ void scan_load(const ScanArgs& A, int b, int h, int ck, int lane, RawRegs& R) {
    const int ch = h * 64 + lane; const size_t tok0 = (size_t)b * S + 16 * ck;
    const unsigned short* p0 = (const unsigned short*)A.P16 + tok0 * PITCH + ch;
    const unsigned short* we = (const unsigned short*)A.WE + tok0 * C_RW + ch; const unsigned short* aa = (const unsigned short*)A.AA + tok0 * C_RW + ch;
    R.pr = 0; R.pk = 0; R.pv = 0;
    if (ck > 0) { R.pr = p0[PC_R - PITCH]; R.pk = p0[PC_K - PITCH]; R.pv = p0[PC_V - PITCH]; }
#pragma unroll
    for (int t = 0; t < 16; ++t) { R.r[t] = p0[(size_t)t * PITCH + PC_R]; R.k[t] = p0[(size_t)t * PITCH + PC_K]; R.v[t] = p0[(size_t)t * PITCH + PC_V]; R.e[t] = we[t * C_RW]; R.a[t] = aa[t * C_RW]; }
    R.rn = A.RN[(tok0 + (lane & 15)) * 6 + h];
}
__device__ __forceinline__ float us2f(unsigned short u) { return (float)__builtin_bit_cast(_Float16, u); }
__device__ __forceinline__ void scan_item(const ScanArgs& A, int bh, LAS unsigned char* lds) {
    int tid_ = threadIdx.x; asm volatile("" : "+v"(tid_)); const int tid = tid_, lane = tid & 63, w = __builtin_amdgcn_readfirstlane(tid >> 6), c = lane & 15, g = lane >> 4;
    const int b = bh / H_RW, h = bh % H_RW, ch = h * 64 + lane;
    LAS unsigned char* sb = lds + w * SLOT;
    LAS h16* AT = (LAS h16*)(sb + S_AT); LAS h16* RT = (LAS h16*)(sb + S_RT); LAS h16* BN = (LAS h16*)(sb + S_BN); LAS h16* KN = (LAS h16*)(sb + S_KN);
    LAS h16* BT = (LAS h16*)(sb + S_BT); LAS h16* KT = (LAS h16*)(sb + S_KT); LAS h16* VT = (LAS h16*)(sb + S_VT);
    LAS h16* TM = (LAS h16*)(sb + S_T); LAS h16* MAK = (LAS h16*)(sb + S_MAK); LAS h16* MRB = (LAS h16*)(sb + S_MRB); LAS h16* MRK = (LAS h16*)(sb + S_MRK);
    LAS float* GL = (LAS float*)(sb + S_GL); LAS float* N32 = (LAS float*)(sb + S_N);
    const float mu_r = A.mu[ch], mu_k = A.mu[384 + ch], mu_v = A.mu[768 + ch], k_k = A.kk[ch], k_a = A.ka[ch];
    f32x4 X[4];
#pragma unroll
    for (int kt = 0; kt < 4; ++kt) X[kt] = (f32x4){0.f, 0.f, 0.f, 0.f};
    RawRegs R;
    scan_load(A, b, h, w, lane, R);
#pragma unroll 1
    for (int bt = 0; bt < NCH / NS; ++bt) {
        {
            float pr = us2f(R.pr), pk = us2f(R.pk), pv = us2f(R.pv);
            float cl = 0.f, G = 1.f;
            const int rnv = __builtin_bit_cast(int, R.rn);
#pragma unroll
            for (int t = 0; t < 16; ++t) {
                const float cr = us2f(R.r[t]), ckv = us2f(R.k[t]), cv = us2f(R.v[t]), e = us2f(R.e[t]), a = us2f(R.a[t]);
                const float r = cr + mu_r * (pr - cr), k = ckv + mu_k * (pk - ckv), v = cv + mu_v * (pv - cv);
                pr = cr; pk = ckv; pv = cv;
                const float Gm1 = G; cl -= e; G = __expf(cl); const float iG = __builtin_amdgcn_rcpf(G);
                const float rn = __builtin_bit_cast(float, __builtin_amdgcn_readlane(rnv, t));
                const float kkn = k * k_k * rn;
                const float k2 = k * (1.f + (a - 1.f) * k_a), be = kkn * a;
                const h16 at = (h16)(-kkn * Gm1), bt_ = (h16)(be * iG), kt_ = (h16)(k2 * iG), rt = (h16)(r * G);
                AT[t * AP + lane] = at; RT[t * AP + lane] = rt; BN[t * AP + lane] = bt_; KN[t * AP + lane] = kt_;
                BT[lane * TP2 + t] = bt_; KT[lane * TP2 + t] = kt_; VT[lane * TP2 + t] = (h16)v;
            }
            GL[lane] = G;
            if (bt + 1 < NCH / NS) scan_load(A, b, h, NS * (bt + 1) + w, lane, R);
            asm volatile("s_waitcnt lgkmcnt(0)" ::: "memory");
            f32x4 mab = {0.f, 0.f, 0.f, 0.f}, mak = mab, mrb = mab, mrk = mab;
#pragma unroll
            for (int ks = 0; ks < 2; ++ks) {
                const f16x8 fa = *(const LAS f16x8*)(AT + c * AP + 32 * ks + 8 * g), fr = *(const LAS f16x8*)(RT + c * AP + 32 * ks + 8 * g);
                const f16x8 fb = *(const LAS f16x8*)(BN + c * AP + 32 * ks + 8 * g), fk = *(const LAS f16x8*)(KN + c * AP + 32 * ks + 8 * g);
                mab = mfma16(fa, fb, mab); mak = mfma16(fa, fk, mak); mrb = mfma16(fr, fb, mrb); mrk = mfma16(fr, fk, mrk);
            }
            asm volatile("s_waitcnt lgkmcnt(0)" ::: "memory");
#pragma unroll
            for (int r = 0; r < 4; ++r) { const int t = 4 * g + r;
                N32[t * 16 + c] = (c < t) ? mab[r] : 0.f;
                MAK[t * TP2 + c] = (h16)((c < t) ? mak[r] : 0.f); MRB[t * TP2 + c] = (h16)((c <= t) ? mrb[r] : 0.f); MRK[t * TP2 + c] = (h16)((c <= t) ? mrk[r] : 0.f); }
            asm volatile("s_waitcnt lgkmcnt(0)" ::: "memory");
            {
                float Tc[16];
#pragma unroll
                for (int t = 0; t < 16; ++t) {
                    float acc = (t == c) ? 1.f : 0.f;
#pragma unroll
                    for (int s4 = 0; s4 < (t + 3) / 4; ++s4) { const f32x4 nr = *(const LAS f32x4*)(N32 + t * 16 + 4 * s4);
#pragma unroll
                        for (int e = 0; e < 4; ++e) if (4 * s4 + e < t) acc += nr[e] * Tc[4 * s4 + e]; }
                    Tc[t] = acc;
                }
                if (g == 0) {
#pragma unroll
                    for (int t = 0; t < 16; ++t) TM[t * TP2 + c] = (h16)Tc[t];
                }
            }
        }
        asm volatile("s_waitcnt lgkmcnt(0)" ::: "memory"); __builtin_amdgcn_s_barrier(); asm volatile("" ::: "memory");
        if (w < 4) {
#pragma unroll 1
            for (int sl = 0; sl < NS; ++sl) {
                const int ck = NS * bt + sl;
                const LAS unsigned char* cb = lds + sl * SLOT;
                const LAS h16* cAT = (const LAS h16*)(cb + S_AT); const LAS h16* cRT = (const LAS h16*)(cb + S_RT);
                const LAS h16* cBT = (const LAS h16*)(cb + S_BT); const LAS h16* cKT = (const LAS h16*)(cb + S_KT); const LAS h16* cVT = (const LAS h16*)(cb + S_VT);
                const LAS h16* cTM = (const LAS h16*)(cb + S_T); const LAS h16* cMAK = (const LAS h16*)(cb + S_MAK); const LAS h16* cMRB = (const LAS h16*)(cb + S_MRB); const LAS h16* cMRK = (const LAS h16*)(cb + S_MRK);
                const LAS float* cGL = (const LAS float*)(cb + S_GL);
                f16x8 xf[2];
#pragma unroll
                for (int ks = 0; ks < 2; ++ks) { const f32x4 x0 = X[2 * ks], x1 = X[2 * ks + 1];
                    xf[ks] = (f16x8){(_Float16)x0[0], (_Float16)x0[1], (_Float16)x0[2], (_Float16)x0[3], (_Float16)x1[0], (_Float16)x1[1], (_Float16)x1[2], (_Float16)x1[3]}; }
                const f16x4 vf = *(const LAS f16x4*)(cVT + (16 * w + c) * TP2 + 4 * g);
                const f16x4 makf = *(const LAS f16x4*)(cMAK + c * TP2 + 4 * g), tf = *(const LAS f16x4*)(cTM + c * TP2 + 4 * g);
                const f16x4 mrbf = *(const LAS f16x4*)(cMRB + c * TP2 + 4 * g), mrkf = *(const LAS f16x4*)(cMRK + c * TP2 + 4 * g);
                f16x8 af[2], rf[2];
#pragma unroll
                for (int ks = 0; ks < 2; ++ks) {
                    const f16x4 a0 = *(const LAS f16x4*)(cAT + c * AP + 32 * ks + 4 * g), a1 = *(const LAS f16x4*)(cAT + c * AP + 32 * ks + 16 + 4 * g);
                    const f16x4 r0 = *(const LAS f16x4*)(cRT + c * AP + 32 * ks + 4 * g), r1 = *(const LAS f16x4*)(cRT + c * AP + 32 * ks + 16 + 4 * g);
                    af[ks] = (f16x8){a0[0], a0[1], a0[2], a0[3], a1[0], a1[1], a1[2], a1[3]}; rf[ks] = (f16x8){r0[0], r0[1], r0[2], r0[3], r1[0], r1[1], r1[2], r1[3]};
                }
                f32x4 gw = {0.f, 0.f, 0.f, 0.f};
                gw = mfma16k16(makf, vf, gw); gw = mfma16(af[0], xf[0], gw); gw = mfma16(af[1], xf[1], gw);
                const f16x4 gwf = (f16x4){(_Float16)gw[0], (_Float16)gw[1], (_Float16)gw[2], (_Float16)gw[3]};
                f32x4 u = {0.f, 0.f, 0.f, 0.f}; u = mfma16k16(tf, gwf, u);
                const f16x4 uf = (f16x4){(_Float16)u[0], (_Float16)u[1], (_Float16)u[2], (_Float16)u[3]};
                f32x4 yy = {0.f, 0.f, 0.f, 0.f};
                yy = mfma16k16(mrkf, vf, yy); yy = mfma16k16(mrbf, uf, yy); yy = mfma16(rf[0], xf[0], yy); yy = mfma16(rf[1], xf[1], yy);
#pragma unroll
                for (int kt = 0; kt < 4; ++kt) {
                    const f16x4 btf = *(const LAS f16x4*)(cBT + (16 * kt + c) * TP2 + 4 * g), ktf = *(const LAS f16x4*)(cKT + (16 * kt + c) * TP2 + 4 * g);
                    const f32x4 gl = *(const LAS f32x4*)(cGL + 16 * kt + 4 * g);
                    f32x4 x = X[kt]; x = mfma16k16(btf, uf, x); x = mfma16k16(ktf, vf, x); X[kt] = x * gl;
                }
                h16* op = A.O16 + ((size_t)b * S + 16 * ck + 4 * g) * D + C_ATT + h * 64 + 16 * w + c;
#pragma unroll
                for (int r = 0; r < 4; ++r) op[(size_t)r * D] = (h16)yy[r];
            }
        }
        asm volatile("s_waitcnt lgkmcnt(0)" ::: "memory"); __builtin_amdgcn_s_barrier(); asm volatile("" ::: "memory");
    }
    asm volatile("s_waitcnt vmcnt(0)" ::: "memory");
    __syncthreads();
}

struct PostArgs { const h16* P16; const h16 *AA, *GG; const float *mu, *ka, *rk, *lnw, *lnb; h16* O16; };
struct PostRaw4 { u32x2 cr, ck, cv, qr, qk, qv, av, gv, yv; };
__device__ __forceinline__ float row_sum16(float v) { v += dpp_mov<0xB1>(v); v += dpp_mov<0x4E>(v); v += dpp_mov<0x141>(v); v += dpp_mov<0x140>(v); return v; }
__device__ __forceinline__ void post_head_load(PostRaw4& R, const PostArgs& A, size_t tok, int col) {
    const h16* pc = A.P16 + tok * PITCH + col; const bool hasp = (tok % S) != 0;
    R.cr = *(const u32x2*)(pc + PC_R); R.ck = *(const u32x2*)(pc + PC_K); R.cv = *(const u32x2*)(pc + PC_V);
    R.qr = (u32x2){0u, 0u}; R.qk = (u32x2){0u, 0u}; R.qv = (u32x2){0u, 0u};
    if (hasp) { R.qr = *(const u32x2*)(pc + PC_R - PITCH); R.qk = *(const u32x2*)(pc + PC_K - PITCH); R.qv = *(const u32x2*)(pc + PC_V - PITCH); }
    R.av = *(const u32x2*)(A.AA + tok * C_RW + col); R.gv = *(const u32x2*)(A.GG + tok * C_RW + col); R.yv = *(const u32x2*)(A.O16 + tok * D + C_ATT + col);
}
__device__ __forceinline__ void h4(const u32x2 w, float (&o)[4]) { o[0] = hlo(w.x); o[1] = hhi(w.x); o[2] = hlo(w.y); o[3] = hhi(w.y); }
__device__ __forceinline__ void post_head(const PostArgs& A, int b, int h) {
    int tid_ = threadIdx.x; asm volatile("" : "+v"(tid_)); const int lane = tid_ & 63, w = tid_ >> 6, col = h * 64 + 4 * (lane & 15);
    float mur[4], muk[4], muv[4], kaw[4], rkw[4], lw[4], lb[4];
#pragma unroll
    for (int e = 0; e < 4; ++e) { mur[e] = A.mu[col + e]; muk[e] = A.mu[384 + col + e]; muv[e] = A.mu[768 + col + e]; kaw[e] = A.ka[col + e]; rkw[e] = A.rk[col + e]; lw[e] = A.lnw[col + e]; lb[e] = A.lnb[col + e]; }
    const size_t tok0 = (size_t)b * S + 512 * w + (lane >> 4);
    PostRaw4 R0, R1;
    post_head_load(R0, A, tok0, col);
#define RWK_POST4(R, TOK) do { \
        float fr[4], fk[4], fv[4], qr[4], qk[4], qv[4], av[4], gv[4], y[4]; \
        h4(R.cr, fr); h4(R.ck, fk); h4(R.cv, fv); h4(R.qr, qr); h4(R.qk, qk); h4(R.qv, qv); h4(R.av, av); h4(R.gv, gv); h4(R.yv, y); \
        float sb = 0.f, vv[4]; \
        _Pragma("unroll") for (int e = 0; e < 4; ++e) { const float r = fr[e] + mur[e] * (qr[e] - fr[e]), k = fk[e] + muk[e] * (qk[e] - fk[e]); vv[e] = fv[e] + muv[e] * (qv[e] - fv[e]); \
            sb += r * (k * (1.f + (av[e] - 1.f) * kaw[e])) * rkw[e]; } \
        const float mean = row_sum16((y[0] + y[1]) + (y[2] + y[3])) * (1.f / 64.f); \
        float dv[4], sv = 0.f; \
        _Pragma("unroll") for (int e = 0; e < 4; ++e) { dv[e] = y[e] - mean; sv += dv[e] * dv[e]; } \
        const float rs = rsqrtf(row_sum16(sv) * (1.f / 64.f) + 64e-5f); \
        const float bon = row_sum16(sb); \
        float o[4]; \
        _Pragma("unroll") for (int e = 0; e < 4; ++e) o[e] = (dv[e] * rs * lw[e] + lb[e] + bon * vv[e]) * gv[e]; \
        u32x2 ov; ov.x = pg8::pk_f16(o[0], o[1]); ov.y = pg8::pk_f16(o[2], o[3]); \
        *(u32x2*)(A.O16 + (TOK) * D + C_ATT + col) = ov; } while (0)
#pragma unroll 1
    for (int t0 = 0; t0 < 512; t0 += 8) {
        post_head_load(R1, A, tok0 + t0 + 4, col);
        RWK_POST4(R0, tok0 + t0);
        if (t0 + 8 < 512) post_head_load(R0, A, tok0 + t0 + 8, col);
        RWK_POST4(R1, tok0 + t0 + 4);
    }
#undef RWK_POST4
}
}
__device__ __forceinline__ void skinny_item(const h16* H, const h16* Wsm, h16* P16o, int tile, LAS unsigned char* lds) {
    int tid_ = threadIdx.x; asm volatile("" : "+v"(tid_)); const int tid = tid_, lane = tid & 63, w = tid >> 6, c = lane & 15, g = lane >> 4;
    LAS float* PART = (LAS float*)lds;
    nsa::f16x8 af[4][4], bf[4][2];
#pragma unroll
    for (int ks = 0; ks < 4; ++ks) { const int k0 = 128 * w + 32 * ks + 8 * g;
#pragma unroll
        for (int mt = 0; mt < 4; ++mt) af[ks][mt] = *(const nsa::f16x8*)(H + ((size_t)tile * 64 + 16 * mt + c) * D + k0);
#pragma unroll
        for (int nt = 0; nt < 2; ++nt) bf[ks][nt] = *(const nsa::f16x8*)(Wsm + (size_t)(16 * nt + c) * D + k0); }
    nsa::f32x4 acc[4][2];
#pragma unroll
    for (int mt = 0; mt < 4; ++mt)
#pragma unroll
        for (int nt = 0; nt < 2; ++nt) acc[mt][nt] = (nsa::f32x4){0.f, 0.f, 0.f, 0.f};
#pragma unroll
    for (int ks = 0; ks < 4; ++ks)
#pragma unroll
        for (int mt = 0; mt < 4; ++mt)
#pragma unroll
            for (int nt = 0; nt < 2; ++nt) acc[mt][nt] = nsa::mfma16(bf[ks][nt], af[ks][mt], acc[mt][nt]);
#pragma unroll
    for (int mt = 0; mt < 4; ++mt)
#pragma unroll
        for (int nt = 0; nt < 2; ++nt) *(LAS nsa::f32x4*)(PART + (w * 64 + 16 * mt + c) * 32 + 16 * nt + 4 * g) = acc[mt][nt];
    __syncthreads();
    {   const int tk = tid >> 3, c4 = (tid & 7) * 4;
        nsa::f32x4 s = {0.f, 0.f, 0.f, 0.f};
#pragma unroll
        for (int ww = 0; ww < 8; ++ww) s = s + *(const LAS nsa::f32x4*)(PART + (ww * 64 + tk) * 32 + c4);
        if (c4 < 24) { pg8::u32x2 o; o.x = pg8::pk_f16(s[0], s[1]); o.y = pg8::pk_f16(s[2], s[3]); *(pg8::u32x2*)(P16o + ((size_t)tile * 64 + tk) * PITCH + PC_GTS + c4) = o; }
    }
    __syncthreads();
}
#define XB_TMO      128
#define XB_XCNT(j)  (256  + 64 * (j))
#define XB_XSUB(j)  (1280 + 64 * (j))
#define XB_XGEN(j)  (2304 + 64 * (j))
#define XB_TOP      3328
#define XB_TOPGEN   3392
#define XCD_BAR_WORDS 3456
#define XB_SPIN_CAP (1u << 18)

__device__ __forceinline__ unsigned xb_ld(unsigned* p)              { return __hip_atomic_load(p, __ATOMIC_RELAXED, __HIP_MEMORY_SCOPE_AGENT); }
__device__ __forceinline__ unsigned xb_add(unsigned* p, unsigned v) { return __hip_atomic_fetch_add(p, v, __ATOMIC_RELAXED, __HIP_MEMORY_SCOPE_AGENT); }
__device__ __forceinline__ unsigned xb_xcc_id() { return (unsigned)__builtin_amdgcn_s_getreg((3 << 11) | 20) & 0xFu; }
#define XB_SPIN(cond, bar) do { unsigned _sp = 0; while (cond) { __builtin_amdgcn_s_sleep(1); \
    if ((++_sp & 255u) == 0u) { if (xb_ld(&(bar)[XB_TMO])) break; if (_sp > XB_SPIN_CAP) { atomicAdd(&(bar)[XB_TMO], 1u); break; } } } } while (0)

struct XcdBarrier {
    unsigned* bar; unsigned x;
    volatile LAS unsigned* st;
};

__device__ __forceinline__ XcdBarrier xcd_barrier_post(unsigned* bar, volatile LAS unsigned* st) {
    XcdBarrier b; b.bar = bar; b.x = xb_xcc_id(); b.st = st;
    if (threadIdx.x == 0) (void)xb_add(&bar[XB_XCNT(b.x)], 1u);
    return b;
}
__device__ __forceinline__ void xcd_barrier_complete(unsigned* bar, unsigned x, unsigned& nloc, unsigned& nx) {
    const unsigned G = gridDim.x * gridDim.y * gridDim.z;
    unsigned sum, cnt, mine, sp = 0u;
    for (;;) {
        sum = 0u; cnt = 0u; mine = 0u;
#pragma unroll
        for (unsigned j = 0; j < 16; ++j) { const unsigned c = xb_ld(&bar[XB_XCNT(j)]); sum += c; cnt += (c > 0u) ? 1u : 0u; mine = (j == x) ? c : mine; }
        if (sum == G) break;
        __builtin_amdgcn_s_sleep(1);
        if ((++sp & 255u) == 0u) { if (xb_ld(&bar[XB_TMO])) break; if (sp > XB_SPIN_CAP) { atomicAdd(&bar[XB_TMO], 1u); break; } }
    }
    nloc = mine > 0u ? mine : 1u; nx = cnt > 0u ? cnt : 1u;
}

__device__ __forceinline__ void xcd_barrier(const XcdBarrier& b) {
    asm volatile("s_waitcnt vmcnt(0)" ::: "memory");
    __syncthreads();
    if (threadIdx.x == 0) {
        unsigned* bar = b.bar;
        __builtin_amdgcn_s_waitcnt(0);
        unsigned nloc = b.st[0], nx = b.st[1];
        if (nloc == 0u) { xcd_barrier_complete(bar, b.x, nloc, nx); b.st[0] = nloc; b.st[1] = nx; }
        const unsigned old = xb_add(&bar[XB_XSUB(b.x)], 1u);
        const unsigned gen = old / nloc;
        if (old + 1u == (gen + 1u) * nloc) {
            __builtin_amdgcn_fence(__ATOMIC_RELEASE, "agent");
            asm volatile("s_waitcnt vmcnt(0)" ::: "memory");
            const unsigned og = xb_add(&bar[XB_TOP], 1u);
            const unsigned tg = og / nx;
            if (og + 1u == (tg + 1u) * nx) xb_add(&bar[XB_TOPGEN], 1u);
            else XB_SPIN(xb_ld(&bar[XB_TOPGEN]) == tg, bar);
            __builtin_amdgcn_fence(__ATOMIC_ACQUIRE, "agent");
            xb_add(&bar[XB_XGEN(b.x)], 1u);
            asm volatile("s_waitcnt vmcnt(0)" ::: "memory");
        } else {
            XB_SPIN(xb_ld(&bar[XB_XGEN(b.x)]) == gen, bar);
            __builtin_amdgcn_fence(__ATOMIC_ACQUIRE, "agent");
            asm volatile("s_waitcnt vmcnt(0)" ::: "memory");
        }
    }
    __syncthreads();
}
constexpr int N_PHASES = 20;
__global__ void __launch_bounds__(512, 2) mk_fwd(Args a) {
    extern __shared__ __attribute__((aligned(16))) unsigned char lds_raw[];
    LAS unsigned char* lds = (LAS unsigned char*)lds_raw;
    cg::grid_group grid = cg::this_grid();
    if (threadIdx.x < 4) ((LAS unsigned*)(lds + L_BARST))[threadIdx.x] = 0u;
    __syncthreads();
    const XcdBarrier xbar = xcd_barrier_post((unsigned*)(a.ws + WS_BAR), (volatile LAS unsigned*)(lds + L_BARST));
    unsigned char* ws = a.ws;
    float* MOD = (float*)(ws + WS_MOD); h16* QK32 = (h16*)(ws + WS_QK32); h16* P16 = (h16*)(ws + WS_P16); h16* H16 = (h16*)(ws + WS_H16);
    h16* Y16 = (h16*)(ws + WS_Y32); h16* ACT = (h16*)(ws + WS_ACT); float* X = a.out;
    h16* XB16 = (h16*)(ws + WS_XB16);
    const int lo = a.ph_lo, hi = a.ph_hi;
#define IN(k) (lo <= (k) && (k) < hi)
    if (lo > 1000) grid.sync();
#define SEAM(k) do { if (IN(k) && IN((k) + 1)) { \
        xcd_barrier(xbar); \
    } } while (0)
    if (IN(0)) { phase_prologue(a, lds); } SEAM(0);
    if (IN(1)) { phase_post<false, false, false, true, 2>(a.in[0], nullptr, nullptr, MOD, 0, nullptr, a.in[4], MOD, 0, D, H16); prologue_weights(a, lds, 1); } SEAM(1);
#define LAYER(l) do { \
    const float* modl = MOD + (size_t)(l) * NB * 6 * D; constexpr int pb = 2 + 9 * (l); \
    mls::Args ma{P16, a.in[29] + (l) * 4 * 768, a.in[30] + (l) * 768, a.in[31] + (l) * H_ML, a.in[32] + (l) * H_ML, a.in[33] + (l) * C_ML, (float*)(ws + mls::WS_KVB), (float*)(ws + mls::WS_KSUM), (float*)(ws + mls::WS_MUB), H16, (float*)(ws + mls::WS_GT), (const h16*)(ws + WS_CW16) + (size_t)(l) * 5 * 768}; \
    if (IN(pb + 0)) { for (int it = blockIdx.x; it < 512; it += gridDim.x) skinny_item(H16, (const h16*)(ws + WS_WSM) + (size_t)(l) * 32 * D, P16, it, lds); \
        pg8::Gemm g{H16, (const h16*)(ws + WS_WIN) + (size_t)(l) * NIN_PAD * D, M, NIN_PAD, D}; pg8::StaticOrder So; So.init(M, NIN_PAD, gridDim.x, blockIdx.x); \
        pg8::EpiProj E{QK32, P16, (h16*)(ws + WS_VTG)}; pg8::gemm_phase<pg8::EpiProj, pg8::StaticOrder, true, true>(lds, g, So, E); } SEAM(pb + 0); \
    if (IN(pb + 1)) { nsa::CmpArgs ca{QK32, P16, (const h16*)(ws + WS_W1C) + (size_t)(l) * 2 * 64 * 2048, (const float*)(ws + WS_CBIAS) + (l) * 128, a.in[13] + (l) * 4096, a.in[15] + (l) * 4096, (h16*)(ws + WS_KC16), (h16*)(ws + WS_VC16)}; \
        for (int it = blockIdx.x; it < 256; it += gridDim.x) nsa::compress_item(ca, it >> 5, (it >> 4) & 1, it & 15, lds); \
        for (int it = blockIdx.x; it < 3072; it += gridDim.x) mls::m1_item(ma, it >> 6, it & 63, lds); \
        rwk::PrepArgs rp{P16, a.in[18] + (l) * RW_IN, a.in[19] + (l) * C_RW, a.in[21] + (l) * C_RW, a.in[24] + (l) * C_RW, (const h16*)(ws + rwk::WS_LRW) + (size_t)(l) * rwk::LRW_L, (h16*)(ws + rwk::WS_WE), (h16*)(ws + rwk::WS_AA), (h16*)(ws + rwk::WS_GG), (float*)(ws + rwk::WS_RN)}; \
        for (int it = blockIdx.x; it < 512; it += gridDim.x) rwk::prep_item(rp, it, lds); } SEAM(pb + 1); \
    if (IN(pb + 2)) { nsa::AttnArgs aa{QK32, P16, (const h16*)(ws + WS_KC16), (const h16*)(ws + WS_VC16), (const h16*)(ws + WS_VTG), a.in[16] + (l) * 12, a.in[17] + (l) * 256, H16}; \
        rwk::ScanArgs rs{P16, (const h16*)(ws + rwk::WS_WE), (const h16*)(ws + rwk::WS_AA), (const float*)(ws + rwk::WS_RN), a.in[18] + (l) * RW_IN, a.in[24] + (l) * C_RW, a.in[25] + (l) * C_RW, H16}; \
        rwk::PostArgs rq{P16, (const h16*)(ws + rwk::WS_AA), (const h16*)(ws + rwk::WS_GG), a.in[18] + (l) * RW_IN, a.in[25] + (l) * C_RW, a.in[26] + (l) * C_RW, a.in[27] + (l) * C_RW, a.in[28] + (l) * C_RW, H16}; \
        if (blockIdx.x < 48) { rwk::scan_item(rs, blockIdx.x, lds); rwk::post_head(rq, blockIdx.x / H_RW, blockIdx.x % H_RW); } \
        {     \
            volatile LAS unsigned* qs = (volatile LAS unsigned*)(lds + L_QSLOT); \
            for (int kq = 0; kq < 8; ++kq) {   \
            const int xq = (int)((xbar.x + (unsigned)kq) & 7u); unsigned* qh = (unsigned*)(ws + WS_QCTR) + 64 * ((l) * 8 + xq); unsigned* m2d = (unsigned*)(ws + WS_QCTR) + 64 * (32 + (l) * 8 + xq); int it; \
            for (;;) { __syncthreads(); if (threadIdx.x == 0) *qs = atomicAdd(qh, 1u); __syncthreads(); it = (int)*qs; if (it >= 24 + 64) break; \
                if (it < 24) { mls::m2_item(ma, xq * 6 + (it >> 2), it & 3); asm volatile("s_waitcnt vmcnt(0)" ::: "memory"); __syncthreads(); \
                               if (threadIdx.x == 0) { __builtin_amdgcn_fence(__ATOMIC_RELEASE, "agent"); asm volatile("s_waitcnt vmcnt(0)" ::: "memory"); __hip_atomic_fetch_add(m2d, 1u, __ATOMIC_RELAXED, __HIP_MEMORY_SCOPE_AGENT); } } \
                else nsa::attn_item(aa, xq, 63 - (it - 24), lds); } \
            if (it < 24 + 64 + 384) {   \
                if (threadIdx.x == 0) { while (__hip_atomic_load(m2d, __ATOMIC_RELAXED, __HIP_MEMORY_SCOPE_AGENT) < 24u) __builtin_amdgcn_s_sleep(8); } \
                __syncthreads(); __builtin_amdgcn_fence(__ATOMIC_ACQUIRE, "agent"); asm volatile("s_waitcnt vmcnt(0)" ::: "memory"); \
                mls::M3Regs mr; mls::m3_load(mr, ma, xq * 384 + (it - 88), threadIdx.x); \
                while (it < 24 + 64 + 384) { __syncthreads(); if (threadIdx.x == 0) *qs = atomicAdd(qh, 1u); __syncthreads(); const int nx = (int)*qs; \
                    mls::m3_item(ma, xq * 384 + (it - 88), nx < 24 + 64 + 384 ? xq * 384 + (nx - 88) : -1, mr, lds); it = nx; } } } } } SEAM(pb + 2); \
    if (IN(pb + 4)) { pg8::Gemm g{H16, (const h16*)(ws + WS_WOUT) + (size_t)(l) * D * D, M, D, D}; pg8::StaticOrder So; So.init(M, D, gridDim.x, blockIdx.x); \
        pg8::EpiF16 E{Y16, D}; pg8::gemm_phase<pg8::EpiF16, pg8::StaticOrder, true, true>(lds, g, So, E); } SEAM(pb + 4); \
    if (IN(pb + 5)) { phase_post<(l) != 0, true, true, true, 2>((l) == 0 ? (const void*)a.in[0] : (const void*)X, Y16, a.in[5] + (l) * D, modl, 2 * D, XB16, a.in[6] + (l) * D, modl, 3 * D, 4 * D, H16); } SEAM(pb + 5); \
    if (IN(pb + 6)) { pg8::Gemm g{H16, (const h16*)(ws + WS_W1) + (size_t)(l) * NFF2 * D, M, NFF2, D}; pg8::StaticOrder So; So.init(M, NFF2, gridDim.x, blockIdx.x); \
        pg8::EpiSwiglu E{ACT, DFF}; pg8::gemm_phase<pg8::EpiSwiglu, pg8::StaticOrder, true, true>(lds, g, So, E); } SEAM(pb + 6); \
    if (IN(pb + 7)) { pg8::Gemm g{ACT, (const h16*)(ws + WS_W2) + (size_t)(l) * D * DFF, M, D, DFF}; pg8::StaticOrder So; So.init(M, D, gridDim.x, blockIdx.x); \
        pg8::EpiF16 E{Y16, D}; pg8::gemm_phase<pg8::EpiF16, pg8::StaticOrder, true, true>(lds, g, So, E); } SEAM(pb + 7); \
    if (IN(pb + 8)) { constexpr bool last = ((l) == DEPTH - 1); \
        phase_post<true, !last, true, !last, 2>(XB16, Y16, a.in[7] + (l) * D, modl, 5 * D, X, last ? nullptr : a.in[4] + ((l) + 1) * D, MOD + (size_t)(last ? (l) : (l) + 1) * NB * 6 * D, 0, D, H16); } \
    if (!((l) == DEPTH - 1)) SEAM(pb + 8); \
    } while (0)
    LAYER(0);
    LAYER(1);
#undef LAYER
#undef SEAM
#undef IN
}

static int g_grid = 0;
static void launch_mk(const Args& a0, int lo, int hi, hipStream_t stream) {
    Args a = a0; a.ph_lo = lo; a.ph_hi = hi;
    void* args[] = {(void*)&a};
    hipError_t e = hipLaunchCooperativeKernel((const void*)mk_fwd, dim3(g_grid), dim3(512), args, LDS_BYTES, stream);
    if (e != hipSuccess) fprintf(stderr, "cooperative launch failed: %s (grid %d)\n", hipGetErrorString(e), g_grid);
}
extern "C" void kernel_launch(void* const* d_in, const int* in_sizes, int n_in, void* d_out, int out_size, void* d_ws, size_t ws_size, hipStream_t stream) {
    if (n_in != 37 || ws_size < WS_END2) { fprintf(stderr, "kernel_launch: unexpected n_in %d / ws %zu\n", n_in, ws_size); return; }
    if (!g_grid) {
        int dev = 0, cus = 0, per_cu = 0;
        hipGetDevice(&dev); hipDeviceGetAttribute(&cus, hipDeviceAttributeMultiprocessorCount, dev);
        hipFuncSetAttribute((const void*)mk_fwd, hipFuncAttributeMaxDynamicSharedMemorySize, LDS_BYTES);
        hipOccupancyMaxActiveBlocksPerMultiprocessor(&per_cu, (const void*)mk_fwd, 512, LDS_BYTES);
        if (per_cu < 1) { fprintf(stderr, "kernel_launch: occupancy query says %d blocks/CU\n", per_cu); per_cu = 1; }
        g_grid = cus * (per_cu > 1 ? 1 : per_cu);
    }
    const float* const* in = (const float* const*)d_in;
    Args a{};
    for (int i = 0; i < 37; ++i) a.in[i] = in[i];
    a.out = (float*)d_out; a.ws = (unsigned char*)d_ws;
    hipMemsetAsync((char*)d_ws + WS_BAR, 0, 32768, stream);
    launch_mk(a, 0, N_PHASES, stream);
}
```

```cpp
#include <hip/hip_runtime.h>
#include <cstdio>
#include <cstdint>

typedef _Float16 h16;

constexpr int D = 1024, NB = 8, S = 4096, M = NB * S, DEPTH = 2;
constexpr int HD = 64;
constexpr int C_ATT = 256, C_RW = 384, C_ML = 384;
constexpr int H_ATT = 4, H_RW = 6, H_ML = 6;
constexpr int NSA_IN = 652, RW_IN = 1408, ML_IN = 1548, D_IN = 3608;
constexpr int DFF = 2816;
constexpr int NCMP = 255, NSLC = 64;
constexpr int PITCH = 3296;
constexpr int PC_VC = 0, PC_KS = 64, PC_VS = 128, PC_KW = 192, PC_VW = 256;
constexpr int PC_R = 320, PC_K = 704, PC_V = 1088, PC_XW = 1472, PC_XA = 1536, PC_XG = 1600;
constexpr int PC_MQ = 1728, PC_MK = 2112, PC_MV = 2496, PC_MO = 2880;
constexpr int PC_GTS = 3264, PC_IG = 3276, PC_FG = 3282;
constexpr int QKP = 320;
constexpr float QSCALE_Q = 0.125f * 1.4426950408889634f;

constexpr size_t MiB = 1u << 20;
constexpr size_t WS_MOD = 0;
constexpr size_t WS_QK32 = 4 * MiB;
constexpr size_t WS_P16 = 44 * MiB;
constexpr size_t WS_H16 = 250 * MiB;
constexpr size_t WS_Y32 = 314 * MiB;
constexpr size_t WS_XB16 = 184 * MiB;
constexpr size_t WS_ACT = 4 * MiB;
constexpr size_t WS_END = 442 * MiB;

__device__ __forceinline__ float wave_sum(float v) {
#pragma unroll
    for (int o = 32; o > 0; o >>= 1) v += __shfl_xor(v, o);
    return v;
}
__device__ __forceinline__ float wave_max(float v) {
#pragma unroll
    for (int o = 32; o > 0; o >>= 1) v = fmaxf(v, __shfl_xor(v, o));
    return v;
}
__device__ __forceinline__ float sigmoidf_(float x) { return 1.f / (1.f + expf(-x)); }
__device__ __forceinline__ float siluf_(float x) { return x * sigmoidf_(x); }
__device__ __forceinline__ float softplusf_(float x) { return fmaxf(x, 0.f) + log1pf(expf(-fabsf(x))); }
__device__ __forceinline__ float gelu_tanh(float x) { return 0.5f * x * (1.f + tanhf(0.7978845608028654f * (x + 0.044715f * x * x * x))); }

#include <hip/hip_cooperative_groups.h>
namespace cg = cooperative_groups;

namespace pg8 {
#define PG8_LAS __attribute__((address_space(3)))
typedef short s16x8 __attribute__((ext_vector_type(8)));
typedef _Float16 f16x8 __attribute__((ext_vector_type(8)));
typedef float f32x4 __attribute__((ext_vector_type(4)));
typedef unsigned u32x4 __attribute__((ext_vector_type(4)));
typedef unsigned u32x2 __attribute__((ext_vector_type(2)));
constexpr int BM = 256, BK = 64, HALF = 128, HTB = HALF * BK * 2  , STAGE_BYTES = 8 * HTB, NXCD = 8, WGM = 8;

__host__ __device__ __forceinline__ int lds_byte(int r, int c) { const int st = (r >> 4) * 2 + (c >> 5), rr = r & 15, cc = c & 31, ob = rr * 64 + cc * 2; return st * 1024 + (ob ^ (((ob >> 9) & 1) << 5)); }
__host__ __device__ __forceinline__ void stage_rc(int b, int& R, int& C) { const int st = b / 1024, sb = b % 1024, swz = sb ^ (((sb >> 9) & 1) << 5); R = (st >> 1) * 16 + swz / 64; C = (st & 1) * 32 + (swz % 64) / 2; }
__host__ __device__ __forceinline__ int perm32(int rho) { const int n = rho >> 4, i = rho & 15; return 8 * (i >> 2) + 4 * n + (i & 3); }

struct Unit { int pm, pn; };
struct Gemm { const h16* A; const h16* Bt; int M, N, K; };

struct StaticOrder {
    int nM, nN, nwg, G, c;
    __host__ __device__ void init(int M, int N, int G_, int c_) { nM = M / BM; nN = N / BM; nwg = nM * nN; G = G_; c = c_; }
    __host__ __device__ bool next(int i, Unit& u) const {
        const long L = (long)i * G + c; if (L >= nwg) return false;
        int wgid = (int)L; { const int q = nwg / NXCD, r = nwg % NXCD, xcd = wgid % NXCD, off = wgid / NXCD; wgid = (xcd < r ? xcd * (q + 1) : r * (q + 1) + (xcd - r) * q) + off; }
        const int nig = WGM * nN, gid = wgid / nig, fm = gid * WGM, gsz = (nM - fm) < WGM ? (nM - fm) : WGM;
        u.pm = fm + ((wgid % nig) % gsz); u.pn = (wgid % nig) / gsz; return true;
    }
    __device__ __forceinline__ void a_ready(const Unit&) const {}
    __device__ __forceinline__ void done(const Unit&) const {}
};

__device__ __forceinline__ unsigned pk_f16(float lo, float hi) { typedef _Float16 h2 __attribute__((ext_vector_type(2))); h2 v = {(_Float16)lo, (_Float16)hi}; return __builtin_bit_cast(unsigned, v); }

struct EpiProj {
    static constexpr bool PERM = true, AFTER_DRAIN = false; static constexpr int NSTORE = 16;
    h16* QK; h16* P; h16* VT;
    __device__ __forceinline__ void operator()(const f32x4 (&acc)[2][2][4][2], const Unit& u, int wr, int wc, int fr, int fq) const {
        const int row0 = u.pm * BM + wr * 64 + fr;
#pragma unroll
        for (int bj = 0; bj < 2; ++bj) {
            const int colt = u.pn * BM + bj * HALF + wc * 32 + 8 * fq;
            if (colt < 320) {
                const float qs = colt < 256 ? QSCALE_Q : 1.f;
#pragma unroll
                for (int ai = 0; ai < 2; ++ai)
#pragma unroll
                    for (int m = 0; m < 4; ++m) { const f32x4 v0 = acc[ai][bj][m][0], v1 = acc[ai][bj][m][1];
                        u32x4 w; w.x = pk_f16(v0[0] * qs, v0[1] * qs); w.y = pk_f16(v0[2] * qs, v0[3] * qs); w.z = pk_f16(v1[0] * qs, v1[1] * qs); w.w = pk_f16(v1[2] * qs, v1[3] * qs);
                        *(u32x4*)(QK + (size_t)(row0 + ai * HALF + m * 16) * QKP + colt) = w; }
            } else if ((colt >= 448 && colt < 512) || (colt >= 576 && colt < 640)) {
                const int br = colt >= 576 ? 1 : 0, d0 = colt - (br ? 576 : 448);
#pragma unroll
                for (int ai = 0; ai < 2; ++ai)
#pragma unroll
                    for (int m = 0; m < 4; ++m) { const int row = row0 + ai * HALF + m * 16, bb = row / S, tl = row % S;
                        h16* vp = VT + (((size_t)bb * 2 + br) * 64 + d0) * S + tl;
#pragma unroll
                        for (int e = 0; e < 4; ++e) { vp[(size_t)e * S] = (h16)acc[ai][bj][m][0][e]; vp[(size_t)(4 + e) * S] = (h16)acc[ai][bj][m][1][e]; } }
            } else {
#pragma unroll
                for (int ai = 0; ai < 2; ++ai)
#pragma unroll
                    for (int m = 0; m < 4; ++m) { const f32x4 v0 = acc[ai][bj][m][0], v1 = acc[ai][bj][m][1];
                        u32x4 w; w.x = pk_f16(v0[0], v0[1]); w.y = pk_f16(v0[2], v0[3]); w.z = pk_f16(v1[0], v1[1]); w.w = pk_f16(v1[2], v1[3]);
                        *(u32x4*)(P + (size_t)(row0 + ai * HALF + m * 16) * PITCH + (colt - 320)) = w; }
            }
        }
    }
};
struct EpiF16 {
    static constexpr bool PERM = true, AFTER_DRAIN = false; static constexpr int NSTORE = 16;
    h16* C; int ldc;
    __device__ __forceinline__ void operator()(const f32x4 (&acc)[2][2][4][2], const Unit& u, int wr, int wc, int fr, int fq) const {
        const int row0 = u.pm * BM + wr * 64 + fr;
#pragma unroll
        for (int ai = 0; ai < 2; ++ai)
#pragma unroll
            for (int m = 0; m < 4; ++m)
#pragma unroll
                for (int bj = 0; bj < 2; ++bj) { const f32x4 v0 = acc[ai][bj][m][0], v1 = acc[ai][bj][m][1];
                    u32x4 w; w.x = pk_f16(v0[0], v0[1]); w.y = pk_f16(v0[2], v0[3]); w.z = pk_f16(v1[0], v1[1]); w.w = pk_f16(v1[2], v1[3]);
                    *(u32x4*)(C + (size_t)(row0 + ai * HALF + m * 16) * ldc + u.pn * BM + bj * HALF + wc * 32 + 8 * fq) = w; }
    }
};
struct EpiSwiglu {
    static constexpr bool PERM = true, AFTER_DRAIN = false; static constexpr int NSTORE = 8;
    h16* C; int ldc;
    __device__ __forceinline__ void operator()(const f32x4 (&acc)[2][2][4][2], const Unit& u, int wr, int wc, int fr, int fq) const {
        const int row0 = u.pm * BM + wr * 64 + fr;
#pragma unroll
        for (int ai = 0; ai < 2; ++ai)
#pragma unroll
            for (int m = 0; m < 4; ++m) { float o[8];
#pragma unroll
                for (int n = 0; n < 2; ++n)
#pragma unroll
                    for (int e = 0; e < 4; ++e) { const float gt = acc[ai][0][m][n][e]; o[4 * n + e] = gt * __builtin_amdgcn_rcpf(1.f + __expf(-gt)) * acc[ai][1][m][n][e]; }
                u32x4 w; w.x = pk_f16(o[0], o[1]); w.y = pk_f16(o[2], o[3]); w.z = pk_f16(o[4], o[5]); w.w = pk_f16(o[6], o[7]);
                *(u32x4*)(C + (size_t)(row0 + ai * HALF + m * 16) * ldc + u.pn * HALF + wc * 32 + 8 * fq) = w; }
    }
};

template <class Epi, class Sched, bool ALIGN_EPI = false, bool SP2 = false>
__device__ __forceinline__ void gemm_phase(PG8_LAS unsigned char* lds, const Gemm g, const Sched& S, const Epi& E) {
    int tid_ = threadIdx.x; asm volatile("" : "+v"(tid_)); const int tid = tid_, wid = __builtin_amdgcn_readfirstlane(tid >> 6), lane = tid & 63, wr = wid >> 2, wc = wid & 3, fr = lane & 15, fq = lane >> 4;
    const int K = g.K, nt = K / BK;
    unsigned voffA[2], voffB[2];
#pragma unroll
    for (int i = 0; i < 2; ++i) { int R, C; stage_rc(tid * 16 + i * 8192, R, C); const int Rb = Epi::PERM ? ((R & ~31) + perm32(R & 31)) : R;
        voffA[i] = (unsigned)(R * K + C) * 2u; voffB[i] = (unsigned)(Rb * K + C) * 2u; }
    const size_t kstep = (size_t)(BK * 2);
    const size_t hstep = (size_t)HALF * K * 2;
    const size_t tstep = 2 * hstep;
    const unsigned ldsw = (unsigned)wid * 1024u;
    const int aoff = lds_byte(wr * 64 + fr, fq * 8), boff = lds_byte(wc * 32 + fr, fq * 8);
#define PG8_SA(b, h) (((b) * 2 + (h)) * HTB)
#define PG8_SB(b, h) ((4 + (b) * 2 + (h)) * HTB)
#define PG8_STAGE(bufoff, gbase, voff) do { _Pragma("unroll") for (int _i = 0; _i < 2; ++_i) \
        __builtin_amdgcn_global_load_lds((const unsigned*)((const char*)(gbase) + (voff)[_i]), (PG8_LAS unsigned*)(lds + (bufoff) + ldsw + _i * 8192), 16, 0, 0); } while (0)
#define PG8_LDA(dst, b, h) do { _Pragma("unroll") for (int m = 0; m < 4; ++m) _Pragma("unroll") for (int k = 0; k < 2; ++k) dst[m][k] = *(const PG8_LAS s16x8*)(lds + PG8_SA(b, h) + aoff + m * 2048 + k * 1024); } while (0)
#define PG8_LDB(dst, b, h) do { _Pragma("unroll") for (int n = 0; n < 2; ++n) _Pragma("unroll") for (int k = 0; k < 2; ++k) dst[n][k] = *(const PG8_LAS s16x8*)(lds + PG8_SB(b, h) + boff + n * 2048 + k * 1024); } while (0)
#define PG8_MMA(ai, bj, At, Bt) do { __builtin_amdgcn_s_setprio(1); _Pragma("unroll") for (int m = 0; m < 4; ++m) _Pragma("unroll") for (int n = 0; n < 2; ++n) _Pragma("unroll") for (int k = 0; k < 2; ++k) \
        acc[ai][bj][m][n] = __builtin_amdgcn_mfma_f32_16x16x32_f16(__builtin_bit_cast(f16x8, Bt[n][k]), __builtin_bit_cast(f16x8, At[m][k]), acc[ai][bj][m][n], 0, 0, 0); __builtin_amdgcn_s_setprio(0); } while (0)
#define PG8_WAIT_V(n) asm volatile("s_waitcnt vmcnt(" #n ")" ::: "memory")
#define PG8_WAIT_VF(f, n) asm volatile("s_cmp_lg_u32 %0, 0\n\ts_cbranch_scc1 .Lpg8wv%=\n\ts_waitcnt vmcnt(8)\n.Lpg8wv%=:\n\ts_waitcnt vmcnt(%1)" :: "s"(f), "n"(n) : "memory", "scc")
#define PG8_WAIT_L(n) asm volatile("s_waitcnt lgkmcnt(" #n ")" ::: "memory")
#define PG8_BAR __builtin_amdgcn_s_barrier()
#define PG8_SCHED __builtin_amdgcn_sched_barrier(0)
    Unit cur, nxt; int ui = 0;
    if (!S.next(0, cur)) return;
    f32x4 acc[2][2][4][2];
#pragma unroll
    for (int a = 0; a < 2; ++a)
#pragma unroll
        for (int b = 0; b < 2; ++b)
#pragma unroll
            for (int m = 0; m < 4; ++m)
#pragma unroll
                for (int n = 0; n < 2; ++n) acc[a][b][m][n] = (f32x4){0.f, 0.f, 0.f, 0.f};
    s16x8 At[4][2], B0[2][2], B1[2][2];
    const char* cA = (const char*)g.A + (size_t)cur.pm * tstep; const char* cB = (const char*)g.Bt + (size_t)cur.pn * tstep;
    S.a_ready(cur);
    if constexpr (SP2) {
        PG8_STAGE(PG8_SB(0, 0), cB, voffB); PG8_STAGE(PG8_SB(0, 1), cB + hstep, voffB); PG8_STAGE(PG8_SA(0, 0), cA, voffA); PG8_STAGE(PG8_SA(0, 1), cA + hstep, voffA);
        if (wr == 1) PG8_BAR;
        PG8_WAIT_V(2); PG8_BAR;
        PG8_STAGE(PG8_SB(1, 0), cB + kstep, voffB); PG8_STAGE(PG8_SA(1, 0), cA + kstep, voffA); PG8_STAGE(PG8_SB(1, 1), cB + hstep + kstep, voffB);
        PG8_WAIT_V(6); PG8_BAR;
    } else {
        PG8_STAGE(PG8_SB(0, 0), cB, voffB); PG8_STAGE(PG8_SA(0, 0), cA, voffA); PG8_STAGE(PG8_SB(0, 1), cB + hstep, voffB); PG8_STAGE(PG8_SA(0, 1), cA + hstep, voffA);
        if (wr == 1) PG8_BAR;
        PG8_WAIT_V(4); PG8_BAR;
        PG8_STAGE(PG8_SB(1, 0), cB + kstep, voffB); PG8_STAGE(PG8_SA(1, 0), cA + kstep, voffA); PG8_STAGE(PG8_SB(1, 1), cB + hstep + kstep, voffB);
        PG8_WAIT_V(6); PG8_BAR;
    }
    for (;;) {
        const bool has_next = S.next(ui + 1, nxt);
        const char* nA = has_next ? (const char*)g.A + (size_t)nxt.pm * tstep : cA; const char* nB = has_next ? (const char*)g.Bt + (size_t)nxt.pn * tstep : cB;
        for (int t = 0; t < nt; t += 2) {
            const bool last = (t == nt - 2);
            const char* a1 = cA + (size_t)(t + 1) * kstep;
            const char* a2 = last ? nA : cA + (size_t)(t + 2) * kstep; const char* b2 = last ? nB : cB + (size_t)(t + 2) * kstep;
            const char* a3 = a2 + kstep; const char* b3 = b2 + kstep;
            if (last && has_next) S.a_ready(nxt);
            const int fe = __builtin_amdgcn_readfirstlane(((t == 0) && (ui > 0)) ? 1 : 0);
            if constexpr (SP2) {
            PG8_LDB(B0, 0, 0); PG8_LDB(B1, 0, 1); PG8_SCHED; PG8_LDA(At, 0, 0); PG8_STAGE(PG8_SA(1, 1), a1 + hstep, voffA);
            PG8_WAIT_VF(fe, 8 + Epi::NSTORE); PG8_WAIT_L(0); PG8_BAR; PG8_MMA(0, 0, At, B0); PG8_MMA(0, 1, At, B1); PG8_BAR; PG8_SCHED;
            PG8_LDA(At, 0, 1); PG8_STAGE(PG8_SB(0, 0), b2, voffB); PG8_STAGE(PG8_SB(0, 1), b2 + hstep, voffB); PG8_STAGE(PG8_SA(0, 0), a2, voffA);
            PG8_WAIT_VF(fe, 8 + Epi::NSTORE); PG8_WAIT_L(0); PG8_BAR; PG8_MMA(1, 0, At, B0); PG8_MMA(1, 1, At, B1); PG8_BAR; PG8_SCHED;
            PG8_LDB(B0, 1, 0); PG8_LDB(B1, 1, 1); PG8_SCHED; PG8_LDA(At, 1, 0); PG8_STAGE(PG8_SA(0, 1), a2 + hstep, voffA);
            PG8_WAIT_V(8); PG8_WAIT_L(0); PG8_BAR; PG8_MMA(0, 0, At, B0); PG8_MMA(0, 1, At, B1); PG8_BAR; PG8_SCHED;
            PG8_LDA(At, 1, 1); PG8_STAGE(PG8_SB(1, 0), b3, voffB); PG8_STAGE(PG8_SB(1, 1), b3 + hstep, voffB); PG8_STAGE(PG8_SA(1, 0), a3, voffA);
            PG8_WAIT_V(8); PG8_WAIT_L(0); PG8_BAR; PG8_MMA(1, 0, At, B0); PG8_MMA(1, 1, At, B1); PG8_BAR; PG8_SCHED;
            } else {
            PG8_LDB(B0, 0, 0); PG8_SCHED; PG8_LDA(At, 0, 0); PG8_STAGE(PG8_SA(1, 1), a1 + hstep, voffA);
            PG8_WAIT_L(8); PG8_BAR; PG8_WAIT_L(0); PG8_MMA(0, 0, At, B0); PG8_BAR; PG8_SCHED;
            PG8_LDB(B1, 0, 1); PG8_STAGE(PG8_SB(0, 0), b2, voffB);
            PG8_BAR; PG8_WAIT_L(0); PG8_MMA(0, 1, At, B1); PG8_BAR;
            PG8_LDA(At, 0, 1); PG8_STAGE(PG8_SA(0, 0), a2, voffA);
            PG8_BAR; PG8_WAIT_L(0); PG8_MMA(1, 0, At, B0); PG8_BAR; PG8_SCHED;
            PG8_STAGE(PG8_SB(0, 1), b2 + hstep, voffB);
            PG8_WAIT_V(6); PG8_BAR; PG8_MMA(1, 1, At, B1); PG8_BAR;
            PG8_LDB(B0, 1, 0); PG8_SCHED; PG8_LDA(At, 1, 0); PG8_STAGE(PG8_SA(0, 1), a2 + hstep, voffA);
            PG8_WAIT_L(8); PG8_BAR; PG8_WAIT_L(0); PG8_MMA(0, 0, At, B0); PG8_BAR; PG8_SCHED;
            PG8_LDB(B1, 1, 1); PG8_STAGE(PG8_SB(1, 0), b3, voffB);
            PG8_BAR; PG8_WAIT_L(0); PG8_MMA(0, 1, At, B1); PG8_BAR;
            PG8_LDA(At, 1, 1); PG8_STAGE(PG8_SA(1, 0), a3, voffA);
            PG8_BAR; PG8_WAIT_L(0); PG8_MMA(1, 0, At, B0); PG8_BAR; PG8_SCHED;
            PG8_STAGE(PG8_SB(1, 1), b3 + hstep, voffB);
            PG8_WAIT_V(6); PG8_BAR; PG8_MMA(1, 1, At, B1); PG8_BAR;
            }
        }
        if constexpr (ALIGN_EPI) { if (wr == 0) PG8_BAR; }
        if constexpr (!Epi::AFTER_DRAIN) { E(acc, cur, wr, wc, fr, fq); S.done(cur); }
        if (!has_next) break;
#pragma unroll
        for (int a = 0; a < 2; ++a)
#pragma unroll
            for (int b = 0; b < 2; ++b)
#pragma unroll
                for (int m = 0; m < 4; ++m)
#pragma unroll
                    for (int n = 0; n < 2; ++n) acc[a][b][m][n] = (f32x4){0.f, 0.f, 0.f, 0.f};
        cur = nxt; cA = nA; cB = nB; ++ui;
        if constexpr (ALIGN_EPI) { if (wr == 1) PG8_BAR; }
    }
    PG8_WAIT_V(0);
    if constexpr (!ALIGN_EPI) { if (wr == 0) PG8_BAR; }
    PG8_BAR;
#undef PG8_SA
#undef PG8_SB
#undef PG8_STAGE
#undef PG8_LDA
#undef PG8_LDB
#undef PG8_MMA
#undef PG8_WAIT_V
#undef PG8_WAIT_VF
#undef PG8_WAIT_L
#undef PG8_BAR
#undef PG8_SCHED
}
}
constexpr size_t WS_WIN = 442 * MiB;
constexpr size_t WS_WOUT = 457 * MiB;
constexpr size_t WS_W1 = 461 * MiB;
constexpr size_t WS_W2 = 483 * MiB;
constexpr size_t WS_VTG = 496 * MiB;
constexpr size_t WS_CW16 = 509 * MiB;
constexpr size_t WS_END2 = 510 * MiB;
constexpr size_t WS_CBIAS = 512 * 1024;
constexpr size_t WS_KC16 = 1 * MiB;
constexpr size_t WS_VC16 = 1 * MiB + 512 * 1024;
constexpr size_t WS_W1C = 3 * MiB;
constexpr size_t WS_LRW0 = 2 * MiB;
constexpr int LRW_L0 = 384 * 64 * 2 + 384 * 128;
constexpr int NIN_PAD = 3584, NFF2 = 2 * DFF;
constexpr size_t WS_WSM = 508 * MiB;
constexpr int LDS_BYTES = 163840;
constexpr size_t WS_BAR = 400 * 1024;
constexpr int L_BARST = LDS_BYTES - 16;
constexpr size_t WS_QCTR = WS_BAR + 14336;
constexpr int L_QSLOT = LDS_BYTES - 32;
#define LAS __attribute__((address_space(3)))

struct Args { const float* in[37]; float* out; unsigned char* ws; int ph_lo, ph_hi; };

__device__ __forceinline__ int win_src_col(int nd) {
    if (nd < 320) return nd;
    const int c = nd - 320;
    if (c < 320) return c + 320;
    if (c < 3264) return c + 332;
    if (c < 3276) return c - 2624;
    if (c < 3288) return c + 320;
    return -1;
}
__device__ __forceinline__ int wsm_src_col(int r) { return r < 12 ? 640 + r : (r < 18 ? 3596 + (r - 12) : (r < 24 ? 3602 + (r - 18) : -1)); }
__device__ __forceinline__ void transpose_item(const float* cp, int ns, int K, h16* WT, int k0, int n0, LAS float* scr, int lane) {
    float tv[32];
#pragma unroll
    for (int i = 0; i < 32; ++i) { const int kk = 2 * i + (lane >> 5); tv[i] = cp ? __builtin_nontemporal_load(cp + (size_t)(k0 + kk) * ns) : 0.f; }
#pragma unroll
    for (int i = 0; i < 32; ++i) { const int kk = 2 * i + (lane >> 5); scr[kk * 33 + (lane & 31)] = tv[i]; }
    asm volatile("s_waitcnt lgkmcnt(0)" ::: "memory");
    const int c = lane & 7;
#pragma unroll
    for (int j = 0; j < 4; ++j) { const int n = (lane >> 3) + 8 * j; const LAS float* s = scr + (8 * c) * 33 + n;
        pg8::u32x4 o; o.x = pg8::pk_f16(s[0 * 33], s[1 * 33]); o.y = pg8::pk_f16(s[2 * 33], s[3 * 33]); o.z = pg8::pk_f16(s[4 * 33], s[5 * 33]); o.w = pg8::pk_f16(s[6 * 33], s[7 * 33]);
        *(pg8::u32x4*)(WT + (size_t)(n0 + n) * K + k0 + 8 * c) = o; }
    asm volatile("s_waitcnt lgkmcnt(0)" ::: "memory");
}

__device__ __forceinline__ void prologue_weights(const Args& a, LAS unsigned char* lds, int part) {
    int tid_ = threadIdx.x; asm volatile("" : "+v"(tid_)); const int tid = tid_, lane = tid & 63, wave = __builtin_amdgcn_readfirstlane(tid >> 6);
    const int G = gridDim.x, gw = blockIdx.x * 8 + wave, NGW = G * 8;
    LAS float* scr = (LAS float*)(lds + wave * 16384);
    constexpr int I_IN = 16 * (NIN_PAD / 32), I_OUT = 16 * 32, I_W1 = 16 * (NFF2 / 32), I_W2 = (DFF / 64) * 32, I_L = I_IN + I_OUT + I_W1 + I_W2;
    for (int it = gw; it < 2 * I_L; it += NGW) {
        const int l = it / I_L; int r = it % I_L;
        if ((part == 0) != (l == 0 && r < I_IN)) continue;
        if (r < I_IN) { const int nblk = NIN_PAD / 32, kb = r / nblk, nb = r % nblk; const int sc = win_src_col(nb * 32 + (lane & 31));
            transpose_item(sc >= 0 ? a.in[8] + (size_t)l * D * D_IN + sc : nullptr, D_IN, D, (h16*)(a.ws + WS_WIN) + (size_t)l * NIN_PAD * D, kb * 64, nb * 32, scr, lane); continue; }
        r -= I_IN;
        if (r < I_OUT) { const int kb = r / 32, nb = r % 32;
            transpose_item(a.in[9] + (size_t)l * D * D + nb * 32 + (lane & 31), D, D, (h16*)(a.ws + WS_WOUT) + (size_t)l * D * D, kb * 64, nb * 32, scr, lane); continue; }
        r -= I_OUT;
        if (r < I_W1) { const int nblk = NFF2 / 32, kb = r / nblk, nb = r % nblk; const int nd = nb * 32 + (lane & 31);
            const float* src = (((nd >> 7) & 1) ? a.in[35] : a.in[34]) + (size_t)l * D * DFF + (128 * (nd >> 8) + (nd & 127));
            transpose_item(src, DFF, D, (h16*)(a.ws + WS_W1) + (size_t)l * NFF2 * D, kb * 64, nb * 32, scr, lane); continue; }
        r -= I_W1;
        { const int kb = r / 32, nb = r % 32;
            transpose_item(a.in[36] + (size_t)l * DFF * D + nb * 32 + (lane & 31), D, DFF, (h16*)(a.ws + WS_W2) + (size_t)l * D * DFF, kb * 64, nb * 32, scr, lane); }
    }
}
__device__ __forceinline__ void phase_prologue(const Args& a, LAS unsigned char* lds) {
    int tid_ = threadIdx.x; asm volatile("" : "+v"(tid_)); const int tid = tid_, lane = tid & 63, wave = __builtin_amdgcn_readfirstlane(tid >> 6);
    const int G = gridDim.x, gw = blockIdx.x * 8 + wave, NGW = G * 8;
    LAS float* scr = (LAS float*)(lds + wave * 16384);
    prologue_weights(a, lds, 0);
    for (int i = blockIdx.x * 512 + tid; i < 2 * 5 * 768; i += G * 512) {
        const int l = i / 3840, r = i % 3840; ((h16*)(a.ws + WS_CW16))[i] = (h16)(r < 3072 ? a.in[29][l * 3072 + r] : a.in[30][l * 768 + (r - 3072)]); }
    for (int it = gw; it < 2 * 16; it += NGW) {
        const int l = it >> 4, kb = it & 15; const int sc = wsm_src_col(lane & 31);
        transpose_item(sc >= 0 ? a.in[8] + (size_t)l * D * D_IN + sc : nullptr, D_IN, D, (h16*)(a.ws + WS_WSM) + (size_t)l * 32 * D, kb * 64, 0, scr, lane); }
    for (int it = gw; it < 4 * 64; it += NGW) {
        const int mat = it >> 6, r = it & 63, l = mat >> 1, kv = mat & 1, kb = r >> 1, nb = r & 1;
        transpose_item((kv ? a.in[14] : a.in[12]) + (size_t)l * 2048 * 64 + nb * 32 + (lane & 31), 64, 2048, (h16*)(a.ws + WS_W1C) + (size_t)mat * 64 * 2048, kb * 64, nb * 32, scr, lane);
    }
    for (int it = gw; it < 2 * 48; it += NGW) {
        const int l = it / 48, r = it % 48;
        h16* dst = (h16*)(a.ws + WS_LRW0) + (size_t)l * LRW_L0;
        if (r < 12) transpose_item(a.in[20] + (size_t)l * 64 * C_RW + r * 32 + (lane & 31), C_RW, 64, dst, 0, r * 32, scr, lane);
        else if (r < 24) transpose_item(a.in[22] + (size_t)l * 64 * C_RW + (r - 12) * 32 + (lane & 31), C_RW, 64, dst + 384 * 64, 0, (r - 12) * 32, scr, lane);
        else { const int kb = (r - 24) / 12, nb = (r - 24) % 12; transpose_item(a.in[23] + (size_t)l * 128 * C_RW + nb * 32 + (lane & 31), C_RW, 128, dst + 2 * 384 * 64, kb * 64, nb * 32, scr, lane); }
    }
    if (blockIdx.x >= G - 4) {
        const int u = G - 1 - (int)blockIdx.x, l = u >> 1, kv = u & 1; const float* pe = (kv ? a.in[11] : a.in[10]) + l * 2048 + wave * 256; const float* w1 = (kv ? a.in[14] : a.in[12]) + (size_t)l * 2048 * 64 + (size_t)wave * 256 * 64 + lane;
        float sacc = 0.f;
#pragma unroll 1
        for (int k = 0; k < 256; k += 16) { float wv[16];
#pragma unroll
            for (int j = 0; j < 16; ++j) wv[j] = w1[(size_t)(k + j) * 64];
#pragma unroll
            for (int j = 0; j < 16; ++j) sacc += pe[k + j] * wv[j]; }
        LAS float* bred = (LAS float*)(lds + 8 * 16384);
        bred[wave * 64 + lane] = sacc;
        __syncthreads();
        if (wave == 0) { float t = 0.f;
#pragma unroll
            for (int j = 0; j < 8; ++j) t += bred[j * 64 + lane];
            ((float*)(a.ws + WS_CBIAS))[u * 64 + lane] = t; }
    }
    __syncthreads();
    LAS float* cs = (LAS float*)lds;
    LAS float* red = (LAS float*)(lds + 32768);
    for (int i = tid; i < NB * D; i += 512) { const float v = a.in[1][i]; cs[i] = v / (1.f + __expf(-v)); }
    __syncthreads();
    float* MOD = (float*)(a.ws + WS_MOD);
    for (int u = blockIdx.x; u < 2 * 96; u += G) {
        const int l = u / 96, col = (u % 96) * 64 + (tid & 63), ks = tid >> 6;
        const float* w = a.in[2] + (size_t)l * D * 6 * D + col;
        float acc[8];
#pragma unroll
        for (int b = 0; b < 8; ++b) acc[b] = 0.f;
#pragma unroll 1
        for (int k = ks * 128; k < ks * 128 + 128; k += 16) { float wv[16];
#pragma unroll
            for (int j = 0; j < 16; ++j) wv[j] = w[(size_t)(k + j) * 6 * D];
#pragma unroll
            for (int j = 0; j < 16; ++j)
#pragma unroll
                for (int b = 0; b < 8; ++b) acc[b] += cs[b * D + k + j] * wv[j]; }
#pragma unroll
        for (int b = 0; b < 8; ++b) red[(ks * 8 + b) * 64 + (tid & 63)] = acc[b];
        __syncthreads();
        { const int b = tid >> 6; float s = a.in[3][l * 6 * D + col];
#pragma unroll
          for (int k2 = 0; k2 < 8; ++k2) s += red[(k2 * 8 + b) * 64 + (tid & 63)];
          MOD[((size_t)l * NB + b) * 6 * D + col] = s; }
        __syncthreads();
    }
}

template <bool XH> struct XRaw;
template <> struct XRaw<false> { pg8::f32x4 x[2][2]; };
template <> struct XRaw<true> { pg8::u32x4 x[2]; };
__device__ __forceinline__ void x_load(XRaw<false>& R, const void* base, size_t off) {
#pragma unroll
    for (int j = 0; j < 2; ++j) { const float* p = (const float*)base + off + j * 512; R.x[j][0] = __builtin_nontemporal_load((const pg8::f32x4*)p); R.x[j][1] = __builtin_nontemporal_load((const pg8::f32x4*)(p + 4)); }
}
__device__ __forceinline__ void x_load(XRaw<true>& R, const void* base, size_t off) {
#pragma unroll
    for (int j = 0; j < 2; ++j) R.x[j] = __builtin_nontemporal_load((const pg8::u32x4*)((const h16*)base + off + j * 512));
}
__device__ __forceinline__ float h_lo(unsigned w) { return (float)__builtin_bit_cast(_Float16, (unsigned short)(w & 0xffffu)); }
__device__ __forceinline__ float h_hi(unsigned w) { return (float)__builtin_bit_cast(_Float16, (unsigned short)(w >> 16)); }
__device__ __forceinline__ void h_unpack(const pg8::u32x4 w, float (&o)[8]) { o[0] = h_lo(w.x); o[1] = h_hi(w.x); o[2] = h_lo(w.y); o[3] = h_hi(w.y); o[4] = h_lo(w.z); o[5] = h_hi(w.z); o[6] = h_lo(w.w); o[7] = h_hi(w.w); }
__device__ __forceinline__ void x_unpack(const XRaw<false>& R, int j, float (&o)[8]) {
#pragma unroll
    for (int e = 0; e < 4; ++e) { o[e] = R.x[j][0][e]; o[4 + e] = R.x[j][1][e]; } }
__device__ __forceinline__ void x_unpack(const XRaw<true>& R, int j, float (&o)[8]) { h_unpack(R.x[j], o); }
template <bool XI, bool HASY> struct PostRaw { XRaw<XI> x; pg8::u32x4 y[2]; };
template <bool XI, bool HASY>
__device__ __forceinline__ void post_load(PostRaw<XI, HASY>& R, const void* xold, const h16* y, int tok, int lane) {
    const size_t off = (size_t)tok * D + lane * 8;
    if constexpr (HASY) {
#pragma unroll
        for (int j = 0; j < 2; ++j) R.y[j] = __builtin_nontemporal_load((const pg8::u32x4*)(y + off + j * 512)); }
    x_load(R.x, xold, off);
}
template <bool XI, bool XO, bool HASY, bool HASH>
__device__ __forceinline__ void post_row(const PostRaw<XI, HASY>& R, int tok, int lane, const float (&pa)[2][8], const float (&pb)[2][8], const float (&pc)[2][8], void* xnew, h16* H) {
    float v[2][8]; float s2 = 0.f;
    if constexpr (HASY) {
        float ss = 0.f;
#pragma unroll
        for (int j = 0; j < 2; ++j) { h_unpack(R.y[j], v[j]);
#pragma unroll
            for (int e = 0; e < 8; ++e) ss += v[j][e] * v[j][e]; }
        const float rstd = rsqrtf(wave_sum(ss) * (1.f / D) + 1e-6f);
#pragma unroll
        for (int j = 0; j < 2; ++j) { float xo[8]; x_unpack(R.x, j, xo);
#pragma unroll
            for (int e = 0; e < 8; ++e) { v[j][e] = xo[e] + pa[j][e] * (v[j][e] * rstd); s2 += v[j][e] * v[j][e]; }
            const size_t off = (size_t)tok * D + j * 512 + lane * 8;
            if constexpr (XO) { pg8::u32x4 w; w.x = pg8::pk_f16(v[j][0], v[j][1]); w.y = pg8::pk_f16(v[j][2], v[j][3]); w.z = pg8::pk_f16(v[j][4], v[j][5]); w.w = pg8::pk_f16(v[j][6], v[j][7]); *(pg8::u32x4*)((h16*)xnew + off) = w; }
            else { *(pg8::f32x4*)((float*)xnew + off) = (pg8::f32x4){v[j][0], v[j][1], v[j][2], v[j][3]}; *(pg8::f32x4*)((float*)xnew + off + 4) = (pg8::f32x4){v[j][4], v[j][5], v[j][6], v[j][7]}; } }
    } else {
#pragma unroll
        for (int j = 0; j < 2; ++j) { x_unpack(R.x, j, v[j]);
#pragma unroll
            for (int e = 0; e < 8; ++e) s2 += v[j][e] * v[j][e]; }
    }
    if constexpr (HASH) {
        const float r2 = rsqrtf(wave_sum(s2) * (1.f / D) + 1e-6f);
#pragma unroll
        for (int j = 0; j < 2; ++j) { pg8::u32x4 w;
            w.x = pg8::pk_f16(v[j][0] * r2 * pb[j][0] + pc[j][0], v[j][1] * r2 * pb[j][1] + pc[j][1]); w.y = pg8::pk_f16(v[j][2] * r2 * pb[j][2] + pc[j][2], v[j][3] * r2 * pb[j][3] + pc[j][3]);
            w.z = pg8::pk_f16(v[j][4] * r2 * pb[j][4] + pc[j][4], v[j][5] * r2 * pb[j][5] + pc[j][5]); w.w = pg8::pk_f16(v[j][6] * r2 * pb[j][6] + pc[j][6], v[j][7] * r2 * pb[j][7] + pc[j][7]);
            *(pg8::u32x4*)(H + (size_t)tok * D + j * 512 + lane * 8) = w; }
    }
}
template <bool XI, bool XO, bool HASY, bool HASH, int G>
__device__ __forceinline__ void phase_post(const void* xold, const h16* y, const float* gpost, const float* modl, int gt_off, void* xnew,
                                           const float* gnext, const float* modn, int sh_off, int sc_off, h16* H) {
    int tid_ = threadIdx.x; asm volatile("" : "+v"(tid_)); const int lane = tid_ & 63, gw = blockIdx.x * 8 + (tid_ >> 6), NGW = gridDim.x * 8;
    constexpr int CH = 16;
    static_assert(S % CH == 0 && CH % (2 * G) == 0, "chunking");
    for (int ch = gw; ch < M / CH; ch += NGW) {
        const int tok0 = ch * CH, b = tok0 / S;
        float pa[2][8], pb[2][8], pc[2][8];
#pragma unroll
        for (int j = 0; j < 2; ++j) { const int cc = j * 512 + lane * 8;
#pragma unroll
            for (int hf = 0; hf < 2; ++hf) {
                if constexpr (HASY) { const pg8::f32x4 gp = *(const pg8::f32x4*)(gpost + cc + 4 * hf), gt = *(const pg8::f32x4*)(modl + (size_t)b * 6 * D + gt_off + cc + 4 * hf);
#pragma unroll
                    for (int e = 0; e < 4; ++e) pa[j][4 * hf + e] = gt[e] * gp[e]; }
                if constexpr (HASH) { const float* mn = modn + (size_t)b * 6 * D;
                    const pg8::f32x4 gg = *(const pg8::f32x4*)(gnext + cc + 4 * hf), sc = *(const pg8::f32x4*)(mn + sc_off + cc + 4 * hf), sh = *(const pg8::f32x4*)(mn + sh_off + cc + 4 * hf);
#pragma unroll
                    for (int e = 0; e < 4; ++e) { pb[j][4 * hf + e] = gg[e] * (1.f + sc[e]); pc[j][4 * hf + e] = sh[e]; } }
            } }
        PostRaw<XI, HASY> R0[G], R1[G];
#pragma unroll
        for (int t = 0; t < G; ++t) post_load<XI, HASY>(R0[t], xold, y, tok0 + t, lane);
#pragma unroll 1
        for (int g = 0; g < CH / G; g += 2) {
#pragma unroll
            for (int t = 0; t < G; ++t) post_load<XI, HASY>(R1[t], xold, y, tok0 + (g + 1) * G + t, lane);
#pragma unroll
            for (int t = 0; t < G; ++t) { post_row<XI, XO, HASY, HASH>(R0[t], tok0 + g * G + t, lane, pa, pb, pc, xnew, H); }
            if (g + 2 < CH / G) {
#pragma unroll
                for (int t = 0; t < G; ++t) post_load<XI, HASY>(R0[t], xold, y, tok0 + (g + 2) * G + t, lane); }
#pragma unroll
            for (int t = 0; t < G; ++t) { post_row<XI, XO, HASY, HASH>(R1[t], tok0 + (g + 1) * G + t, lane, pa, pb, pc, xnew, H); }
        }
    }
}

namespace nsa {
typedef _Float16 f16x8 __attribute__((ext_vector_type(8)));
typedef _Float16 f16x4 __attribute__((ext_vector_type(4)));
typedef float f32x4 __attribute__((ext_vector_type(4)));
typedef unsigned u32x4 __attribute__((ext_vector_type(4)));
typedef unsigned u32x2 __attribute__((ext_vector_type(2)));
constexpr int KP = 72;
constexpr int L_KT = 0, L_VT = 36864  , L_OF = 73728, L_IMPA = L_OF  , L_IMPB = L_OF + 64 * 65 * 4, L_MASK = L_OF + 65536, L_END = L_MASK + 512;
static_assert(2 * 64 * 65 * 4 <= 65536 && L_END <= 163840 - 64, "NSA LDS map");
constexpr float QSCALE = 0.125f * 1.4426950408889634f;

struct TileRegs { u32x4 k, v; };
__device__ __forceinline__ TileRegs tile_load(const h16* kbase, int kp, const h16* vbase, int vp, int tid) {
    TileRegs r;
    r.k = *(const u32x4*)(kbase + (size_t)(tid >> 3) * kp + 8 * (tid & 7));
    r.v = *(const u32x4*)(vbase + (size_t)(tid >> 3) * vp + 8 * (tid & 7));
    return r;
}
__device__ __forceinline__ void tile_store(LAS unsigned char* lds, int buf  , const TileRegs& r, int tid) {
    LAS h16* kt = (LAS h16*)(lds + L_KT) + buf * 64 * KP;
    *(LAS u32x4*)(kt + (tid >> 3) * KP + 8 * (tid & 7)) = r.k;
    LAS h16* vt = (LAS h16*)(lds + L_VT) + buf * 64 * KP;
    *(LAS u32x4*)(vt + (tid >> 3) * KP + 8 * (tid & 7)) = r.v;
}
__device__ __forceinline__ void tile_load_async(TileRegs& r, const h16* kbase, int kp, const h16* vbase, int vp, int tid) {
    const h16* ka = kbase + (size_t)(tid >> 3) * kp + 8 * (tid & 7); const h16* va = vbase + (size_t)(tid >> 3) * vp + 8 * (tid & 7);
    asm volatile("global_load_dwordx4 %0, %1, off" : "=v"(r.k) : "v"(ka) : "memory");
    asm volatile("global_load_dwordx4 %0, %1, off" : "=v"(r.v) : "v"(va) : "memory");
}
template <int N> __device__ __forceinline__ void tile_wait(TileRegs& r) {
    if (N == 2) asm volatile("s_waitcnt vmcnt(2)" : "+v"(r.k), "+v"(r.v) :: "memory"); else asm volatile("s_waitcnt vmcnt(0)" : "+v"(r.k), "+v"(r.v) :: "memory");
}
__device__ __forceinline__ float max_x16(float v) { return fmaxf(v, __shfl_xor(v, 16)); }
__device__ __forceinline__ float max_x32(float v) { return fmaxf(v, __shfl_xor(v, 32)); }
__device__ __forceinline__ float sum_x16(float v) { return v + __shfl_xor(v, 16); }
__device__ __forceinline__ float sum_x32(float v) { return v + __shfl_xor(v, 32); }
template <int CTRL> __device__ __forceinline__ float dpp_mv(float v) { return __builtin_bit_cast(float, __builtin_amdgcn_update_dpp(0, __builtin_bit_cast(int, v), CTRL, 0xF, 0xF, true)); }
__device__ __forceinline__ float sum_quad(float v) { v += __shfl_xor(v, 1); v += __shfl_xor(v, 2); return v; }
__device__ __forceinline__ f32x4 mfma16(f16x8 a, f16x8 b, f32x4 c) { return __builtin_amdgcn_mfma_f32_16x16x32_f16(a, b, c, 0, 0, 0); }

__device__ __forceinline__ void qk_tiles(const LAS h16* kt_lds, const f16x8 (&qf)[2][2], int c, int g, f32x4 (&sc)[2][4]) {
    f16x8 kf[4][2];
#pragma unroll
    for (int kt = 0; kt < 4; ++kt) { kf[kt][0] = *(const LAS f16x8*)(kt_lds + (16 * kt + c) * KP + 8 * g); kf[kt][1] = *(const LAS f16x8*)(kt_lds + (16 * kt + c) * KP + 32 + 8 * g); }
#pragma unroll
    for (int kt = 0; kt < 4; ++kt)
#pragma unroll
        for (int qi = 0; qi < 2; ++qi) { f32x4 a = {0.f, 0.f, 0.f, 0.f}; a = mfma16(kf[kt][0], qf[qi][0], a); a = mfma16(kf[kt][1], qf[qi][1], a); sc[qi][kt] = a; }
}
__device__ __forceinline__ void pv_tiles(const LAS h16* vt_lds, const f32x4 (&p)[2][4], int c, int g, f32x4 (&o)[4][2]) {
    f16x4 vlo[2][4], vhi[2][4];
#pragma unroll
    for (int kk = 0; kk < 2; ++kk)
#pragma unroll
        for (int dt = 0; dt < 4; ++dt) { vlo[kk][dt] = *(const LAS f16x4*)(vt_lds + (16 * dt + c) * KP + 32 * kk + 4 * g); vhi[kk][dt] = *(const LAS f16x4*)(vt_lds + (16 * dt + c) * KP + 32 * kk + 16 + 4 * g); }
#pragma unroll
    for (int kk = 0; kk < 2; ++kk) {
        f16x8 bf[2];
#pragma unroll
        for (int qi = 0; qi < 2; ++qi) { const f32x4 a = p[qi][2 * kk], b = p[qi][2 * kk + 1];
            bf[qi] = (f16x8){(_Float16)a[0], (_Float16)a[1], (_Float16)a[2], (_Float16)a[3], (_Float16)b[0], (_Float16)b[1], (_Float16)b[2], (_Float16)b[3]}; }
#pragma unroll
        for (int dt = 0; dt < 4; ++dt) {
            const f16x4 v0 = vlo[kk][dt], v1 = vhi[kk][dt];
            const f16x8 a = (f16x8){v0[0], v0[1], v0[2], v0[3], v1[0], v1[1], v1[2], v1[3]};
#pragma unroll
            for (int qi = 0; qi < 2; ++qi) o[dt][qi] = mfma16(a, bf[qi], o[dt][qi]);
        }
    }
}
__device__ __forceinline__ void apply_mask(f32x4 (&sc)[4], int mode, int lim) {
    if (mode == 1) {
#pragma unroll
        for (int kt = 0; kt < 4; ++kt)
#pragma unroll
            for (int r = 0; r < 4; ++r) sc[kt][r] = (16 * kt + r <= lim) ? sc[kt][r] : -1e30f;
    } else if (mode == 2) {
#pragma unroll
        for (int kt = 0; kt < 4; ++kt)
#pragma unroll
            for (int r = 0; r < 4; ++r) sc[kt][r] = (16 * kt + r > lim) ? sc[kt][r] : -1e30f;
    }
}
typedef float f32x2 __attribute__((ext_vector_type(2)));
__device__ __forceinline__ float max3f(float a, float b, float c) { float r; asm("v_max3_f32 %0, %1, %2, %3" : "=v"(r) : "v"(a), "v"(b), "v"(c)); return r; }
__device__ __forceinline__ void softmax_step(f32x4 (&sc)[4], bool row_on, float& m, float& l, float& f_out) {
    float mx = max3f(sc[0][0], sc[0][1], sc[0][2]);
    mx = max3f(mx, sc[0][3], sc[1][0]); mx = max3f(mx, sc[1][1], sc[1][2]); mx = max3f(mx, sc[1][3], sc[2][0]); mx = max3f(mx, sc[2][1], sc[2][2]);
    mx = max3f(mx, sc[2][3], sc[3][0]); mx = max3f(mx, sc[3][1], sc[3][2]); mx = fmaxf(mx, sc[3][3]);
    mx = row_on ? mx : -1e30f;
    mx = max_x16(mx); mx = max_x32(mx);
    const float mn = fmaxf(m, mx), f = __builtin_amdgcn_exp2f(m - mn), mu = row_on ? fmaxf(mn, -1e20f) : 1e30f;
    const f32x2 mu2 = {mu, mu};
    f32x2 sum2 = {0.f, 0.f};
#pragma unroll
    for (int kt = 0; kt < 4; ++kt) {
        f32x2 a = (f32x2){sc[kt][0], sc[kt][1]} - mu2, b = (f32x2){sc[kt][2], sc[kt][3]} - mu2;
        a.x = __builtin_amdgcn_exp2f(a.x); a.y = __builtin_amdgcn_exp2f(a.y); b.x = __builtin_amdgcn_exp2f(b.x); b.y = __builtin_amdgcn_exp2f(b.y);
        sc[kt] = (f32x4){a.x, a.y, b.x, b.y}; sum2 = sum2 + a; sum2 = sum2 + b;
    }
    l = l * f + (sum2.x + sum2.y); m = mn; f_out = f;
}

struct AttnArgs { const h16* QK32; const h16* P16; const h16* KC; const h16* VCT;   const h16* VTG;   const float* gate_b; const float* out_g; h16* O16; };

__device__ __forceinline__ void attn_item(const AttnArgs& A, int b, int qt, LAS unsigned char* lds) {
    int tid_ = threadIdx.x; asm volatile("" : "+v"(tid_)); const int tid = tid_, lane = tid & 63, w = tid >> 6, c = lane & 15, g = lane >> 4;
    const size_t tok0 = (size_t)b * S + 64 * qt;
    LAS float* impa = (LAS float*)(lds + L_IMPA); LAS float* impb = (LAS float*)(lds + L_IMPB);
    LAS unsigned char* maskb = lds + L_MASK;
    LAS f32x4* ofl = (LAS f32x4*)(lds + L_OF);
    const LAS h16* KT = (const LAS h16*)(lds + L_KT); const LAS h16* VT = (const LAS h16*)(lds + L_VT);
    int tl[2]; f16x8 qf[2][2];
    const int hh = c & 3;
#pragma unroll
    for (int qi = 0; qi < 2; ++qi) {
        tl[qi] = 8 * w + 4 * qi + (c >> 2);
        const h16* qp = A.QK32 + (tok0 + tl[qi]) * QKP + hh * 64 + 8 * g;
#pragma unroll
        for (int ks = 0; ks < 2; ++ks) qf[qi][ks] = *(const f16x8*)(qp + 32 * ks);
    }
    for (int i = tid; i < 64 * 65; i += 512) { impa[i] = 0.f; impb[i] = 0.f; }
    const int nblk_c = (4 * qt + 3 + 63) >> 6;
    int nvis[2];
#pragma unroll
    for (int qi = 0; qi < 2; ++qi) { const int s = 64 * qt + tl[qi]; nvis[qi] = (s >= 31) ? ((s - 31) / 16 + 1) : 0; }
    const h16* kcb = A.KC + (size_t)b * 256 * 64; const h16* vcb = A.VCT + (size_t)b * 64 * 256;
    float m_c[2] = {-1e30f, -1e30f}, l_c[2] = {0.f, 0.f};
    f32x4 ofin[4][2];
#pragma unroll
    for (int dt = 0; dt < 4; ++dt)
#pragma unroll
        for (int qi = 0; qi < 2; ++qi) ofin[dt][qi] = (f32x4){0.f, 0.f, 0.f, 0.f};
    float glog[2][3];
#pragma unroll
    for (int qi = 0; qi < 2; ++qi) { const h16* gp = A.P16 + (tok0 + tl[qi]) * PITCH + PC_GTS; glog[qi][0] = (float)gp[hh]; glog[qi][1] = (float)gp[4 + hh]; glog[qi][2] = (float)gp[8 + hh]; }
    {
        TileRegs r[4];
#pragma unroll
        for (int u = 0; u < 4; ++u) if (u < nblk_c) r[u] = tile_load(kcb + (size_t)u * 64 * 64, 64, vcb + u * 64, 256, tid);
#pragma unroll
        for (int u = 0; u < 4; ++u) if (u < nblk_c) tile_store(lds, u, r[u], tid);
    }
    __syncthreads();
#pragma unroll 1
    for (int pass = 0; pass < 2; ++pass) {
        float inv_l[2];
        if (pass == 1) {
#pragma unroll
            for (int qi = 0; qi < 2; ++qi) { float lt = l_c[qi]; lt = sum_x16(lt); lt = sum_x32(lt); inv_l[qi] = lt > 0.f ? 1.f / lt : 0.f; }
        }
#pragma unroll 1
        for (int blk = 0; blk < nblk_c; ++blk) {
            f32x4 sc[2][4];
            qk_tiles(KT + blk * 64 * KP, qf, c, g, sc);
#pragma unroll
            for (int qi = 0; qi < 2; ++qi) {
                apply_mask(sc[qi], 1, nvis[qi] - 1 - 64 * blk - 4 * g);
                if (pass == 0) { float f; softmax_step(sc[qi], true, m_c[qi], l_c[qi], f); }
                else {
                    const float mu = fmaxf(m_c[qi], -1e20f);
#pragma unroll
                    for (int kt = 0; kt < 4; ++kt) {
#pragma unroll
                        for (int r = 0; r < 4; ++r) sc[qi][kt][r] = __builtin_amdgcn_exp2f(sc[qi][kt][r] - mu) * inv_l[qi];
                        float e0 = (sc[qi][kt][0] + sc[qi][kt][1]) + (sc[qi][kt][2] + sc[qi][kt][3]), e1 = sc[qi][kt][3];
                        e0 = sum_quad(e0); e1 = sum_quad(e1);
                        const int jj = 16 * blk + 4 * kt + g;
                        if (hh == 0) { impa[tl[qi] * 65 + jj] = e0; if (jj + 1 < 64) impb[tl[qi] * 65 + jj + 1] = e1; }
                    }
                }
            }
            if (pass == 1) pv_tiles(VT + blk * 64 * KP, sc, c, g, ofin);
        }
    }
    __syncthreads();
    {
        const int t = tid >> 3, jg = tid & 7;
        unsigned long long key[8];
#pragma unroll
        for (int i = 0; i < 8; ++i) { const int j = 8 * jg + i; const float imp = impa[t * 65 + j] + impb[t * 65 + j];
            const bool forced = (j == 0) || (j == qt) || (j == qt - 1); const float scv = forced ? 1e9f : (j <= qt ? imp : -1e30f);
            const unsigned fb = __builtin_bit_cast(unsigned, scv), ob = (fb & 0x80000000u) ? ~fb : (fb | 0x80000000u);
            key[i] = ((unsigned long long)ob << 32) | (unsigned)(63 - j); }
        __syncthreads();
        LAS unsigned long long* keys = (LAS unsigned long long*)(lds + L_IMPA);
#pragma unroll
        for (int i = 0; i < 8; ++i) keys[t * 65 + 8 * jg + i] = key[i];
        __syncthreads();
        int rank[8];
#pragma unroll
        for (int i = 0; i < 8; ++i) rank[i] = 0;
        for (int j2 = 0; j2 < 64; ++j2) { const unsigned long long k2 = keys[t * 65 + j2];
#pragma unroll
            for (int i = 0; i < 8; ++i) rank[i] += (k2 > key[i]) ? 1 : 0; }
        unsigned bits = 0;
#pragma unroll
        for (int i = 0; i < 8; ++i) bits |= ((rank[i] < 16 && (8 * jg + i) <= qt) ? 1u : 0u) << i;
        maskb[t * 8 + jg] = (unsigned char)bits;
    }
    __syncthreads();
    unsigned mlo[2], mhi[2];
#pragma unroll
    for (int qi = 0; qi < 2; ++qi) { const LAS unsigned* mp = (const LAS unsigned*)(lds + L_MASK) + 2 * tl[qi]; mlo[qi] = mp[0]; mhi[qi] = mp[1]; }
    float gsel[2], gwin[2];
#pragma unroll
    for (int qi = 0; qi < 2; ++qi) {
        const float g0 = __builtin_amdgcn_rcpf(1.f + __expf(-(glog[qi][0] + A.gate_b[hh])));
        gsel[qi] = __builtin_amdgcn_rcpf(1.f + __expf(-(glog[qi][1] + A.gate_b[4 + hh])));
        gwin[qi] = __builtin_amdgcn_rcpf(1.f + __expf(-(glog[qi][2] + A.gate_b[8 + hh])));
#pragma unroll
        for (int dt = 0; dt < 4; ++dt) ofl[(dt * 2 + qi) * 512 + tid] = ofin[dt][qi] * g0;
    }
    const h16* Pb = A.P16 + (size_t)b * S * PITCH;
    const int jw0 = qt >= 8 ? qt - 8 : 0;
#pragma unroll 1
    for (int br = 0; br < 2; ++br) {
        const bool win = br == 1;
        const int j0 = win ? jw0 : 0, nsteps = qt - j0 + 1, kcol = win ? PC_KW : PC_KS;
        const h16* Vb = A.VTG + ((size_t)b * 2 + br) * 64 * S;
        float m_b[2] = {-1e30f, -1e30f}, l_b[2] = {0.f, 0.f};
        f32x4 o_b[4][2];
#pragma unroll
        for (int dt = 0; dt < 4; ++dt)
#pragma unroll
            for (int qi = 0; qi < 2; ++qi) o_b[dt][qi] = (f32x4){0.f, 0.f, 0.f, 0.f};
        TileRegs R[4];
#define NSA_LOADG(G0) do { _Pragma("unroll") for (int u = 0; u < 4; ++u) if ((G0) + u < nsteps) R[u] = tile_load(Pb + (size_t)(j0 + (G0) + u) * 64 * PITCH + kcol, PITCH, Vb + 64 * (j0 + (G0) + u), S, tid); } while (0)
#define NSA_STOREG(G0) do { _Pragma("unroll") for (int u = 0; u < 4; ++u) if ((G0) + u < nsteps) tile_store(lds, u, R[u], tid); } while (0)
        NSA_LOADG(0); NSA_STOREG(0);
        __syncthreads();
#pragma unroll 1
        for (int g0 = 0; g0 < nsteps; g0 += 4) {
            NSA_LOADG(g0 + 4);
#pragma unroll
            for (int u = 0; u < 4; ++u) {
                if (g0 + u < nsteps) {
                    const int jb = j0 + g0 + u;
                    f32x4 sc[2][4];
                    qk_tiles(KT + u * 64 * KP, qf, c, g, sc);
                    const int mode = (jb == qt) ? 1 : ((win && jb == qt - 8) ? 2 : 0);
#pragma unroll
                    for (int qi = 0; qi < 2; ++qi) {
                        const bool selb = win ? true : ((jb < 32) ? ((mlo[qi] >> jb) & 1u) : ((mhi[qi] >> (jb - 32)) & 1u));
                        apply_mask(sc[qi], mode, tl[qi] - 4 * g);
                        float f;
                        softmax_step(sc[qi], selb, m_b[qi], l_b[qi], f);
                        if (__any(f != 1.f)) {
#pragma unroll
                            for (int dt = 0; dt < 4; ++dt) o_b[dt][qi] = o_b[dt][qi] * f; }
                    }
                    pv_tiles(VT + u * 64 * KP, sc, c, g, o_b);
                }
            }
            __syncthreads();
            if (g0 + 4 < nsteps) { NSA_STOREG(g0 + 4); __syncthreads(); }
        }
#undef NSA_LOADG
#undef NSA_STOREG
#pragma unroll
        for (int qi = 0; qi < 2; ++qi) {
            float lb = l_b[qi]; lb = sum_x16(lb); lb = sum_x32(lb);
            const float cb = (win ? gwin[qi] : gsel[qi]) / lb;
#pragma unroll
            for (int dt = 0; dt < 4; ++dt) ofl[(dt * 2 + qi) * 512 + tid] = ofl[(dt * 2 + qi) * 512 + tid] + o_b[dt][qi] * cb;
        }
    }
#pragma unroll
    for (int qi = 0; qi < 2; ++qi) {
        float ss = 0.f;
#pragma unroll
        for (int dt = 0; dt < 4; ++dt) ofin[dt][qi] = ofl[(dt * 2 + qi) * 512 + tid];
#pragma unroll
        for (int dt = 0; dt < 4; ++dt)
            ss += (ofin[dt][qi][0] * ofin[dt][qi][0] + ofin[dt][qi][1] * ofin[dt][qi][1]) + (ofin[dt][qi][2] * ofin[dt][qi][2] + ofin[dt][qi][3] * ofin[dt][qi][3]);
        ss = sum_x16(ss); ss = sum_x32(ss); ss = sum_quad(ss);
        const float rstd = rsqrtf(ss * (1.f / 256.f) + 1e-6f);
        h16* op = A.O16 + (tok0 + tl[qi]) * D + hh * 64;
#pragma unroll
        for (int dt = 0; dt < 4; ++dt) { const int d0 = 16 * dt + 4 * g; const f32x4 gg = *(const f32x4*)(A.out_g + hh * 64 + d0);
            u32x2 wv; wv.x = pg8::pk_f16(ofin[dt][qi][0] * rstd * gg[0], ofin[dt][qi][1] * rstd * gg[1]); wv.y = pg8::pk_f16(ofin[dt][qi][2] * rstd * gg[2], ofin[dt][qi][3] * rstd * gg[3]);
            *(u32x2*)(op + d0) = wv; }
    }
    __syncthreads();
}

struct CmpArgs { const h16* QK32; const h16* P16; const h16* W1T;   const float* bias;   const float* w2k; const float* w2v; h16* KC; h16* VC; };
constexpr int TP = 72;
__device__ __forceinline__ void compress_item(const CmpArgs& A, int b, int kv, int ng, LAS unsigned char* lds) {
    int tid_ = threadIdx.x; asm volatile("" : "+v"(tid_)); const int tid = tid_, lane = tid & 63, w = tid >> 6, c = lane & 15, g = lane >> 4;
    LAS h16* TOK = (LAS h16*)lds;
    LAS float* RED = (LAS float*)(lds + 272 * TP * 2);
    LAS float* HID = RED + 2 * 16 * 64;
    const int t0 = 256 * ng;
    for (int e = tid; e < 272 * 8; e += 512) {
        const int t = e >> 3, ch = e & 7; const int tok = t0 + t;
        u32x4 v = {0u, 0u, 0u, 0u};
        if (tok < S) {
            if (kv == 0) v = *(const u32x4*)(A.QK32 + ((size_t)b * S + tok) * QKP + 256 + 8 * ch);
            else v = *(const u32x4*)(A.P16 + ((size_t)b * S + tok) * PITCH + PC_VC + 8 * ch);
        }
        *(LAS u32x4*)(TOK + t * TP + 8 * ch) = v;
    }
    __syncthreads();
    {
        const int nt = w & 3, kh = w >> 2;
        const h16* wb = A.W1T + ((size_t)kv * 64 + 16 * nt + c) * 2048 + 8 * g;
        f32x4 acc = {0.f, 0.f, 0.f, 0.f};
#pragma unroll 1
        for (int k8 = 32 * kh; k8 < 32 * kh + 32; k8 += 8) {
            f16x8 bw[8];
#pragma unroll
            for (int u = 0; u < 8; ++u) bw[u] = *(const f16x8*)(wb + 32 * (k8 + u));
#pragma unroll
            for (int u = 0; u < 8; ++u) { const int ks = k8 + u;
                const f16x8 a = *(const LAS f16x8*)(TOK + (16 * c + (ks >> 1)) * TP + 32 * (ks & 1) + 8 * g);
                acc = mfma16(a, bw[u], acc); }
        }
#pragma unroll
        for (int r = 0; r < 4; ++r) RED[(kh * 16 + 4 * g + r) * 64 + 16 * nt + c] = acc[r];
    }
    __syncthreads();
    for (int e = tid; e < 1024; e += 512) { const int n = e >> 6, j = e & 63; const float x = RED[n * 64 + j] + RED[(16 + n) * 64 + j] + A.bias[kv * 64 + j];
        HID[n * 64 + j] = 0.5f * x * (1.f + tanhf(0.7978845608028654f * (x + 0.044715f * x * x * x))); }
    __syncthreads();
    const float* w2 = kv == 0 ? A.w2k : A.w2v; h16* outp = kv == 0 ? A.KC : A.VC;
    for (int e = tid; e < 1024; e += 512) { const int n = e >> 6, j = e & 63; float s = 0.f;
        for (int i = 0; i < 64; ++i) s += HID[n * 64 + i] * w2[i * 64 + j];
        const int nn = 16 * ng + n;
        const h16 ov = (nn < NCMP) ? (h16)s : (h16)0.f;
        if (kv == 0) outp[((size_t)b * 256 + nn) * 64 + j] = ov; else outp[((size_t)b * 64 + j) * 256 + nn] = ov; }
    __syncthreads();
}
}
namespace mls {
using nsa::f16x8; using nsa::f32x4; using nsa::u32x4; using nsa::u32x2; using nsa::mfma16;
constexpr int KP = 72;
#define LDS_BAR() do { asm volatile("s_waitcnt lgkmcnt(0)" ::: "memory"); __builtin_amdgcn_s_barrier(); asm volatile("" ::: "memory"); } while (0)
constexpr size_t WS_KVB = WS_Y32;
constexpr size_t WS_KSUM = WS_Y32 + 48 * MiB;
constexpr size_t WS_MUB = WS_KSUM + 1 * MiB;
constexpr size_t WS_GT = 505 * MiB;
struct Args { const h16* P16; const float *conv_w, *conv_b, *ig_b, *fg_b, *norm_g; float* KVB; float* KSUM; float* MUB; h16* O16; float* GT; const h16* CW16; };

__device__ __forceinline__ void mm64(const LAS h16* A, const LAS h16* Bt, int w, int c, int g, f32x4 (&acc)[2]) {
    const int mi = w >> 1;
    const f16x8 a0 = *(const LAS f16x8*)(A + (16 * mi + c) * KP + 8 * g), a1 = *(const LAS f16x8*)(A + (16 * mi + c) * KP + 32 + 8 * g);
#pragma unroll
    for (int n = 0; n < 2; ++n) { const int ni = 2 * (w & 1) + n;
        const f16x8 b0 = *(const LAS f16x8*)(Bt + (16 * ni + c) * KP + 8 * g), b1 = *(const LAS f16x8*)(Bt + (16 * ni + c) * KP + 32 + 8 * g);
        acc[n] = mfma16(a0, b0, acc[n]); acc[n] = mfma16(a1, b1, acc[n]); }
}
__device__ __forceinline__ float half_lo(unsigned u) { return (float)__builtin_bit_cast(_Float16, (unsigned short)(u & 0xffffu)); }
__device__ __forceinline__ float half_hi(unsigned u) { return (float)__builtin_bit_cast(_Float16, (unsigned short)(u >> 16)); }
struct ConvTaps { u32x4 x[4]; };
__device__ __forceinline__ void conv_load(ConvTaps& T, const h16* Pbatch, int tloc, int col) {
#pragma unroll
    for (int i = 0; i < 4; ++i) { const int tt = tloc - 3 + i; T.x[i] = (u32x4){0u, 0u, 0u, 0u}; if (tt >= 0) T.x[i] = *(const u32x4*)(Pbatch + (size_t)tt * PITCH + col); }
}
typedef _Float16 h16x2 __attribute__((ext_vector_type(2)));
__device__ __forceinline__ void conv_apply(const ConvTaps& T, const h16* cw16, float scale, float (&out)[8]) {
    float acc[8];
    { const u32x4 bw = *(const u32x4*)(cw16 + 4 * 768); acc[0] = half_lo(bw.x); acc[1] = half_hi(bw.x); acc[2] = half_lo(bw.y); acc[3] = half_hi(bw.y); acc[4] = half_lo(bw.z); acc[5] = half_hi(bw.z); acc[6] = half_lo(bw.w); acc[7] = half_hi(bw.w); }
#pragma unroll
    for (int i = 0; i < 4; ++i) { const u32x4 x = T.x[i], wv = *(const u32x4*)(cw16 + i * 768);
        acc[0] += half_lo(x.x) * half_lo(wv.x); acc[1] += half_hi(x.x) * half_hi(wv.x); acc[2] += half_lo(x.y) * half_lo(wv.y); acc[3] += half_hi(x.y) * half_hi(wv.y);
        acc[4] += half_lo(x.z) * half_lo(wv.z); acc[5] += half_hi(x.z) * half_hi(wv.z); acc[6] += half_lo(x.w) * half_lo(wv.w); acc[7] += half_hi(x.w) * half_hi(wv.w); }
#pragma unroll
    for (int e = 0; e < 8; ++e) out[e] = acc[e] * __builtin_amdgcn_rcpf(1.f + __expf(-acc[e])) * scale;
}
__device__ __forceinline__ void conv8(const h16* Pbatch, int tloc, int col, const h16* cw16, float scale, float (&out)[8]) {
    ConvTaps T; conv_load(T, Pbatch, tloc, col); conv_apply(T, cw16, scale, out);
}
__device__ __forceinline__ float log_sigmoid(float x) { return fminf(x, 0.f) - log1pf(__expf(-fabsf(x))); }

__device__ __forceinline__ void m1_item(const Args& A, int bh, int ck, LAS unsigned char* lds) {
    int tid_ = threadIdx.x; asm volatile("" : "+v"(tid_)); const int tid = tid_, lane = tid & 63, w = tid >> 6, c = lane & 15, g = lane >> 4;
    const int b = bh / H_ML, h = bh % H_ML;
    LAS h16* KT2 = (LAS h16*)lds;
    LAS h16* WVT = KT2 + 64 * KP;
    LAS float* WGT = (LAS float*)(lds + 2 * 64 * KP * 2);
    const h16* Pb = A.P16 + (size_t)b * S * PITCH;
    const int tloc = 64 * ck + lane;
    if (w == 0) {
        const h16* pr = Pb + (size_t)tloc * PITCH;
        const float li = (float)pr[PC_IG + h] + A.ig_b[h];
        const float lf = log_sigmoid((float)pr[PC_FG + h] + A.fg_b[h]);
        float bs = lf;
#pragma unroll
        for (int o = 1; o < 64; o <<= 1) { const float t = __shfl_up(bs, o); if (lane >= o) bs += t; }
        const float gt = __shfl(bs, 63);
        const float u = gt - bs + li;
        const float mu = wave_max(u);
        WGT[lane] = __expf(u - mu);
        if (lane == 0) { A.MUB[bh * 64 + ck] = mu; A.MUB[3072 + bh * 64 + ck] = gt; }
        const float as = li - bs; float pm = as;
#pragma unroll
        for (int o = 1; o < 64; o <<= 1) { const float t = __shfl_up(pm, o); if (lane >= o) pm = fmaxf(pm, t); }
        float* gto = A.GT + ((size_t)bh * 64 + ck) * 192; gto[lane] = bs; gto[64 + lane] = as; gto[128 + lane] = pm;
    }
    float kc[8];
    conv8(Pb, tloc, PC_MK + h * 64 + 8 * w, A.CW16 + 384 + h * 64 + 8 * w, 0.125f, kc);
    LDS_BAR();
    const float wg = WGT[lane];
    const u32x4 vv = *(const u32x4*)(Pb + (size_t)tloc * PITCH + PC_MV + h * 64 + 8 * w);
    const float v8[8] = {half_lo(vv.x), half_hi(vv.x), half_lo(vv.y), half_hi(vv.y), half_lo(vv.z), half_hi(vv.z), half_lo(vv.w), half_hi(vv.w)};
#pragma unroll
    for (int e = 0; e < 8; ++e) { KT2[(8 * w + e) * KP + lane] = (h16)kc[e]; WVT[(8 * w + e) * KP + lane] = (h16)(v8[e] * wg); }
    LDS_BAR();
    f32x4 acc[2] = {{0.f, 0.f, 0.f, 0.f}, {0.f, 0.f, 0.f, 0.f}};
    mm64(WVT, KT2, w, c, g, acc);
    float* kvo = A.KVB + ((size_t)bh * 64 + ck) * 4096;
#pragma unroll
    for (int n = 0; n < 2; ++n)
#pragma unroll
        for (int r = 0; r < 4; ++r) kvo[(16 * (w >> 1) + 4 * g + r) * 64 + 16 * (2 * (w & 1) + n) + c] = acc[n][r];
    if (w == 1) { float s = 0.f;
        for (int t = 0; t < 64; ++t) s += (float)KT2[lane * KP + t] * WGT[t];
        A.KSUM[((size_t)bh * 64 + ck) * 64 + lane] = s; }
    LDS_BAR();
}

__device__ __forceinline__ void m2_item(const Args& A, int bh, int qr) {
    int tid_ = threadIdx.x; asm volatile("" : "+v"(tid_)); const int tid = tid_;
    float* kv = A.KVB + (size_t)bh * 64 * 4096 + qr * 1024 + tid;
    float* ks = A.KSUM + (size_t)bh * 64 * 64 + tid;
    const bool don = (qr == 0 && tid < 64);
    float C0 = 0.f, C1 = 0.f, n = 0.f, m = 0.f;
#pragma unroll 1
    for (int c8 = 0; c8 < 64; c8 += 8) {
        float x0[8], x1[8], xn[8], mu[8], gt[8];
#pragma unroll
        for (int u = 0; u < 8; ++u) { x0[u] = kv[(size_t)(c8 + u) * 4096]; x1[u] = kv[(size_t)(c8 + u) * 4096 + 512]; xn[u] = don ? ks[(c8 + u) * 64] : 0.f;
            mu[u] = A.MUB[bh * 64 + c8 + u]; gt[u] = A.MUB[3072 + bh * 64 + c8 + u]; }
#pragma unroll
        for (int u = 0; u < 8; ++u) { const int ck = c8 + u;
            const float mn = fmaxf(gt[u] + m, mu[u]), dec = __expf(gt[u] + m - mn), wl = __expf(mu[u] - mn);
            kv[(size_t)ck * 4096] = C0; kv[(size_t)ck * 4096 + 512] = C1;
            if (don) ks[ck * 64] = n;
            if (qr == 0 && tid == 0) A.MUB[2 * 3072 + bh * 64 + ck] = m;
            C0 = dec * C0 + wl * x0[u]; C1 = dec * C1 + wl * x1[u]; n = dec * n + wl * xn[u]; m = mn; }
    }
}

struct M3Regs { ConvTaps q, k; u32x4 v, og; f32x4 c0, c1; float bs, as, pm, n0, m0; };
__device__ __forceinline__ void m3_load(M3Regs& R, const Args& A, int item, int tid) {
    const int bh = item >> 6, ck = item & 63, b = bh / H_ML, h = bh % H_ML, lane = tid & 63, w = tid >> 6;
    const h16* Pb = A.P16 + (size_t)b * S * PITCH; const int tloc = 64 * ck + lane;
    conv_load(R.q, Pb, tloc, PC_MQ + h * 64 + 8 * w); conv_load(R.k, Pb, tloc, PC_MK + h * 64 + 8 * w);
    R.v = *(const u32x4*)(Pb + (size_t)tloc * PITCH + PC_MV + h * 64 + 8 * w);
    const float* cp = A.KVB + ((size_t)bh * 64 + ck) * 4096 + (tid >> 3) * 64 + 8 * (tid & 7);
    R.c0 = *(const f32x4*)cp; R.c1 = *(const f32x4*)(cp + 4);
    R.og = *(const u32x4*)(A.P16 + ((size_t)b * S + 64 * ck + (tid >> 3)) * PITCH + PC_MO + h * 64 + 8 * (tid & 7));
    const float* gti = A.GT + ((size_t)bh * 64 + ck) * 192; R.bs = gti[lane]; R.as = gti[64 + lane]; R.pm = gti[128 + lane];
    R.n0 = A.KSUM[((size_t)bh * 64 + ck) * 64 + lane]; R.m0 = A.MUB[2 * 3072 + bh * 64 + ck];
}
__device__ __forceinline__ void m3_item(const Args& A, int item, int next_item, M3Regs& R, LAS unsigned char* lds) {
    int tid_ = threadIdx.x; asm volatile("" : "+v"(tid_)); const int tid = tid_, lane = tid & 63, w = tid >> 6, c = lane & 15, g = lane >> 4;
    const int bh = item >> 6, ck = item & 63, b = bh / H_ML, h = bh % H_ML;
    LAS h16* Q16 = (LAS h16*)lds;
    LAS h16* K16 = Q16 + 64 * KP;
    LAS h16* VT2 = K16 + 64 * KP;
    LAS h16* C016 = VT2 + 64 * KP;
    LAS h16* SM16 = C016 + 64 * KP;
    LAS float* HV = (LAS float*)(lds + 5 * 64 * KP * 2);
    LAS float* BJ = HV + 64 * 65; LAS float* AS = BJ + 64; LAS float* MJ = AS + 64; LAS float* WI = MJ + 64; LAS float* N0 = WI + 64; LAS float* DEN = N0 + 64;
    const float m0 = R.m0;
    if (w == 0) {
        const float bs = R.bs, mj = bs + fmaxf(m0, R.pm);
        BJ[lane] = bs; AS[lane] = R.as; MJ[lane] = mj; WI[lane] = __expf(bs + m0 - mj);
        N0[lane] = R.n0;
    }
    u32x4 og;
    {   float q8[8], k8[8];
        conv_apply(R.q, A.CW16 + h * 64 + 8 * w, 1.f, q8);
        conv_apply(R.k, A.CW16 + 384 + h * 64 + 8 * w, 0.125f, k8);
        u32x4 qo, ko;
        qo.x = pg8::pk_f16(q8[0], q8[1]); qo.y = pg8::pk_f16(q8[2], q8[3]); qo.z = pg8::pk_f16(q8[4], q8[5]); qo.w = pg8::pk_f16(q8[6], q8[7]);
        ko.x = pg8::pk_f16(k8[0], k8[1]); ko.y = pg8::pk_f16(k8[2], k8[3]); ko.z = pg8::pk_f16(k8[4], k8[5]); ko.w = pg8::pk_f16(k8[6], k8[7]);
        *(LAS u32x4*)(Q16 + lane * KP + 8 * w) = qo; *(LAS u32x4*)(K16 + lane * KP + 8 * w) = ko;
        const u32x4 vv = R.v;
        LAS unsigned short* vt = (LAS unsigned short*)VT2 + (8 * w) * KP + lane;
        vt[0 * KP] = (unsigned short)(vv.x & 0xffffu); vt[1 * KP] = (unsigned short)(vv.x >> 16); vt[2 * KP] = (unsigned short)(vv.y & 0xffffu); vt[3 * KP] = (unsigned short)(vv.y >> 16);
        vt[4 * KP] = (unsigned short)(vv.z & 0xffffu); vt[5 * KP] = (unsigned short)(vv.z >> 16); vt[6 * KP] = (unsigned short)(vv.w & 0xffffu); vt[7 * KP] = (unsigned short)(vv.w >> 16);
        const f32x4 c0 = R.c0, c1 = R.c1;
        u32x4 co; co.x = pg8::pk_f16(c0[0], c0[1]); co.y = pg8::pk_f16(c0[2], c0[3]); co.z = pg8::pk_f16(c1[0], c1[1]); co.w = pg8::pk_f16(c1[2], c1[3]);
        *(LAS u32x4*)(C016 + (tid >> 3) * KP + 8 * (tid & 7)) = co;
        og = R.og;
    }
    if (next_item >= 0) m3_load(R, A, next_item, tid);
    LDS_BAR();
    {
        f32x4 acc[2] = {{0.f, 0.f, 0.f, 0.f}, {0.f, 0.f, 0.f, 0.f}};
        mm64(Q16, K16, w, c, g, acc);
#pragma unroll
        for (int n = 0; n < 2; ++n)
#pragma unroll
            for (int r = 0; r < 4; ++r) { const int j = 16 * (w >> 1) + 4 * g + r, s = 16 * (2 * (w & 1) + n) + c;
                const float v = (s <= j) ? __expf(BJ[j] + AS[s] - MJ[j]) * acc[n][r] : 0.f;
                SM16[j * KP + s] = (h16)v; }
    }
    LDS_BAR();
    {
        const int j = tid >> 3, sg = tid & 7; float rs = 0.f, nq = 0.f;
#pragma unroll
        for (int e = 0; e < 8; ++e) { rs += (float)SM16[j * KP + 8 * sg + e]; nq += (float)Q16[j * KP + 8 * sg + e] * N0[8 * sg + e]; }
        rs += __shfl_xor(rs, 1); rs += __shfl_xor(rs, 2); rs += __shfl_xor(rs, 4);
        nq += __shfl_xor(nq, 1); nq += __shfl_xor(nq, 2); nq += __shfl_xor(nq, 4);
        if (sg == 0) DEN[j] = fmaxf(fabsf(WI[j] * nq + rs), __expf(-MJ[j]));
    }
    f32x4 a1[2] = {{0.f, 0.f, 0.f, 0.f}, {0.f, 0.f, 0.f, 0.f}}, a2[2] = {{0.f, 0.f, 0.f, 0.f}, {0.f, 0.f, 0.f, 0.f}};
    mm64(Q16, C016, w, c, g, a1);
    mm64(SM16, VT2, w, c, g, a2);
    LDS_BAR();
#pragma unroll
    for (int n = 0; n < 2; ++n)
#pragma unroll
        for (int r = 0; r < 4; ++r) { const int j = 16 * (w >> 1) + 4 * g + r, d = 16 * (2 * (w & 1) + n) + c;
            HV[j * 65 + d] = (WI[j] * a1[n][r] + a2[n][r]) * __builtin_amdgcn_rcpf(DEN[j]); }
    LDS_BAR();
    {   const int j = tid >> 3, sg = tid & 7; float hv[8], ss = 0.f;
#pragma unroll
        for (int e = 0; e < 8; ++e) { hv[e] = HV[j * 65 + 8 * sg + e]; ss += hv[e] * hv[e]; }
        ss += __shfl_xor(ss, 1); ss += __shfl_xor(ss, 2); ss += __shfl_xor(ss, 4);
        const float rstd = rsqrtf(ss * (1.f / 64.f) + 1e-6f);
        const size_t tok = (size_t)b * S + 64 * ck + j;
        const float o8[8] = {half_lo(og.x), half_hi(og.x), half_lo(og.y), half_hi(og.y), half_lo(og.z), half_hi(og.z), half_lo(og.w), half_hi(og.w)};
        const float* ng = A.norm_g + h * 64 + 8 * sg;
        float r8[8];
#pragma unroll
        for (int e = 0; e < 8; ++e) r8[e] = hv[e] * rstd * ng[e] * __builtin_amdgcn_rcpf(1.f + __expf(-o8[e]));
        u32x4 ov; ov.x = pg8::pk_f16(r8[0], r8[1]); ov.y = pg8::pk_f16(r8[2], r8[3]); ov.z = pg8::pk_f16(r8[4], r8[5]); ov.w = pg8::pk_f16(r8[6], r8[7]);
        *(u32x4*)(A.O16 + tok * D + C_ATT + C_RW + h * 64 + 8 * sg) = ov;
    }
    LDS_BAR();
}
}
namespace rwk {
using nsa::f16x8; using nsa::f16x4; using nsa::f32x4; using nsa::u32x4; using nsa::u32x2; using nsa::mfma16;
constexpr size_t WS_WE = 364 * MiB, WS_AA = 388 * MiB, WS_GG = 412 * MiB;
constexpr size_t WS_LRW = WS_LRW0; constexpr int LRW_L = LRW_L0;
__device__ __forceinline__ f32x4 mfma16k16(f16x4 a, f16x4 b, f32x4 c) { return __builtin_amdgcn_mfma_f32_16x16x16f16(a, b, c, 0, 0, 0); }
template <int CTRL> __device__ __forceinline__ float dpp_mov(float v) { return __builtin_bit_cast(float, __builtin_amdgcn_update_dpp(0, __builtin_bit_cast(int, v), CTRL, 0xF, 0xF, true)); }
__device__ __forceinline__ float wave_sum_fast(float v) {
    v += dpp_mov<0xB1>(v); v += dpp_mov<0x4E>(v); v += dpp_mov<0x141>(v); v += dpp_mov<0x140>(v);
    const int iv = __builtin_bit_cast(int, v);
    return (__builtin_bit_cast(float, __builtin_amdgcn_readlane(iv, 0)) + __builtin_bit_cast(float, __builtin_amdgcn_readlane(iv, 16))) +
           (__builtin_bit_cast(float, __builtin_amdgcn_readlane(iv, 32)) + __builtin_bit_cast(float, __builtin_amdgcn_readlane(iv, 48)));
}
__device__ __forceinline__ float hlo(unsigned u) { return (float)__builtin_bit_cast(_Float16, (unsigned short)(u & 0xffffu)); }
__device__ __forceinline__ float hhi(unsigned u) { return (float)__builtin_bit_cast(_Float16, (unsigned short)(u >> 16)); }

template <int MAT> __device__ __forceinline__ void prep_mat(const LAS h16* X, LAS h16* OT, const h16* WT, const float* biasp, h16* outp, int tile, int w, int c, int g) {
        constexpr int K = (MAT == 2) ? 128 : 64, xp = (MAT == 2) ? 136 : 72;


        f32x4 acc[3][4];
#pragma unroll
        for (int nt = 0; nt < 3; ++nt)
#pragma unroll
            for (int mt = 0; mt < 4; ++mt) acc[nt][mt] = (f32x4){0.f, 0.f, 0.f, 0.f};
        f16x8 af[K / 32][3];
#pragma unroll
        for (int ks = 0; ks < K / 32; ++ks)
#pragma unroll
            for (int nt = 0; nt < 3; ++nt) af[ks][nt] = *(const f16x8*)(WT + (size_t)(48 * w + 16 * nt + c) * K + 32 * ks + 8 * g);
#pragma unroll
        for (int ks = 0; ks < K / 32; ++ks) {
            f16x8 bf[4];
#pragma unroll
            for (int mt = 0; mt < 4; ++mt) bf[mt] = *(const LAS f16x8*)(X + (16 * mt + c) * xp + 32 * ks + 8 * g);
#pragma unroll
            for (int nt = 0; nt < 3; ++nt)
#pragma unroll
                for (int mt = 0; mt < 4; ++mt) acc[nt][mt] = mfma16(af[ks][nt], bf[mt], acc[nt][mt]);
        }

#pragma unroll
        for (int nt = 0; nt < 3; ++nt) { const int ch = 48 * w + 16 * nt + 4 * g;
            f32x4 bias = {0.f, 0.f, 0.f, 0.f}; if (MAT == 0) bias = *(const f32x4*)(biasp + ch); else if (MAT == 1) bias = *(const f32x4*)(biasp + ch);
#pragma unroll
            for (int mt = 0; mt < 4; ++mt) { float o[4];
#pragma unroll
                for (int r = 0; r < 4; ++r) { const float x = acc[nt][mt][r] + bias[r];
                    if (MAT == 0) { const float sp = fmaxf(-x, 0.f) + __logf(1.f + __expf(-fabsf(x))); o[r] = __expf(-sp - 0.5f); }
                    else if (MAT == 1) o[r] = __builtin_amdgcn_rcpf(1.f + __expf(-x)); else o[r] = x; }
                u32x2 ov; ov.x = pg8::pk_f16(o[0], o[1]); ov.y = pg8::pk_f16(o[2], o[3]);
                *(LAS u32x2*)(OT + (16 * mt + c) * 392 + ch) = ov; }
        }
        __syncthreads();
        {
            int tid2_ = threadIdx.x; asm volatile("" : "+v"(tid2_));
#pragma unroll
            for (int k = 0; k < 6; ++k) { const int e = tid2_ + 512 * k, row = e / 48, cc = e % 48;
                *(u32x4*)(outp + ((size_t)tile * 64 + row) * C_RW + 8 * cc) = *(const LAS u32x4*)(OT + row * 392 + 8 * cc); }
        }
        __syncthreads();
}
constexpr size_t WS_RN = 363 * MiB + 128 * 1024;
struct PrepArgs { const h16* P16; const float *mu, *w0, *a0, *kkp; const h16* LRW; h16 *WE, *AA, *GG; float* RN; };
__device__ __forceinline__ void prep_item(const PrepArgs& A, int tile, LAS unsigned char* lds) {
    int tid_ = threadIdx.x; asm volatile("" : "+v"(tid_)); const int tid = tid_, lane = tid & 63, w = tid >> 6, c = lane & 15, g = lane >> 4;
    LAS h16* XW = (LAS h16*)lds;
    LAS h16* XA = XW + 64 * 72;
    LAS h16* XG = XA + 64 * 72;
    {
        const int tk = tid >> 3, part = tid & 7; const size_t tok = (size_t)tile * 64 + tk; const bool hasp = (tok % S) != 0;
        const h16* pc = A.P16 + tok * PITCH; const h16* pp = pc - PITCH;
#pragma unroll
        for (int q = 0; q < 4; ++q) {
            const int col = (q == 0) ? PC_XW + 8 * part : (q == 1) ? PC_XA + 8 * part : PC_XG + 64 * (q - 2) + 8 * part;
            const int mcol = (q == 0) ? 1152 + 8 * part : (q == 1) ? 1216 + 8 * part : 1280 + 64 * (q - 2) + 8 * part;
            const u32x4 xc = *(const u32x4*)(pc + col); u32x4 xp = {0u, 0u, 0u, 0u}; if (hasp) xp = *(const u32x4*)(pp + col);
            const float cv[8] = {hlo(xc.x), hhi(xc.x), hlo(xc.y), hhi(xc.y), hlo(xc.z), hhi(xc.z), hlo(xc.w), hhi(xc.w)};
            const float pv[8] = {hlo(xp.x), hhi(xp.x), hlo(xp.y), hhi(xp.y), hlo(xp.z), hhi(xp.z), hlo(xp.w), hhi(xp.w)};
            float o[8];
#pragma unroll
            for (int e = 0; e < 8; ++e) { const float x = cv[e] + A.mu[mcol + e] * (pv[e] - cv[e]);
                o[e] = (q == 0) ? (1.f - 2.f * __builtin_amdgcn_rcpf(1.f + __expf(2.f * x))) : (q == 1) ? x : __builtin_amdgcn_rcpf(1.f + __expf(-x)); }
            u32x4 ov; ov.x = pg8::pk_f16(o[0], o[1]); ov.y = pg8::pk_f16(o[2], o[3]); ov.z = pg8::pk_f16(o[4], o[5]); ov.w = pg8::pk_f16(o[6], o[7]);
            if (q == 0) *(LAS u32x4*)(XW + tk * 72 + 8 * part) = ov; else if (q == 1) *(LAS u32x4*)(XA + tk * 72 + 8 * part) = ov; else *(LAS u32x4*)(XG + tk * 136 + 64 * (q - 2) + 8 * part) = ov;
        }
#pragma unroll
        for (int hd = 0; hd < H_RW; ++hd) {
            const int col = hd * 64 + 8 * part;
            const u32x4 xc = *(const u32x4*)(pc + PC_K + col); u32x4 xp = {0u, 0u, 0u, 0u}; if (hasp) xp = *(const u32x4*)(pp + PC_K + col);
            const float cv[8] = {hlo(xc.x), hhi(xc.x), hlo(xc.y), hhi(xc.y), hlo(xc.z), hhi(xc.z), hlo(xc.w), hhi(xc.w)};
            const float pv[8] = {hlo(xp.x), hhi(xp.x), hlo(xp.y), hhi(xp.y), hlo(xp.z), hhi(xp.z), hlo(xp.w), hhi(xp.w)};
            float ss = 0.f;
#pragma unroll
            for (int e = 0; e < 8; ++e) { const float kq = (cv[e] + A.mu[384 + col + e] * (pv[e] - cv[e])) * A.kkp[col + e]; ss += kq * kq; }
            ss += __shfl_xor(ss, 1); ss += __shfl_xor(ss, 2); ss += __shfl_xor(ss, 4);
            if (part == 0) A.RN[tok * 6 + hd] = rsqrtf(fmaxf(ss, 1e-24f));
        }
    }
    __syncthreads();
    LAS h16* OT = XG + 64 * 136;
    prep_mat<0>(XW, OT, A.LRW, A.w0, A.WE, tile, w, c, g);
    prep_mat<1>(XA, OT, A.LRW + 384 * 64, A.a0, A.AA, tile, w, c, g);
    prep_mat<2>(XG, OT, A.LRW + 2 * 384 * 64, nullptr, A.GG, tile, w, c, g);
}

struct ScanArgs { const h16* P16; const h16 *WE, *AA; const float* RN; const float *mu, *kk, *ka; h16* O16; };
constexpr int NS = 8, AP = 72, TP2 = 20;
constexpr int S_AT = 0, S_RT = 2304, S_BN = 4608, S_KN = 6912, S_BT = 9216, S_KT = 11776, S_VT = 14336, S_T = 16896, S_MAK = 17536, S_MRB = 18176, S_MRK = 18816, S_GL = 19456, S_N = S_BN  , SLOT = 19712;
constexpr int NCH = S / 16;
static_assert(NS * SLOT <= LDS_BYTES - 16, "scan slots fit the LDS allocation");
struct RawRegs { unsigned short r[16], k[16], v[16], e[16], a[16]; unsigned short pr, pk, pv; float rn; };
__device__ __forceinline__ void scan_load(const ScanArgs& A, int b, int h, int ck, int lane, RawRegs& R) {
    const int ch = h * 64 + lane; const size_t tok0 = (size_t)b * S + 16 * ck;
    const unsigned short* p0 = (const unsigned short*)A.P16 + tok0 * PITCH + ch;
    const unsigned short* we = (const unsigned short*)A.WE + tok0 * C_RW + ch; const unsigned short* aa = (const unsigned short*)A.AA + tok0 * C_RW + ch;
    R.pr = 0; R.pk = 0; R.pv = 0;
    if (ck > 0) { R.pr = p0[PC_R - PITCH]; R.pk = p0[PC_K - PITCH]; R.pv = p0[PC_V - PITCH]; }
#pragma unroll
    for (int t = 0; t < 16; ++t) { R.r[t] = p0[(size_t)t * PITCH + PC_R]; R.k[t] = p0[(size_t)t * PITCH + PC_K]; R.v[t] = p0[(size_t)t * PITCH + PC_V]; R.e[t] = we[t * C_RW]; R.a[t] = aa[t * C_RW]; }
    R.rn = A.RN[(tok0 + (lane & 15)) * 6 + h];
}
__device__ __forceinline__ float us2f(unsigned short u) { return (float)__builtin_bit_cast(_Float16, u); }
__device__ __forceinline__ void scan_item(const ScanArgs& A, int bh, LAS unsigned char* lds) {
    int tid_ = threadIdx.x; asm volatile("" : "+v"(tid_)); const int tid = tid_, lane = tid & 63, w = __builtin_amdgcn_readfirstlane(tid >> 6), c = lane & 15, g = lane >> 4;
    const int b = bh / H_RW, h = bh % H_RW, ch = h * 64 + lane;
    LAS unsigned char* sb = lds + w * SLOT;
    LAS h16* AT = (LAS h16*)(sb + S_AT); LAS h16* RT = (LAS h16*)(sb + S_RT); LAS h16* BN = (LAS h16*)(sb + S_BN); LAS h16* KN = (LAS h16*)(sb + S_KN);
    LAS h16* BT = (LAS h16*)(sb + S_BT); LAS h16* KT = (LAS h16*)(sb + S_KT); LAS h16* VT = (LAS h16*)(sb + S_VT);
    LAS h16* TM = (LAS h16*)(sb + S_T); LAS h16* MAK = (LAS h16*)(sb + S_MAK); LAS h16* MRB = (LAS h16*)(sb + S_MRB); LAS h16* MRK = (LAS h16*)(sb + S_MRK);
    LAS float* GL = (LAS float*)(sb + S_GL); LAS float* N32 = (LAS float*)(sb + S_N);
    const float mu_r = A.mu[ch], mu_k = A.mu[384 + ch], mu_v = A.mu[768 + ch], k_k = A.kk[ch], k_a = A.ka[ch];
    f32x4 X[4];
#pragma unroll
    for (int kt = 0; kt < 4; ++kt) X[kt] = (f32x4){0.f, 0.f, 0.f, 0.f};
    RawRegs R;
    scan_load(A, b, h, w, lane, R);
#pragma unroll 1
    for (int bt = 0; bt < NCH / NS; ++bt) {
        {
            float pr = us2f(R.pr), pk = us2f(R.pk), pv = us2f(R.pv);
            float cl = 0.f, G = 1.f;
            const int rnv = __builtin_bit_cast(int, R.rn);
#pragma unroll
            for (int t = 0; t < 16; ++t) {
                const float cr = us2f(R.r[t]), ckv = us2f(R.k[t]), cv = us2f(R.v[t]), e = us2f(R.e[t]), a = us2f(R.a[t]);
                const float r = cr + mu_r * (pr - cr), k = ckv + mu_k * (pk - ckv), v = cv + mu_v * (pv - cv);
                pr = cr; pk = ckv; pv = cv;
                const float Gm1 = G; cl -= e; G = __expf(cl); const float iG = __builtin_amdgcn_rcpf(G);
                const float rn = __builtin_bit_cast(float, __builtin_amdgcn_readlane(rnv, t));
                const float kkn = k * k_k * rn;
                const float k2 = k * (1.f + (a - 1.f) * k_a), be = kkn * a;
                const h16 at = (h16)(-kkn * Gm1), bt_ = (h16)(be * iG), kt_ = (h16)(k2 * iG), rt = (h16)(r * G);
                AT[t * AP + lane] = at; RT[t * AP + lane] = rt; BN[t * AP + lane] = bt_; KN[t * AP + lane] = kt_;
                BT[lane * TP2 + t] = bt_; KT[lane * TP2 + t] = kt_; VT[lane * TP2 + t] = (h16)v;
            }
            GL[lane] = G;
            if (bt + 1 < NCH / NS) scan_load(A, b, h, NS * (bt + 1) + w, lane, R);
            asm volatile("s_waitcnt lgkmcnt(0)" ::: "memory");
            f32x4 mab = {0.f, 0.f, 0.f, 0.f}, mak = mab, mrb = mab, mrk = mab;
#pragma unroll
            for (int ks = 0; ks < 2; ++ks) {
                const f16x8 fa = *(const LAS f16x8*)(AT + c * AP + 32 * ks + 8 * g), fr = *(const LAS f16x8*)(RT + c * AP + 32 * ks + 8 * g);
                const f16x8 fb = *(const LAS f16x8*)(BN + c * AP + 32 * ks + 8 * g), fk = *(const LAS f16x8*)(KN + c * AP + 32 * ks + 8 * g);
                mab = mfma16(fa, fb, mab); mak = mfma16(fa, fk, mak); mrb = mfma16(fr, fb, mrb); mrk = mfma16(fr, fk, mrk);
            }
            asm volatile("s_waitcnt lgkmcnt(0)" ::: "memory");
#pragma unroll
            for (int r = 0; r < 4; ++r) { const int t = 4 * g + r;
                N32[t * 16 + c] = (c < t) ? mab[r] : 0.f;
                MAK[t * TP2 + c] = (h16)((c < t) ? mak[r] : 0.f); MRB[t * TP2 + c] = (h16)((c <= t) ? mrb[r] : 0.f); MRK[t * TP2 + c] = (h16)((c <= t) ? mrk[r] : 0.f); }
            asm volatile("s_waitcnt lgkmcnt(0)" ::: "memory");
            {
                float Tc[16];
#pragma unroll
                for (int t = 0; t < 16; ++t) {
                    float acc = (t == c) ? 1.f : 0.f;
#pragma unroll
                    for (int s4 = 0; s4 < (t + 3) / 4; ++s4) { const f32x4 nr = *(const LAS f32x4*)(N32 + t * 16 + 4 * s4);
#pragma unroll
                        for (int e = 0; e < 4; ++e) if (4 * s4 + e < t) acc += nr[e] * Tc[4 * s4 + e]; }
                    Tc[t] = acc;
                }
                if (g == 0) {
#pragma unroll
                    for (int t = 0; t < 16; ++t) TM[t * TP2 + c] = (h16)Tc[t];
                }
            }
        }
        asm volatile("s_waitcnt lgkmcnt(0)" ::: "memory"); __builtin_amdgcn_s_barrier(); asm volatile("" ::: "memory");
        if (w < 4) {
#pragma unroll 1
            for (int sl = 0; sl < NS; ++sl) {
                const int ck = NS * bt + sl;
                const LAS unsigned char* cb = lds + sl * SLOT;
                const LAS h16* cAT = (const LAS h16*)(cb + S_AT); const LAS h16* cRT = (const LAS h16*)(cb + S_RT);
                const LAS h16* cBT = (const LAS h16*)(cb + S_BT); const LAS h16* cKT = (const LAS h16*)(cb + S_KT); const LAS h16* cVT = (const LAS h16*)(cb + S_VT);
                const LAS h16* cTM = (const LAS h16*)(cb + S_T); const LAS h16* cMAK = (const LAS h16*)(cb + S_MAK); const LAS h16* cMRB = (const LAS h16*)(cb + S_MRB); const LAS h16* cMRK = (const LAS h16*)(cb + S_MRK);
                const LAS float* cGL = (const LAS float*)(cb + S_GL);
                f16x8 xf[2];
#pragma unroll
                for (int ks = 0; ks < 2; ++ks) { const f32x4 x0 = X[2 * ks], x1 = X[2 * ks + 1];
                    xf[ks] = (f16x8){(_Float16)x0[0], (_Float16)x0[1], (_Float16)x0[2], (_Float16)x0[3], (_Float16)x1[0], (_Float16)x1[1], (_Float16)x1[2], (_Float16)x1[3]}; }
                const f16x4 vf = *(const LAS f16x4*)(cVT + (16 * w + c) * TP2 + 4 * g);
                const f16x4 makf = *(const LAS f16x4*)(cMAK + c * TP2 + 4 * g), tf = *(const LAS f16x4*)(cTM + c * TP2 + 4 * g);
                const f16x4 mrbf = *(const LAS f16x4*)(cMRB + c * TP2 + 4 * g), mrkf = *(const LAS f16x4*)(cMRK + c * TP2 + 4 * g);
                f16x8 af[2], rf[2];
#pragma unroll
                for (int ks = 0; ks < 2; ++ks) {
                    const f16x4 a0 = *(const LAS f16x4*)(cAT + c * AP + 32 * ks + 4 * g), a1 = *(const LAS f16x4*)(cAT + c * AP + 32 * ks + 16 + 4 * g);
                    const f16x4 r0 = *(const LAS f16x4*)(cRT + c * AP + 32 * ks + 4 * g), r1 = *(const LAS f16x4*)(cRT + c * AP + 32 * ks + 16 + 4 * g);
                    af[ks] = (f16x8){a0[0], a0[1], a0[2], a0[3], a1[0], a1[1], a1[2], a1[3]}; rf[ks] = (f16x8){r0[0], r0[1], r0[2], r0[3], r1[0], r1[1], r1[2], r1[3]};
                }
                f32x4 gw = {0.f, 0.f, 0.f, 0.f};
                gw = mfma16k16(makf, vf, gw); gw = mfma16(af[0], xf[0], gw); gw = mfma16(af[1], xf[1], gw);
                const f16x4 gwf = (f16x4){(_Float16)gw[0], (_Float16)gw[1], (_Float16)gw[2], (_Float16)gw[3]};
                f32x4 u = {0.f, 0.f, 0.f, 0.f}; u = mfma16k16(tf, gwf, u);
                const f16x4 uf = (f16x4){(_Float16)u[0], (_Float16)u[1], (_Float16)u[2], (_Float16)u[3]};
                f32x4 yy = {0.f, 0.f, 0.f, 0.f};
                yy = mfma16k16(mrkf, vf, yy); yy = mfma16k16(mrbf, uf, yy); yy = mfma16(rf[0], xf[0], yy); yy = mfma16(rf[1], xf[1], yy);
#pragma unroll
                for (int kt = 0; kt < 4; ++kt) {
                    const f16x4 btf = *(const LAS f16x4*)(cBT + (16 * kt + c) * TP2 + 4 * g), ktf = *(const LAS f16x4*)(cKT + (16 * kt + c) * TP2 + 4 * g);
                    const f32x4 gl = *(const LAS f32x4*)(cGL + 16 * kt + 4 * g);
                    f32x4 x = X[kt]; x = mfma16k16(btf, uf, x); x = mfma16k16(ktf, vf, x); X[kt] = x * gl;
                }
                h16* op = A.O16 + ((size_t)b * S + 16 * ck + 4 * g) * D + C_ATT + h * 64 + 16 * w + c;
#pragma unroll
                for (int r = 0; r < 4; ++r) op[(size_t)r * D] = (h16)yy[r];
            }
        }
        asm volatile("s_waitcnt lgkmcnt(0)" ::: "memory"); __builtin_amdgcn_s_barrier(); asm volatile("" ::: "memory");
    }
    asm volatile("s_waitcnt vmcnt(0)" ::: "memory");
    __syncthreads();
}

struct PostArgs { const h16* P16; const h16 *AA, *GG; const float *mu, *ka, *rk, *lnw, *lnb; h16* O16; };
struct PostRaw4 { u32x2 cr, ck, cv, qr, qk, qv, av, gv, yv; };
__device__ __forceinline__ float row_sum16(float v) { v += dpp_mov<0xB1>(v); v += dpp_mov<0x4E>(v); v += dpp_mov<0x141>(v); v += dpp_mov<0x140>(v); return v; }
__device__ __forceinline__ void post_head_load(PostRaw4& R, const PostArgs& A, size_t tok, int col) {
    const h16* pc = A.P16 + tok * PITCH + col; const bool hasp = (tok % S) != 0;
    R.cr = *(const u32x2*)(pc + PC_R); R.ck = *(const u32x2*)(pc + PC_K); R.cv = *(const u32x2*)(pc + PC_V);
    R.qr = (u32x2){0u, 0u}; R.qk = (u32x2){0u, 0u}; R.qv = (u32x2){0u, 0u};
    if (hasp) { R.qr = *(const u32x2*)(pc + PC_R - PITCH); R.qk = *(const u32x2*)(pc + PC_K - PITCH); R.qv = *(const u32x2*)(pc + PC_V - PITCH); }
    R.av = *(const u32x2*)(A.AA + tok * C_RW + col); R.gv = *(const u32x2*)(A.GG + tok * C_RW + col); R.yv = *(const u32x2*)(A.O16 + tok * D + C_ATT + col);
}
__device__ __forceinline__ void h4(const u32x2 w, float (&o)[4]) { o[0] = hlo(w.x); o[1] = hhi(w.x); o[2] = hlo(w.y); o[3] = hhi(w.y); }
__device__ __forceinline__ void post_part(const PostArgs& A, int b, int h, int part) {
    int tid_ = threadIdx.x; asm volatile("" : "+v"(tid_)); const int lane = tid_ & 63, w = tid_ >> 6, col = h * 64 + 4 * (lane & 15);
    float mur[4], muk[4], muv[4], kaw[4], rkw[4], lw[4], lb[4];
#pragma unroll
    for (int e = 0; e < 4; ++e) { mur[e] = A.mu[col + e]; muk[e] = A.mu[384 + col + e]; muv[e] = A.mu[768 + col + e]; kaw[e] = A.ka[col + e]; rkw[e] = A.rk[col + e]; lw[e] = A.lnw[col + e]; lb[e] = A.lnb[col + e]; }
    const size_t tok0 = (size_t)b * S + 512 * part + 64 * w + (lane >> 4);
    PostRaw4 R0, R1;
    post_head_load(R0, A, tok0, col);
#define RWK_POST4(R, TOK) do { \
        float fr[4], fk[4], fv[4], qr[4], qk[4], qv[4], av[4], gv[4], y[4]; \
        h4(R.cr, fr); h4(R.ck, fk); h4(R.cv, fv); h4(R.qr, qr); h4(R.qk, qk); h4(R.qv, qv); h4(R.av, av); h4(R.gv, gv); h4(R.yv, y); \
        float sb = 0.f, vv[4]; \
        _Pragma("unroll") for (int e = 0; e < 4; ++e) { const float r = fr[e] + mur[e] * (qr[e] - fr[e]), k = fk[e] + muk[e] * (qk[e] - fk[e]); vv[e] = fv[e] + muv[e] * (qv[e] - fv[e]); \
            sb += r * (k * (1.f + (av[e] - 1.f) * kaw[e])) * rkw[e]; } \
        const float mean = row_sum16((y[0] + y[1]) + (y[2] + y[3])) * (1.f / 64.f); \
        float dv[4], sv = 0.f; \
        _Pragma("unroll") for (int e = 0; e < 4; ++e) { dv[e] = y[e] - mean; sv += dv[e] * dv[e]; } \
        const float rs = rsqrtf(row_sum16(sv) * (1.f / 64.f) + 64e-5f); \
        const float bon = row_sum16(sb); \
        float o[4]; \
        _Pragma("unroll") for (int e = 0; e < 4; ++e) o[e] = (dv[e] * rs * lw[e] + lb[e] + bon * vv[e]) * gv[e]; \
        u32x2 ov; ov.x = pg8::pk_f16(o[0], o[1]); ov.y = pg8::pk_f16(o[2], o[3]); \
        *(u32x2*)(A.O16 + (TOK) * D + C_ATT + col) = ov; } while (0)
#pragma unroll 1
    for (int t0 = 0; t0 < 64; t0 += 8) {
        post_head_load(R1, A, tok0 + t0 + 4, col);
        RWK_POST4(R0, tok0 + t0);
        if (t0 + 8 < 64) post_head_load(R0, A, tok0 + t0 + 8, col);
        RWK_POST4(R1, tok0 + t0 + 4);
    }
#undef RWK_POST4
}
}
__device__ __forceinline__ void skinny_item(const h16* H, const h16* Wsm, h16* P16o, int tile, LAS unsigned char* lds) {
    int tid_ = threadIdx.x; asm volatile("" : "+v"(tid_)); const int tid = tid_, lane = tid & 63, w = tid >> 6, c = lane & 15, g = lane >> 4;
    LAS float* PART = (LAS float*)lds;
    nsa::f16x8 af[4][4], bf[4][2];
#pragma unroll
    for (int ks = 0; ks < 4; ++ks) { const int k0 = 128 * w + 32 * ks + 8 * g;
#pragma unroll
        for (int mt = 0; mt < 4; ++mt) af[ks][mt] = *(const nsa::f16x8*)(H + ((size_t)tile * 64 + 16 * mt + c) * D + k0);
#pragma unroll
        for (int nt = 0; nt < 2; ++nt) bf[ks][nt] = *(const nsa::f16x8*)(Wsm + (size_t)(16 * nt + c) * D + k0); }
    nsa::f32x4 acc[4][2];
#pragma unroll
    for (int mt = 0; mt < 4; ++mt)
#pragma unroll
        for (int nt = 0; nt < 2; ++nt) acc[mt][nt] = (nsa::f32x4){0.f, 0.f, 0.f, 0.f};
#pragma unroll
    for (int ks = 0; ks < 4; ++ks)
#pragma unroll
        for (int mt = 0; mt < 4; ++mt)
#pragma unroll
            for (int nt = 0; nt < 2; ++nt) acc[mt][nt] = nsa::mfma16(bf[ks][nt], af[ks][mt], acc[mt][nt]);
#pragma unroll
    for (int mt = 0; mt < 4; ++mt)
#pragma unroll
        for (int nt = 0; nt < 2; ++nt) *(LAS nsa::f32x4*)(PART + (w * 64 + 16 * mt + c) * 32 + 16 * nt + 4 * g) = acc[mt][nt];
    __syncthreads();
    {   const int tk = tid >> 3, c4 = (tid & 7) * 4;
        nsa::f32x4 s = {0.f, 0.f, 0.f, 0.f};
#pragma unroll
        for (int ww = 0; ww < 8; ++ww) s = s + *(const LAS nsa::f32x4*)(PART + (ww * 64 + tk) * 32 + c4);
        if (c4 < 24) { pg8::u32x2 o; o.x = pg8::pk_f16(s[0], s[1]); o.y = pg8::pk_f16(s[2], s[3]); *(pg8::u32x2*)(P16o + ((size_t)tile * 64 + tk) * PITCH + PC_GTS + c4) = o; }
    }
    __syncthreads();
}
#define XB_TMO      128
#define XB_XCNT(j)  (256  + 64 * (j))
#define XB_XSUB(j)  (1280 + 64 * (j))
#define XB_XGEN(j)  (2304 + 64 * (j))
#define XB_TOP      3328
#define XB_TOPGEN   3392
#define XCD_BAR_WORDS 3456
#define XB_SPIN_CAP (1u << 18)

__device__ __forceinline__ unsigned xb_ld(unsigned* p)              { return __hip_atomic_load(p, __ATOMIC_RELAXED, __HIP_MEMORY_SCOPE_AGENT); }
__device__ __forceinline__ unsigned xb_add(unsigned* p, unsigned v) { return __hip_atomic_fetch_add(p, v, __ATOMIC_RELAXED, __HIP_MEMORY_SCOPE_AGENT); }
__device__ __forceinline__ unsigned xb_xcc_id() { return (unsigned)__builtin_amdgcn_s_getreg((3 << 11) | 20) & 0xFu; }
#define XB_SPIN(cond, bar) do { unsigned _sp = 0; while (cond) { __builtin_amdgcn_s_sleep(1); \
    if ((++_sp & 255u) == 0u) { if (xb_ld(&(bar)[XB_TMO])) break; if (_sp > XB_SPIN_CAP) { atomicAdd(&(bar)[XB_TMO], 1u); break; } } } } while (0)

struct XcdBarrier {
    unsigned* bar; unsigned x;
    volatile LAS unsigned* st;
};

__device__ __forceinline__ XcdBarrier xcd_barrier_post(unsigned* bar, volatile LAS unsigned* st) {
    XcdBarrier b; b.bar = bar; b.x = xb_xcc_id(); b.st = st;
    if (threadIdx.x == 0) (void)xb_add(&bar[XB_XCNT(b.x)], 1u);
    return b;
}
__device__ __forceinline__ void xcd_barrier_complete(unsigned* bar, unsigned x, unsigned& nloc, unsigned& nx) {
    const unsigned G = gridDim.x * gridDim.y * gridDim.z;
    unsigned sum, cnt, mine, sp = 0u;
    for (;;) {
        sum = 0u; cnt = 0u; mine = 0u;
#pragma unroll
        for (unsigned j = 0; j < 16; ++j) { const unsigned c = xb_ld(&bar[XB_XCNT(j)]); sum += c; cnt += (c > 0u) ? 1u : 0u; mine = (j == x) ? c : mine; }
        if (sum == G) break;
        __builtin_amdgcn_s_sleep(1);
        if ((++sp & 255u) == 0u) { if (xb_ld(&bar[XB_TMO])) break; if (sp > XB_SPIN_CAP) { atomicAdd(&bar[XB_TMO], 1u); break; } }
    }
    nloc = mine > 0u ? mine : 1u; nx = cnt > 0u ? cnt : 1u;
}

__device__ __forceinline__ void xcd_barrier(const XcdBarrier& b) {
    asm volatile("s_waitcnt vmcnt(0)" ::: "memory");
    __syncthreads();
    if (threadIdx.x == 0) {
        unsigned* bar = b.bar;
        __builtin_amdgcn_s_waitcnt(0);
        unsigned nloc = b.st[0], nx = b.st[1];
        if (nloc == 0u) { xcd_barrier_complete(bar, b.x, nloc, nx); b.st[0] = nloc; b.st[1] = nx; }
        const unsigned old = xb_add(&bar[XB_XSUB(b.x)], 1u);
        const unsigned gen = old / nloc;
        if (old + 1u == (gen + 1u) * nloc) {
            __builtin_amdgcn_fence(__ATOMIC_RELEASE, "agent");
            asm volatile("s_waitcnt vmcnt(0)" ::: "memory");
            const unsigned og = xb_add(&bar[XB_TOP], 1u);
            const unsigned tg = og / nx;
            if (og + 1u == (tg + 1u) * nx) xb_add(&bar[XB_TOPGEN], 1u);
            else XB_SPIN(xb_ld(&bar[XB_TOPGEN]) == tg, bar);
            __builtin_amdgcn_fence(__ATOMIC_ACQUIRE, "agent");
            xb_add(&bar[XB_XGEN(b.x)], 1u);
            asm volatile("s_waitcnt vmcnt(0)" ::: "memory");
        } else {
            XB_SPIN(xb_ld(&bar[XB_XGEN(b.x)]) == gen, bar);
            __builtin_amdgcn_fence(__ATOMIC_ACQUIRE, "agent");
            asm volatile("s_waitcnt vmcnt(0)" ::: "memory");
        }
    }
    __syncthreads();
}
constexpr int N_PHASES = 20;
__global__ void __launch_bounds__(512, 2) mk_fwd(Args a) {
    extern __shared__ __attribute__((aligned(16))) unsigned char lds_raw[];
    LAS unsigned char* lds = (LAS unsigned char*)lds_raw;
    cg::grid_group grid = cg::this_grid();
    if (threadIdx.x < 4) ((LAS unsigned*)(lds + L_BARST))[threadIdx.x] = 0u;
    __syncthreads();
    const XcdBarrier xbar = xcd_barrier_post((unsigned*)(a.ws + WS_BAR), (volatile LAS unsigned*)(lds + L_BARST));
    unsigned char* ws = a.ws;
    float* MOD = (float*)(ws + WS_MOD); h16* QK32 = (h16*)(ws + WS_QK32); h16* P16 = (h16*)(ws + WS_P16); h16* H16 = (h16*)(ws + WS_H16);
    h16* Y16 = (h16*)(ws + WS_Y32); h16* ACT = (h16*)(ws + WS_ACT); float* X = a.out;
    h16* XB16 = (h16*)(ws + WS_XB16);
    const int lo = a.ph_lo, hi = a.ph_hi;
#define IN(k) (lo <= (k) && (k) < hi)
    if (lo > 1000) grid.sync();
#define SEAM(k) do { if (IN(k) && IN((k) + 1)) { \
        xcd_barrier(xbar); \
    } } while (0)
    if (IN(0)) { phase_prologue(a, lds); } SEAM(0);
    if (IN(1)) { phase_post<false, false, false, true, 2>(a.in[0], nullptr, nullptr, MOD, 0, nullptr, a.in[4], MOD, 0, D, H16); prologue_weights(a, lds, 1); } SEAM(1);
#define LAYER(l) do { \
    const float* modl = MOD + (size_t)(l) * NB * 6 * D; constexpr int pb = 2 + 9 * (l); \
    mls::Args ma{P16, a.in[29] + (l) * 4 * 768, a.in[30] + (l) * 768, a.in[31] + (l) * H_ML, a.in[32] + (l) * H_ML, a.in[33] + (l) * C_ML, (float*)(ws + mls::WS_KVB), (float*)(ws + mls::WS_KSUM), (float*)(ws + mls::WS_MUB), H16, (float*)(ws + mls::WS_GT), (const h16*)(ws + WS_CW16) + (size_t)(l) * 5 * 768}; \
    if (IN(pb + 0)) { for (int it = blockIdx.x; it < 512; it += gridDim.x) skinny_item(H16, (const h16*)(ws + WS_WSM) + (size_t)(l) * 32 * D, P16, it, lds); \
        pg8::Gemm g{H16, (const h16*)(ws + WS_WIN) + (size_t)(l) * NIN_PAD * D, M, NIN_PAD, D}; pg8::StaticOrder So; So.init(M, NIN_PAD, gridDim.x, blockIdx.x); \
        pg8::EpiProj E{QK32, P16, (h16*)(ws + WS_VTG)}; pg8::gemm_phase<pg8::EpiProj, pg8::StaticOrder, true, true>(lds, g, So, E); } SEAM(pb + 0); \
    if (IN(pb + 1)) { nsa::CmpArgs ca{QK32, P16, (const h16*)(ws + WS_W1C) + (size_t)(l) * 2 * 64 * 2048, (const float*)(ws + WS_CBIAS) + (l) * 128, a.in[13] + (l) * 4096, a.in[15] + (l) * 4096, (h16*)(ws + WS_KC16), (h16*)(ws + WS_VC16)}; \
        for (int it = blockIdx.x; it < 256; it += gridDim.x) nsa::compress_item(ca, it >> 5, (it >> 4) & 1, it & 15, lds); \
        for (int it = blockIdx.x; it < 3072; it += gridDim.x) mls::m1_item(ma, it >> 6, it & 63, lds); \
        rwk::PrepArgs rp{P16, a.in[18] + (l) * RW_IN, a.in[19] + (l) * C_RW, a.in[21] + (l) * C_RW, a.in[24] + (l) * C_RW, (const h16*)(ws + rwk::WS_LRW) + (size_t)(l) * rwk::LRW_L, (h16*)(ws + rwk::WS_WE), (h16*)(ws + rwk::WS_AA), (h16*)(ws + rwk::WS_GG), (float*)(ws + rwk::WS_RN)}; \
        for (int it = blockIdx.x; it < 512; it += gridDim.x) rwk::prep_item(rp, it, lds); } SEAM(pb + 1); \
    if (IN(pb + 2)) { nsa::AttnArgs aa{QK32, P16, (const h16*)(ws + WS_KC16), (const h16*)(ws + WS_VC16), (const h16*)(ws + WS_VTG), a.in[16] + (l) * 12, a.in[17] + (l) * 256, H16}; \
        rwk::ScanArgs rs{P16, (const h16*)(ws + rwk::WS_WE), (const h16*)(ws + rwk::WS_AA), (const float*)(ws + rwk::WS_RN), a.in[18] + (l) * RW_IN, a.in[24] + (l) * C_RW, a.in[25] + (l) * C_RW, H16}; \
        rwk::PostArgs rq{P16, (const h16*)(ws + rwk::WS_AA), (const h16*)(ws + rwk::WS_GG), a.in[18] + (l) * RW_IN, a.in[25] + (l) * C_RW, a.in[26] + (l) * C_RW, a.in[27] + (l) * C_RW, a.in[28] + (l) * C_RW, H16}; \
        if (blockIdx.x < 48) { rwk::scan_item(rs, blockIdx.x, lds);   \
            if (threadIdx.x == 0) { __builtin_amdgcn_fence(__ATOMIC_RELEASE, "agent"); asm volatile("s_waitcnt vmcnt(0)" ::: "memory"); \
                __hip_atomic_fetch_add((unsigned*)(ws + WS_QCTR) + 64 * (48 + (l) * 8 + (int)blockIdx.x / H_RW), 1u, __ATOMIC_RELAXED, __HIP_MEMORY_SCOPE_AGENT); } } \
        {     \
            volatile LAS unsigned* qs = (volatile LAS unsigned*)(lds + L_QSLOT); \
            for (int kq = 0; kq < 8; ++kq) {   \
            const int xq = (int)((xbar.x + (unsigned)kq) & 7u); unsigned* qh = (unsigned*)(ws + WS_QCTR) + 64 * ((l) * 8 + xq); unsigned* m2d = (unsigned*)(ws + WS_QCTR) + 64 * (32 + (l) * 8 + xq); unsigned* scd = (unsigned*)(ws + WS_QCTR) + 64 * (48 + (l) * 8 + xq); int it; \
            for (;;) { __syncthreads(); if (threadIdx.x == 0) *qs = atomicAdd(qh, 1u); __syncthreads(); it = (int)*qs; if (it >= 24 + 64) break; \
                if (it < 24) { mls::m2_item(ma, xq * 6 + (it >> 2), it & 3); asm volatile("s_waitcnt vmcnt(0)" ::: "memory"); __syncthreads(); \
                               if (threadIdx.x == 0) { __builtin_amdgcn_fence(__ATOMIC_RELEASE, "agent"); asm volatile("s_waitcnt vmcnt(0)" ::: "memory"); __hip_atomic_fetch_add(m2d, 1u, __ATOMIC_RELAXED, __HIP_MEMORY_SCOPE_AGENT); } } \
                else nsa::attn_item(aa, xq, 63 - (it - 24), lds); } \
            if (it < 24 + 64 + 384) {   \
                if (threadIdx.x == 0) { while (__hip_atomic_load(m2d, __ATOMIC_RELAXED, __HIP_MEMORY_SCOPE_AGENT) < 24u) __builtin_amdgcn_s_sleep(8); } \
                __syncthreads(); __builtin_amdgcn_fence(__ATOMIC_ACQUIRE, "agent"); asm volatile("s_waitcnt vmcnt(0)" ::: "memory"); \
                mls::M3Regs mr; mls::m3_load(mr, ma, xq * 384 + (it - 88), threadIdx.x); \
                while (it < 24 + 64 + 384) { __syncthreads(); if (threadIdx.x == 0) *qs = atomicAdd(qh, 1u); __syncthreads(); const int nx = (int)*qs; \
                    mls::m3_item(ma, xq * 384 + (it - 88), nx < 24 + 64 + 384 ? xq * 384 + (nx - 88) : -1, mr, lds); it = nx; } } \
            if (it < 472 + 48) {   \
                if (threadIdx.x == 0) { while (__hip_atomic_load(scd, __ATOMIC_RELAXED, __HIP_MEMORY_SCOPE_AGENT) < 6u) __builtin_amdgcn_s_sleep(8); } \
                __syncthreads(); __builtin_amdgcn_fence(__ATOMIC_ACQUIRE, "agent"); asm volatile("s_waitcnt vmcnt(0)" ::: "memory"); \
                while (it < 472 + 48) { rwk::post_part(rq, xq, (it - 472) >> 3, (it - 472) & 7); \
                    __syncthreads(); if (threadIdx.x == 0) *qs = atomicAdd(qh, 1u); __syncthreads(); it = (int)*qs; } } } } } SEAM(pb + 2); \
    if (IN(pb + 4)) { pg8::Gemm g{H16, (const h16*)(ws + WS_WOUT) + (size_t)(l) * D * D, M, D, D}; pg8::StaticOrder So; So.init(M, D, gridDim.x, blockIdx.x); \
        pg8::EpiF16 E{Y16, D}; pg8::gemm_phase<pg8::EpiF16, pg8::StaticOrder, true, true>(lds, g, So, E); } SEAM(pb + 4); \
    if (IN(pb + 5)) { phase_post<(l) != 0, true, true, true, 2>((l) == 0 ? (const void*)a.in[0] : (const void*)X, Y16, a.in[5] + (l) * D, modl, 2 * D, XB16, a.in[6] + (l) * D, modl, 3 * D, 4 * D, H16); } SEAM(pb + 5); \
    if (IN(pb + 6)) { pg8::Gemm g{H16, (const h16*)(ws + WS_W1) + (size_t)(l) * NFF2 * D, M, NFF2, D}; pg8::StaticOrder So; So.init(M, NFF2, gridDim.x, blockIdx.x); \
        pg8::EpiSwiglu E{ACT, DFF}; pg8::gemm_phase<pg8::EpiSwiglu, pg8::StaticOrder, true, true>(lds, g, So, E); } SEAM(pb + 6); \
    if (IN(pb + 7)) { pg8::Gemm g{ACT, (const h16*)(ws + WS_W2) + (size_t)(l) * D * DFF, M, D, DFF}; pg8::StaticOrder So; So.init(M, D, gridDim.x, blockIdx.x); \
        pg8::EpiF16 E{Y16, D}; pg8::gemm_phase<pg8::EpiF16, pg8::StaticOrder, true, true>(lds, g, So, E); } SEAM(pb + 7); \
    if (IN(pb + 8)) { constexpr bool last = ((l) == DEPTH - 1); \
        phase_post<true, !last, true, !last, 2>(XB16, Y16, a.in[7] + (l) * D, modl, 5 * D, X, last ? nullptr : a.in[4] + ((l) + 1) * D, MOD + (size_t)(last ? (l) : (l) + 1) * NB * 6 * D, 0, D, H16); } \
    if (!((l) == DEPTH - 1)) SEAM(pb + 8); \
    } while (0)
    LAYER(0);
    LAYER(1);
#undef LAYER
#undef SEAM
#undef IN
}

static int g_grid = 0;
static void launch_mk(const Args& a0, int lo, int hi, hipStream_t stream) {
    Args a = a0; a.ph_lo = lo; a.ph_hi = hi;
    void* args[] = {(void*)&a};
    hipError_t e = hipLaunchCooperativeKernel((const void*)mk_fwd, dim3(g_grid), dim3(512), args, LDS_BYTES, stream);
    if (e != hipSuccess) fprintf(stderr, "cooperative launch failed: %s (grid %d)\n", hipGetErrorString(e), g_grid);
}
extern "C" void kernel_launch(void* const* d_in, const int* in_sizes, int n_in, void* d_out, int out_size, void* d_ws, size_t ws_size, hipStream_t stream) {
    if (n_in != 37 || ws_size < WS_END2) { fprintf(stderr, "kernel_launch: unexpected n_in %d / ws %zu\n", n_in, ws_size); return; }
    if (!g_grid) {
        int dev = 0, cus = 0, per_cu = 0;
        hipGetDevice(&dev); hipDeviceGetAttribute(&cus, hipDeviceAttributeMultiprocessorCount, dev);
        hipFuncSetAttribute((const void*)mk_fwd, hipFuncAttributeMaxDynamicSharedMemorySize, LDS_BYTES);
        hipOccupancyMaxActiveBlocksPerMultiprocessor(&per_cu, (const void*)mk_fwd, 512, LDS_BYTES);
        if (per_cu < 1) { fprintf(stderr, "kernel_launch: occupancy query says %d blocks/CU\n", per_cu); per_cu = 1; }
        g_grid = cus * (per_cu > 1 ? 1 : per_cu);
    }
    const float* const* in = (const float* const*)d_in;
    Args a{};
    for (int i = 0; i < 37; ++i) a.in[i] = in[i];
    a.out = (float*)d_out; a.ws = (unsigned char*)d_ws;
    hipMemsetAsync((char*)d_ws + WS_BAR, 0, 32768, stream);
    launch_mk(a, 0, N_PHASES, stream);
}
```

```cpp
#include <hip/hip_runtime.h>
#include <cstdio>
#include <cstdint>

typedef _Float16 h16;

constexpr int D = 1024, NB = 8, S = 4096, M = NB * S, DEPTH = 2;
constexpr int HD = 64;
constexpr int C_ATT = 256, C_RW = 384, C_ML = 384;
constexpr int H_ATT = 4, H_RW = 6, H_ML = 6;
constexpr int NSA_IN = 652, RW_IN = 1408, ML_IN = 1548, D_IN = 3608;
constexpr int DFF = 2816;
constexpr int NCMP = 255, NSLC = 64;
constexpr int PITCH = 3296;
constexpr int PC_VC = 0, PC_KS = 64, PC_VS = 128, PC_KW = 192, PC_VW = 256;
constexpr int PC_R = 320, PC_K = 704, PC_V = 1088, PC_XW = 1472, PC_XA = 1536, PC_XG = 1600;
constexpr int PC_MQ = 1728, PC_MK = 2112, PC_MV = 2496, PC_MO = 2880;
constexpr int PC_GTS = 3264, PC_IG = 3276, PC_FG = 3282;
constexpr int QKP = 320;
constexpr float QSCALE_Q = 0.125f * 1.4426950408889634f;

constexpr size_t MiB = 1u << 20;
constexpr size_t WS_MOD = 0;
constexpr size_t WS_QK32 = 4 * MiB;
constexpr size_t WS_P16 = 44 * MiB;
constexpr size_t WS_H16 = 250 * MiB;
constexpr size_t WS_Y32 = 314 * MiB;
constexpr size_t WS_XB16 = 184 * MiB;
constexpr size_t WS_ACT = 4 * MiB;
constexpr size_t WS_END = 442 * MiB;

__device__ __forceinline__ float wave_sum(float v) {
#pragma unroll
    for (int o = 32; o > 0; o >>= 1) v += __shfl_xor(v, o);
    return v;
}
__device__ __forceinline__ float wave_max(float v) {
#pragma unroll
    for (int o = 32; o > 0; o >>= 1) v = fmaxf(v, __shfl_xor(v, o));
    return v;
}
__device__ __forceinline__ float sigmoidf_(float x) { return 1.f / (1.f + expf(-x)); }
__device__ __forceinline__ float siluf_(float x) { return x * sigmoidf_(x); }
__device__ __forceinline__ float softplusf_(float x) { return fmaxf(x, 0.f) + log1pf(expf(-fabsf(x))); }
__device__ __forceinline__ float gelu_tanh(float x) { return 0.5f * x * (1.f + tanhf(0.7978845608028654f * (x + 0.044715f * x * x * x))); }

#include <hip/hip_cooperative_groups.h>
namespace cg = cooperative_groups;

namespace pg8 {
#define PG8_LAS __attribute__((address_space(3)))
typedef short s16x8 __attribute__((ext_vector_type(8)));
typedef _Float16 f16x8 __attribute__((ext_vector_type(8)));
typedef float f32x4 __attribute__((ext_vector_type(4)));
typedef unsigned u32x4 __attribute__((ext_vector_type(4)));
typedef unsigned u32x2 __attribute__((ext_vector_type(2)));
constexpr int BM = 256, BK = 64, HALF = 128, HTB = HALF * BK * 2  , STAGE_BYTES = 8 * HTB, NXCD = 8, WGM = 8;

__host__ __device__ __forceinline__ int lds_byte(int r, int c) { const int st = (r >> 4) * 2 + (c >> 5), rr = r & 15, cc = c & 31, ob = rr * 64 + cc * 2; return st * 1024 + (ob ^ (((ob >> 9) & 1) << 5)); }
__host__ __device__ __forceinline__ void stage_rc(int b, int& R, int& C) { const int st = b / 1024, sb = b % 1024, swz = sb ^ (((sb >> 9) & 1) << 5); R = (st >> 1) * 16 + swz / 64; C = (st & 1) * 32 + (swz % 64) / 2; }
__host__ __device__ __forceinline__ int perm32(int rho) { const int n = rho >> 4, i = rho & 15; return 8 * (i >> 2) + 4 * n + (i & 3); }

struct Unit { int pm, pn; };
struct Gemm { const h16* A; const h16* Bt; int M, N, K; };

struct StaticOrder {
    int nM, nN, nwg, G, c;
    __host__ __device__ void init(int M, int N, int G_, int c_) { nM = M / BM; nN = N / BM; nwg = nM * nN; G = G_; c = c_; }
    __host__ __device__ bool next(int i, Unit& u) const {
        const long L = (long)i * G + c; if (L >= nwg) return false;
        int wgid = (int)L; { const int q = nwg / NXCD, r = nwg % NXCD, xcd = wgid % NXCD, off = wgid / NXCD; wgid = (xcd < r ? xcd * (q + 1) : r * (q + 1) + (xcd - r) * q) + off; }
        const int nig = WGM * nN, gid = wgid / nig, fm = gid * WGM, gsz = (nM - fm) < WGM ? (nM - fm) : WGM;
        u.pm = fm + ((wgid % nig) % gsz); u.pn = (wgid % nig) / gsz; return true;
    }
    __device__ __forceinline__ void a_ready(const Unit&) const {}
    __device__ __forceinline__ void done(const Unit&) const {}
};

__device__ __forceinline__ unsigned pk_f16(float lo, float hi) { typedef _Float16 h2 __attribute__((ext_vector_type(2))); h2 v = {(_Float16)lo, (_Float16)hi}; return __builtin_bit_cast(unsigned, v); }

struct EpiProj {
    static constexpr bool PERM = true, AFTER_DRAIN = false; static constexpr int NSTORE = 16;
    h16* QK; h16* P; h16* VT;
    __device__ __forceinline__ void operator()(const f32x4 (&acc)[2][2][4][2], const Unit& u, int wr, int wc, int fr, int fq) const {
        const int row0 = u.pm * BM + wr * 64 + fr;
#pragma unroll
        for (int bj = 0; bj < 2; ++bj) {
            const int colt = u.pn * BM + bj * HALF + wc * 32 + 8 * fq;
            if (colt < 320) {
                const float qs = colt < 256 ? QSCALE_Q : 1.f;
#pragma unroll
                for (int ai = 0; ai < 2; ++ai)
#pragma unroll
                    for (int m = 0; m < 4; ++m) { const f32x4 v0 = acc[ai][bj][m][0], v1 = acc[ai][bj][m][1];
                        u32x4 w; w.x = pk_f16(v0[0] * qs, v0[1] * qs); w.y = pk_f16(v0[2] * qs, v0[3] * qs); w.z = pk_f16(v1[0] * qs, v1[1] * qs); w.w = pk_f16(v1[2] * qs, v1[3] * qs);
                        *(u32x4*)(QK + (size_t)(row0 + ai * HALF + m * 16) * QKP + colt) = w; }
            } else if ((colt >= 448 && colt < 512) || (colt >= 576 && colt < 640)) {
                const int br = colt >= 576 ? 1 : 0, d0 = colt - (br ? 576 : 448);
#pragma unroll
                for (int ai = 0; ai < 2; ++ai)
#pragma unroll
                    for (int m = 0; m < 4; ++m) { const int row = row0 + ai * HALF + m * 16, bb = row / S, tl = row % S;
                        h16* vp = VT + (((size_t)bb * 2 + br) * 64 + d0) * S + tl;
#pragma unroll
                        for (int e = 0; e < 4; ++e) { vp[(size_t)e * S] = (h16)acc[ai][bj][m][0][e]; vp[(size_t)(4 + e) * S] = (h16)acc[ai][bj][m][1][e]; } }
            } else {
#pragma unroll
                for (int ai = 0; ai < 2; ++ai)
#pragma unroll
                    for (int m = 0; m < 4; ++m) { const f32x4 v0 = acc[ai][bj][m][0], v1 = acc[ai][bj][m][1];
                        u32x4 w; w.x = pk_f16(v0[0], v0[1]); w.y = pk_f16(v0[2], v0[3]); w.z = pk_f16(v1[0], v1[1]); w.w = pk_f16(v1[2], v1[3]);
                        *(u32x4*)(P + (size_t)(row0 + ai * HALF + m * 16) * PITCH + (colt - 320)) = w; }
            }
        }
    }
};
struct EpiF16 {
    static constexpr bool PERM = true, AFTER_DRAIN = false; static constexpr int NSTORE = 16;
    h16* C; int ldc;
    __device__ __forceinline__ void operator()(const f32x4 (&acc)[2][2][4][2], const Unit& u, int wr, int wc, int fr, int fq) const {
        const int row0 = u.pm * BM + wr * 64 + fr;
#pragma unroll
        for (int ai = 0; ai < 2; ++ai)
#pragma unroll
            for (int m = 0; m < 4; ++m)
#pragma unroll
                for (int bj = 0; bj < 2; ++bj) { const f32x4 v0 = acc[ai][bj][m][0], v1 = acc[ai][bj][m][1];
                    u32x4 w; w.x = pk_f16(v0[0], v0[1]); w.y = pk_f16(v0[2], v0[3]); w.z = pk_f16(v1[0], v1[1]); w.w = pk_f16(v1[2], v1[3]);
                    *(u32x4*)(C + (size_t)(row0 + ai * HALF + m * 16) * ldc + u.pn * BM + bj * HALF + wc * 32 + 8 * fq) = w; }
    }
};
struct EpiSwiglu {
    static constexpr bool PERM = true, AFTER_DRAIN = false; static constexpr int NSTORE = 8;
    h16* C; int ldc;
    __device__ __forceinline__ void operator()(const f32x4 (&acc)[2][2][4][2], const Unit& u, int wr, int wc, int fr, int fq) const {
        const int row0 = u.pm * BM + wr * 64 + fr;
#pragma unroll
        for (int ai = 0; ai < 2; ++ai)
#pragma unroll
            for (int m = 0; m < 4; ++m) { float o[8];
#pragma unroll
                for (int n = 0; n < 2; ++n)
#pragma unroll
                    for (int e = 0; e < 4; ++e) { const float gt = acc[ai][0][m][n][e]; o[4 * n + e] = gt * __builtin_amdgcn_rcpf(1.f + __expf(-gt)) * acc[ai][1][m][n][e]; }
                u32x4 w; w.x = pk_f16(o[0], o[1]); w.y = pk_f16(o[2], o[3]); w.z = pk_f16(o[4], o[5]); w.w = pk_f16(o[6], o[7]);
                *(u32x4*)(C + (size_t)(row0 + ai * HALF + m * 16) * ldc + u.pn * HALF + wc * 32 + 8 * fq) = w; }
    }
};

template <class Epi, class Sched, bool ALIGN_EPI = false, bool SP2 = false>
__device__ __forceinline__ void gemm_phase(PG8_LAS unsigned char* lds, const Gemm g, const Sched& S, const Epi& E) {
    int tid_ = threadIdx.x; asm volatile("" : "+v"(tid_)); const int tid = tid_, wid = __builtin_amdgcn_readfirstlane(tid >> 6), lane = tid & 63, wr = wid >> 2, wc = wid & 3, fr = lane & 15, fq = lane >> 4;
    const int K = g.K, nt = K / BK;
    unsigned voffA[2], voffB[2];
#pragma unroll
    for (int i = 0; i < 2; ++i) { int R, C; stage_rc(tid * 16 + i * 8192, R, C); const int Rb = Epi::PERM ? ((R & ~31) + perm32(R & 31)) : R;
        voffA[i] = (unsigned)(R * K + C) * 2u; voffB[i] = (unsigned)(Rb * K + C) * 2u; }
    const size_t kstep = (size_t)(BK * 2);
    const size_t hstep = (size_t)HALF * K * 2;
    const size_t tstep = 2 * hstep;
    const unsigned ldsw = (unsigned)wid * 1024u;
    const int aoff = lds_byte(wr * 64 + fr, fq * 8), boff = lds_byte(wc * 32 + fr, fq * 8);
#define PG8_SA(b, h) (((b) * 2 + (h)) * HTB)
#define PG8_SB(b, h) ((4 + (b) * 2 + (h)) * HTB)
#define PG8_STAGE(bufoff, gbase, voff) do { _Pragma("unroll") for (int _i = 0; _i < 2; ++_i) \
        __builtin_amdgcn_global_load_lds((const unsigned*)((const char*)(gbase) + (voff)[_i]), (PG8_LAS unsigned*)(lds + (bufoff) + ldsw + _i * 8192), 16, 0, 0); } while (0)
#define PG8_LDA(dst, b, h) do { _Pragma("unroll") for (int m = 0; m < 4; ++m) _Pragma("unroll") for (int k = 0; k < 2; ++k) dst[m][k] = *(const PG8_LAS s16x8*)(lds + PG8_SA(b, h) + aoff + m * 2048 + k * 1024); } while (0)
#define PG8_LDB(dst, b, h) do { _Pragma("unroll") for (int n = 0; n < 2; ++n) _Pragma("unroll") for (int k = 0; k < 2; ++k) dst[n][k] = *(const PG8_LAS s16x8*)(lds + PG8_SB(b, h) + boff + n * 2048 + k * 1024); } while (0)
#define PG8_MMA(ai, bj, At, Bt) do { __builtin_amdgcn_s_setprio(1); _Pragma("unroll") for (int m = 0; m < 4; ++m) _Pragma("unroll") for (int n = 0; n < 2; ++n) _Pragma("unroll") for (int k = 0; k < 2; ++k) \
        acc[ai][bj][m][n] = __builtin_amdgcn_mfma_f32_16x16x32_f16(__builtin_bit_cast(f16x8, Bt[n][k]), __builtin_bit_cast(f16x8, At[m][k]), acc[ai][bj][m][n], 0, 0, 0); __builtin_amdgcn_s_setprio(0); } while (0)
#define PG8_WAIT_V(n) asm volatile("s_waitcnt vmcnt(" #n ")" ::: "memory")
#define PG8_WAIT_VF(f, n) asm volatile("s_cmp_lg_u32 %0, 0\n\ts_cbranch_scc1 .Lpg8wv%=\n\ts_waitcnt vmcnt(8)\n.Lpg8wv%=:\n\ts_waitcnt vmcnt(%1)" :: "s"(f), "n"(n) : "memory", "scc")
#define PG8_WAIT_L(n) asm volatile("s_waitcnt lgkmcnt(" #n ")" ::: "memory")
#define PG8_BAR __builtin_amdgcn_s_barrier()
#define PG8_SCHED __builtin_amdgcn_sched_barrier(0)
    Unit cur, nxt; int ui = 0;
    if (!S.next(0, cur)) return;
    f32x4 acc[2][2][4][2];
#pragma unroll
    for (int a = 0; a < 2; ++a)
#pragma unroll
        for (int b = 0; b < 2; ++b)
#pragma unroll
            for (int m = 0; m < 4; ++m)
#pragma unroll
                for (int n = 0; n < 2; ++n) acc[a][b][m][n] = (f32x4){0.f, 0.f, 0.f, 0.f};
    s16x8 At[4][2], B0[2][2], B1[2][2];
    const char* cA = (const char*)g.A + (size_t)cur.pm * tstep; const char* cB = (const char*)g.Bt + (size_t)cur.pn * tstep;
    S.a_ready(cur);
    if constexpr (SP2) {
        PG8_STAGE(PG8_SB(0, 0), cB, voffB); PG8_STAGE(PG8_SB(0, 1), cB + hstep, voffB); PG8_STAGE(PG8_SA(0, 0), cA, voffA); PG8_STAGE(PG8_SA(0, 1), cA + hstep, voffA);
        if (wr == 1) PG8_BAR;
        PG8_WAIT_V(2); PG8_BAR;
        PG8_STAGE(PG8_SB(1, 0), cB + kstep, voffB); PG8_STAGE(PG8_SA(1, 0), cA + kstep, voffA); PG8_STAGE(PG8_SB(1, 1), cB + hstep + kstep, voffB);
        PG8_WAIT_V(6); PG8_BAR;
    } else {
        PG8_STAGE(PG8_SB(0, 0), cB, voffB); PG8_STAGE(PG8_SA(0, 0), cA, voffA); PG8_STAGE(PG8_SB(0, 1), cB + hstep, voffB); PG8_STAGE(PG8_SA(0, 1), cA + hstep, voffA);
        if (wr == 1) PG8_BAR;
        PG8_WAIT_V(4); PG8_BAR;
        PG8_STAGE(PG8_SB(1, 0), cB + kstep, voffB); PG8_STAGE(PG8_SA(1, 0), cA + kstep, voffA); PG8_STAGE(PG8_SB(1, 1), cB + hstep + kstep, voffB);
        PG8_WAIT_V(6); PG8_BAR;
    }
    for (;;) {
        const bool has_next = S.next(ui + 1, nxt);
        const char* nA = has_next ? (const char*)g.A + (size_t)nxt.pm * tstep : cA; const char* nB = has_next ? (const char*)g.Bt + (size_t)nxt.pn * tstep : cB;
        for (int t = 0; t < nt; t += 2) {
            const bool last = (t == nt - 2);
            const char* a1 = cA + (size_t)(t + 1) * kstep;
            const char* a2 = last ? nA : cA + (size_t)(t + 2) * kstep; const char* b2 = last ? nB : cB + (size_t)(t + 2) * kstep;
            const char* a3 = a2 + kstep; const char* b3 = b2 + kstep;
            if (last && has_next) S.a_ready(nxt);
            const int fe = __builtin_amdgcn_readfirstlane(((t == 0) && (ui > 0)) ? 1 : 0);
            if constexpr (SP2) {
            PG8_LDB(B0, 0, 0); PG8_LDB(B1, 0, 1); PG8_SCHED; PG8_LDA(At, 0, 0); PG8_STAGE(PG8_SA(1, 1), a1 + hstep, voffA);
            PG8_WAIT_VF(fe, 8 + Epi::NSTORE); PG8_WAIT_L(0); PG8_BAR; PG8_MMA(0, 0, At, B0); PG8_MMA(0, 1, At, B1); PG8_BAR; PG8_SCHED;
            PG8_LDA(At, 0, 1); PG8_STAGE(PG8_SB(0, 0), b2, voffB); PG8_STAGE(PG8_SB(0, 1), b2 + hstep, voffB); PG8_STAGE(PG8_SA(0, 0), a2, voffA);
            PG8_WAIT_VF(fe, 8 + Epi::NSTORE); PG8_WAIT_L(0); PG8_BAR; PG8_MMA(1, 0, At, B0); PG8_MMA(1, 1, At, B1); PG8_BAR; PG8_SCHED;
            PG8_LDB(B0, 1, 0); PG8_LDB(B1, 1, 1); PG8_SCHED; PG8_LDA(At, 1, 0); PG8_STAGE(PG8_SA(0, 1), a2 + hstep, voffA);
            PG8_WAIT_V(8); PG8_WAIT_L(0); PG8_BAR; PG8_MMA(0, 0, At, B0); PG8_MMA(0, 1, At, B1); PG8_BAR; PG8_SCHED;
            PG8_LDA(At, 1, 1); PG8_STAGE(PG8_SB(1, 0), b3, voffB); PG8_STAGE(PG8_SB(1, 1), b3 + hstep, voffB); PG8_STAGE(PG8_SA(1, 0), a3, voffA);
            PG8_WAIT_V(8); PG8_WAIT_L(0); PG8_BAR; PG8_MMA(1, 0, At, B0); PG8_MMA(1, 1, At, B1); PG8_BAR; PG8_SCHED;
            } else {
            PG8_LDB(B0, 0, 0); PG8_SCHED; PG8_LDA(At, 0, 0); PG8_STAGE(PG8_SA(1, 1), a1 + hstep, voffA);
            PG8_WAIT_L(8); PG8_BAR; PG8_WAIT_L(0); PG8_MMA(0, 0, At, B0); PG8_BAR; PG8_SCHED;
            PG8_LDB(B1, 0, 1); PG8_STAGE(PG8_SB(0, 0), b2, voffB);
            PG8_BAR; PG8_WAIT_L(0); PG8_MMA(0, 1, At, B1); PG8_BAR;
            PG8_LDA(At, 0, 1); PG8_STAGE(PG8_SA(0, 0), a2, voffA);
            PG8_BAR; PG8_WAIT_L(0); PG8_MMA(1, 0, At, B0); PG8_BAR; PG8_SCHED;
            PG8_STAGE(PG8_SB(0, 1), b2 + hstep, voffB);
            PG8_WAIT_V(6); PG8_BAR; PG8_MMA(1, 1, At, B1); PG8_BAR;
            PG8_LDB(B0, 1, 0); PG8_SCHED; PG8_LDA(At, 1, 0); PG8_STAGE(PG8_SA(0, 1), a2 + hstep, voffA);
            PG8_WAIT_L(8); PG8_BAR; PG8_WAIT_L(0); PG8_MMA(0, 0, At, B0); PG8_BAR; PG8_SCHED;
            PG8_LDB(B1, 1, 1); PG8_STAGE(PG8_SB(1, 0), b3, voffB);
            PG8_BAR; PG8_WAIT_L(0); PG8_MMA(0, 1, At, B1); PG8_BAR;
            PG8_LDA(At, 1, 1); PG8_STAGE(PG8_SA(1, 0), a3, voffA);
            PG8_BAR; PG8_WAIT_L(0); PG8_MMA(1, 0, At, B0); PG8_BAR; PG8_SCHED;
            PG8_STAGE(PG8_SB(1, 1), b3 + hstep, voffB);
            PG8_WAIT_V(6); PG8_BAR; PG8_MMA(1, 1, At, B1); PG8_BAR;
            }
        }
        if constexpr (ALIGN_EPI) { if (wr == 0) PG8_BAR; }
        if constexpr (!Epi::AFTER_DRAIN) { E(acc, cur, wr, wc, fr, fq); S.done(cur); }
        if (!has_next) break;
#pragma unroll
        for (int a = 0; a < 2; ++a)
#pragma unroll
            for (int b = 0; b < 2; ++b)
#pragma unroll
                for (int m = 0; m < 4; ++m)
#pragma unroll
                    for (int n = 0; n < 2; ++n) acc[a][b][m][n] = (f32x4){0.f, 0.f, 0.f, 0.f};
        cur = nxt; cA = nA; cB = nB; ++ui;
        if constexpr (ALIGN_EPI) { if (wr == 1) PG8_BAR; }
    }
    PG8_WAIT_V(0);
    if constexpr (!ALIGN_EPI) { if (wr == 0) PG8_BAR; }
    PG8_BAR;
#undef PG8_SA
#undef PG8_SB
#undef PG8_STAGE
#undef PG8_LDA
#undef PG8_LDB
#undef PG8_MMA
#undef PG8_WAIT_V
#undef PG8_WAIT_VF
#undef PG8_WAIT_L
#undef PG8_BAR
#undef PG8_SCHED
}
}
constexpr size_t WS_WIN = 442 * MiB;
constexpr size_t WS_WOUT = 457 * MiB;
constexpr size_t WS_W1 = 461 * MiB;
constexpr size_t WS_W2 = 483 * MiB;
constexpr size_t WS_VTG = 496 * MiB;
constexpr size_t WS_CW16 = 509 * MiB;
constexpr size_t WS_END2 = 510 * MiB;
constexpr size_t WS_CBIAS = 512 * 1024;
constexpr size_t WS_KC16 = 1 * MiB;
constexpr size_t WS_VC16 = 1 * MiB + 512 * 1024;
constexpr size_t WS_W1C = 3 * MiB;
constexpr size_t WS_LRW0 = 2 * MiB;
constexpr int LRW_L0 = 384 * 64 * 2 + 384 * 128;
constexpr int NIN_PAD = 3584, NFF2 = 2 * DFF;
constexpr size_t WS_WSM = 508 * MiB;
constexpr int LDS_BYTES = 163840;
constexpr size_t WS_BAR = 400 * 1024;
constexpr int L_BARST = LDS_BYTES - 16;
constexpr size_t WS_QCTR = WS_BAR + 14336;
constexpr int L_QSLOT = LDS_BYTES - 32;
#define LAS __attribute__((address_space(3)))

struct Args { const float* in[37]; float* out; unsigned char* ws; int ph_lo, ph_hi; };

__device__ __forceinline__ int win_src_col(int nd) {
    if (nd < 320) return nd;
    const int c = nd - 320;
    if (c < 320) return c + 320;
    if (c < 3264) return c + 332;
    if (c < 3276) return c - 2624;
    if (c < 3288) return c + 320;
    return -1;
}
__device__ __forceinline__ int wsm_src_col(int r) { return r < 12 ? 640 + r : (r < 18 ? 3596 + (r - 12) : (r < 24 ? 3602 + (r - 18) : -1)); }
__device__ __forceinline__ void transpose_item(const float* cp, int ns, int K, h16* WT, int k0, int n0, LAS float* scr, int lane) {
    float tv[32];
#pragma unroll
    for (int i = 0; i < 32; ++i) { const int kk = 2 * i + (lane >> 5); tv[i] = cp ? __builtin_nontemporal_load(cp + (size_t)(k0 + kk) * ns) : 0.f; }
#pragma unroll
    for (int i = 0; i < 32; ++i) { const int kk = 2 * i + (lane >> 5); scr[kk * 33 + (lane & 31)] = tv[i]; }
    asm volatile("s_waitcnt lgkmcnt(0)" ::: "memory");
    const int c = lane & 7;
#pragma unroll
    for (int j = 0; j < 4; ++j) { const int n = (lane >> 3) + 8 * j; const LAS float* s = scr + (8 * c) * 33 + n;
        pg8::u32x4 o; o.x = pg8::pk_f16(s[0 * 33], s[1 * 33]); o.y = pg8::pk_f16(s[2 * 33], s[3 * 33]); o.z = pg8::pk_f16(s[4 * 33], s[5 * 33]); o.w = pg8::pk_f16(s[6 * 33], s[7 * 33]);
        *(pg8::u32x4*)(WT + (size_t)(n0 + n) * K + k0 + 8 * c) = o; }
    asm volatile("s_waitcnt lgkmcnt(0)" ::: "memory");
}

__device__ __forceinline__ void prologue_weights(const Args& a, LAS unsigned char* lds, int part) {
    int tid_ = threadIdx.x; asm volatile("" : "+v"(tid_)); const int tid = tid_, lane = tid & 63, wave = __builtin_amdgcn_readfirstlane(tid >> 6);
    const int G = gridDim.x, gw = blockIdx.x * 8 + wave, NGW = G * 8;
    LAS float* scr = (LAS float*)(lds + wave * 16384);
    constexpr int I_IN = 16 * (NIN_PAD / 32), I_OUT = 16 * 32, I_W1 = 16 * (NFF2 / 32), I_W2 = (DFF / 64) * 32, I_L = I_IN + I_OUT + I_W1 + I_W2;
    for (int it = gw; it < 2 * I_L; it += NGW) {
        const int l = it / I_L; int r = it % I_L;
        if ((part == 0) != (l == 0 && r < I_IN)) continue;
        if (r < I_IN) { const int nblk = NIN_PAD / 32, kb = r / nblk, nb = r % nblk; const int sc = win_src_col(nb * 32 + (lane & 31));
            transpose_item(sc >= 0 ? a.in[8] + (size_t)l * D * D_IN + sc : nullptr, D_IN, D, (h16*)(a.ws + WS_WIN) + (size_t)l * NIN_PAD * D, kb * 64, nb * 32, scr, lane); continue; }
        r -= I_IN;
        if (r < I_OUT) { const int kb = r / 32, nb = r % 32;
            transpose_item(a.in[9] + (size_t)l * D * D + nb * 32 + (lane & 31), D, D, (h16*)(a.ws + WS_WOUT) + (size_t)l * D * D, kb * 64, nb * 32, scr, lane); continue; }
        r -= I_OUT;
        if (r < I_W1) { const int nblk = NFF2 / 32, kb = r / nblk, nb = r % nblk; const int nd = nb * 32 + (lane & 31);
            const float* src = (((nd >> 7) & 1) ? a.in[35] : a.in[34]) + (size_t)l * D * DFF + (128 * (nd >> 8) + (nd & 127));
            transpose_item(src, DFF, D, (h16*)(a.ws + WS_W1) + (size_t)l * NFF2 * D, kb * 64, nb * 32, scr, lane); continue; }
        r -= I_W1;
        { const int kb = r / 32, nb = r % 32;
            transpose_item(a.in[36] + (size_t)l * DFF * D + nb * 32 + (lane & 31), D, DFF, (h16*)(a.ws + WS_W2) + (size_t)l * D * DFF, kb * 64, nb * 32, scr, lane); }
    }
}
__device__ __forceinline__ void phase_prologue(const Args& a, LAS unsigned char* lds) {
    int tid_ = threadIdx.x; asm volatile("" : "+v"(tid_)); const int tid = tid_, lane = tid & 63, wave = __builtin_amdgcn_readfirstlane(tid >> 6);
    const int G = gridDim.x, gw = blockIdx.x * 8 + wave, NGW = G * 8;
    LAS float* scr = (LAS float*)(lds + wave * 16384);
    prologue_weights(a, lds, 0);
    for (int i = blockIdx.x * 512 + tid; i < 2 * 5 * 768; i += G * 512) {
        const int l = i / 3840, r = i % 3840; ((h16*)(a.ws + WS_CW16))[i] = (h16)(r < 3072 ? a.in[29][l * 3072 + r] : a.in[30][l * 768 + (r - 3072)]); }
    for (int it = gw; it < 2 * 16; it += NGW) {
        const int l = it >> 4, kb = it & 15; const int sc = wsm_src_col(lane & 31);
        transpose_item(sc >= 0 ? a.in[8] + (size_t)l * D * D_IN + sc : nullptr, D_IN, D, (h16*)(a.ws + WS_WSM) + (size_t)l * 32 * D, kb * 64, 0, scr, lane); }
    for (int it = gw; it < 4 * 64; it += NGW) {
        const int mat = it >> 6, r = it & 63, l = mat >> 1, kv = mat & 1, kb = r >> 1, nb = r & 1;
        transpose_item((kv ? a.in[14] : a.in[12]) + (size_t)l * 2048 * 64 + nb * 32 + (lane & 31), 64, 2048, (h16*)(a.ws + WS_W1C) + (size_t)mat * 64 * 2048, kb * 64, nb * 32, scr, lane);
    }
    for (int it = gw; it < 2 * 48; it += NGW) {
        const int l = it / 48, r = it % 48;
        h16* dst = (h16*)(a.ws + WS_LRW0) + (size_t)l * LRW_L0;
        if (r < 12) transpose_item(a.in[20] + (size_t)l * 64 * C_RW + r * 32 + (lane & 31), C_RW, 64, dst, 0, r * 32, scr, lane);
        else if (r < 24) transpose_item(a.in[22] + (size_t)l * 64 * C_RW + (r - 12) * 32 + (lane & 31), C_RW, 64, dst + 384 * 64, 0, (r - 12) * 32, scr, lane);
        else { const int kb = (r - 24) / 12, nb = (r - 24) % 12; transpose_item(a.in[23] + (size_t)l * 128 * C_RW + nb * 32 + (lane & 31), C_RW, 128, dst + 2 * 384 * 64, kb * 64, nb * 32, scr, lane); }
    }
    if (blockIdx.x >= G - 4) {
        const int u = G - 1 - (int)blockIdx.x, l = u >> 1, kv = u & 1; const float* pe = (kv ? a.in[11] : a.in[10]) + l * 2048 + wave * 256; const float* w1 = (kv ? a.in[14] : a.in[12]) + (size_t)l * 2048 * 64 + (size_t)wave * 256 * 64 + lane;
        float sacc = 0.f;
#pragma unroll 1
        for (int k = 0; k < 256; k += 16) { float wv[16];
#pragma unroll
            for (int j = 0; j < 16; ++j) wv[j] = w1[(size_t)(k + j) * 64];
#pragma unroll
            for (int j = 0; j < 16; ++j) sacc += pe[k + j] * wv[j]; }
        LAS float* bred = (LAS float*)(lds + 8 * 16384);
        bred[wave * 64 + lane] = sacc;
        __syncthreads();
        if (wave == 0) { float t = 0.f;
#pragma unroll
            for (int j = 0; j < 8; ++j) t += bred[j * 64 + lane];
            ((float*)(a.ws + WS_CBIAS))[u * 64 + lane] = t; }
    }
    __syncthreads();
    LAS float* cs = (LAS float*)lds;
    LAS float* red = (LAS float*)(lds + 32768);
    for (int i = tid; i < NB * D; i += 512) { const float v = a.in[1][i]; cs[i] = v / (1.f + __expf(-v)); }
    __syncthreads();
    float* MOD = (float*)(a.ws + WS_MOD);
    for (int u = blockIdx.x; u < 2 * 96; u += G) {
        const int l = u / 96, col = (u % 96) * 64 + (tid & 63), ks = tid >> 6;
        const float* w = a.in[2] + (size_t)l * D * 6 * D + col;
        float acc[8];
#pragma unroll
        for (int b = 0; b < 8; ++b) acc[b] = 0.f;
#pragma unroll 1
        for (int k = ks * 128; k < ks * 128 + 128; k += 16) { float wv[16];
#pragma unroll
            for (int j = 0; j < 16; ++j) wv[j] = w[(size_t)(k + j) * 6 * D];
#pragma unroll
            for (int j = 0; j < 16; ++j)
#pragma unroll
                for (int b = 0; b < 8; ++b) acc[b] += cs[b * D + k + j] * wv[j]; }
#pragma unroll
        for (int b = 0; b < 8; ++b) red[(ks * 8 + b) * 64 + (tid & 63)] = acc[b];
        __syncthreads();
        { const int b = tid >> 6; float s = a.in[3][l * 6 * D + col];
#pragma unroll
          for (int k2 = 0; k2 < 8; ++k2) s += red[(k2 * 8 + b) * 64 + (tid & 63)];
          MOD[((size_t)l * NB + b) * 6 * D + col] = s; }
        __syncthreads();
    }
}

template <bool XH> struct XRaw;
template <> struct XRaw<false> { pg8::f32x4 x[2][2]; };
template <> struct XRaw<true> { pg8::u32x4 x[2]; };
__device__ __forceinline__ void x_load(XRaw<false>& R, const void* base, size_t off) {
#pragma unroll
    for (int j = 0; j < 2; ++j) { const float* p = (const float*)base + off + j * 512; R.x[j][0] = __builtin_nontemporal_load((const pg8::f32x4*)p); R.x[j][1] = __builtin_nontemporal_load((const pg8::f32x4*)(p + 4)); }
}
__device__ __forceinline__ void x_load(XRaw<true>& R, const void* base, size_t off) {
#pragma unroll
    for (int j = 0; j < 2; ++j) R.x[j] = __builtin_nontemporal_load((const pg8::u32x4*)((const h16*)base + off + j * 512));
}
__device__ __forceinline__ float h_lo(unsigned w) { return (float)__builtin_bit_cast(_Float16, (unsigned short)(w & 0xffffu)); }
__device__ __forceinline__ float h_hi(unsigned w) { return (float)__builtin_bit_cast(_Float16, (unsigned short)(w >> 16)); }
__device__ __forceinline__ void h_unpack(const pg8::u32x4 w, float (&o)[8]) { o[0] = h_lo(w.x); o[1] = h_hi(w.x); o[2] = h_lo(w.y); o[3] = h_hi(w.y); o[4] = h_lo(w.z); o[5] = h_hi(w.z); o[6] = h_lo(w.w); o[7] = h_hi(w.w); }
__device__ __forceinline__ void x_unpack(const XRaw<false>& R, int j, float (&o)[8]) {
#pragma unroll
    for (int e = 0; e < 4; ++e) { o[e] = R.x[j][0][e]; o[4 + e] = R.x[j][1][e]; } }
__device__ __forceinline__ void x_unpack(const XRaw<true>& R, int j, float (&o)[8]) { h_unpack(R.x[j], o); }
template <bool XI, bool HASY> struct PostRaw { XRaw<XI> x; pg8::u32x4 y[2]; };
template <bool XI, bool HASY>
__device__ __forceinline__ void post_load(PostRaw<XI, HASY>& R, const void* xold, const h16* y, int tok, int lane) {
    const size_t off = (size_t)tok * D + lane * 8;
    if constexpr (HASY) {
#pragma unroll
        for (int j = 0; j < 2; ++j) R.y[j] = __builtin_nontemporal_load((const pg8::u32x4*)(y + off + j * 512)); }
    x_load(R.x, xold, off);
}
template <bool XI, bool XO, bool HASY, bool HASH>
__device__ __forceinline__ void post_row(const PostRaw<XI, HASY>& R, int tok, int lane, const float (&pa)[2][8], const float (&pb)[2][8], const float (&pc)[2][8], void* xnew, h16* H) {
    float v[2][8]; float s2 = 0.f;
    if constexpr (HASY) {
        float ss = 0.f;
#pragma unroll
        for (int j = 0; j < 2; ++j) { h_unpack(R.y[j], v[j]);
#pragma unroll
            for (int e = 0; e < 8; ++e) ss += v[j][e] * v[j][e]; }
        const float rstd = rsqrtf(wave_sum(ss) * (1.f / D) + 1e-6f);
#pragma unroll
        for (int j = 0; j < 2; ++j) { float xo[8]; x_unpack(R.x, j, xo);
#pragma unroll
            for (int e = 0; e < 8; ++e) { v[j][e] = xo[e] + pa[j][e] * (v[j][e] * rstd); s2 += v[j][e] * v[j][e]; }
            const size_t off = (size_t)tok * D + j * 512 + lane * 8;
            if constexpr (XO) { pg8::u32x4 w; w.x = pg8::pk_f16(v[j][0], v[j][1]); w.y = pg8::pk_f16(v[j][2], v[j][3]); w.z = pg8::pk_f16(v[j][4], v[j][5]); w.w = pg8::pk_f16(v[j][6], v[j][7]); *(pg8::u32x4*)((h16*)xnew + off) = w; }
            else { *(pg8::f32x4*)((float*)xnew + off) = (pg8::f32x4){v[j][0], v[j][1], v[j][2], v[j][3]}; *(pg8::f32x4*)((float*)xnew + off + 4) = (pg8::f32x4){v[j][4], v[j][5], v[j][6], v[j][7]}; } }
    } else {
#pragma unroll
        for (int j = 0; j < 2; ++j) { x_unpack(R.x, j, v[j]);
#pragma unroll
            for (int e = 0; e < 8; ++e) s2 += v[j][e] * v[j][e]; }
    }
    if constexpr (HASH) {
        const float r2 = rsqrtf(wave_sum(s2) * (1.f / D) + 1e-6f);
#pragma unroll
        for (int j = 0; j < 2; ++j) { pg8::u32x4 w;
            w.x = pg8::pk_f16(v[j][0] * r2 * pb[j][0] + pc[j][0], v[j][1] * r2 * pb[j][1] + pc[j][1]); w.y = pg8::pk_f16(v[j][2] * r2 * pb[j][2] + pc[j][2], v[j][3] * r2 * pb[j][3] + pc[j][3]);
            w.z = pg8::pk_f16(v[j][4] * r2 * pb[j][4] + pc[j][4], v[j][5] * r2 * pb[j][5] + pc[j][5]); w.w = pg8::pk_f16(v[j][6] * r2 * pb[j][6] + pc[j][6], v[j][7] * r2 * pb[j][7] + pc[j][7]);
            *(pg8::u32x4*)(H + (size_t)tok * D + j * 512 + lane * 8) = w; }
    }
}
template <bool XI, bool XO, bool HASY, bool HASH, int G>
__device__ __forceinline__ void phase_post(const void* xold, const h16* y, const float* gpost, const float* modl, int gt_off, void* xnew,
                                           const float* gnext, const float* modn, int sh_off, int sc_off, h16* H) {
    int tid_ = threadIdx.x; asm volatile("" : "+v"(tid_)); const int lane = tid_ & 63, gw = blockIdx.x * 8 + (tid_ >> 6), NGW = gridDim.x * 8;
    constexpr int CH = 16;
    static_assert(S % CH == 0 && CH % (2 * G) == 0, "chunking");
    for (int ch = gw; ch < M / CH; ch += NGW) {
        const int tok0 = ch * CH, b = tok0 / S;
        float pa[2][8], pb[2][8], pc[2][8];
#pragma unroll
        for (int j = 0; j < 2; ++j) { const int cc = j * 512 + lane * 8;
#pragma unroll
            for (int hf = 0; hf < 2; ++hf) {
                if constexpr (HASY) { const pg8::f32x4 gp = *(const pg8::f32x4*)(gpost + cc + 4 * hf), gt = *(const pg8::f32x4*)(modl + (size_t)b * 6 * D + gt_off + cc + 4 * hf);
#pragma unroll
                    for (int e = 0; e < 4; ++e) pa[j][4 * hf + e] = gt[e] * gp[e]; }
                if constexpr (HASH) { const float* mn = modn + (size_t)b * 6 * D;
                    const pg8::f32x4 gg = *(const pg8::f32x4*)(gnext + cc + 4 * hf), sc = *(const pg8::f32x4*)(mn + sc_off + cc + 4 * hf), sh = *(const pg8::f32x4*)(mn + sh_off + cc + 4 * hf);
#pragma unroll
                    for (int e = 0; e < 4; ++e) { pb[j][4 * hf + e] = gg[e] * (1.f + sc[e]); pc[j][4 * hf + e] = sh[e]; } }
            } }
        PostRaw<XI, HASY> R0[G], R1[G];
#pragma unroll
        for (int t = 0; t < G; ++t) post_load<XI, HASY>(R0[t], xold, y, tok0 + t, lane);
#pragma unroll 1
        for (int g = 0; g < CH / G; g += 2) {
#pragma unroll
            for (int t = 0; t < G; ++t) post_load<XI, HASY>(R1[t], xold, y, tok0 + (g + 1) * G + t, lane);
#pragma unroll
            for (int t = 0; t < G; ++t) { post_row<XI, XO, HASY, HASH>(R0[t], tok0 + g * G + t, lane, pa, pb, pc, xnew, H); }
            if (g + 2 < CH / G) {
#pragma unroll
                for (int t = 0; t < G; ++t) post_load<XI, HASY>(R0[t], xold, y, tok0 + (g + 2) * G + t, lane); }
#pragma unroll
            for (int t = 0; t < G; ++t) { post_row<XI, XO, HASY, HASH>(R1[t], tok0 + (g + 1) * G + t, lane, pa, pb, pc, xnew, H); }
        }
    }
}

namespace nsa {
typedef _Float16 f16x8 __attribute__((ext_vector_type(8)));
typedef _Float16 f16x4 __attribute__((ext_vector_type(4)));
typedef float f32x4 __attribute__((ext_vector_type(4)));
typedef unsigned u32x4 __attribute__((ext_vector_type(4)));
typedef unsigned u32x2 __attribute__((ext_vector_type(2)));
constexpr int KP = 72;
constexpr int L_KT = 0, L_VT = 36864  , L_OF = 73728, L_IMPA = L_OF  , L_IMPB = L_OF + 64 * 65 * 4, L_MASK = L_OF + 65536, L_END = L_MASK + 512;
static_assert(2 * 64 * 65 * 4 <= 65536 && L_END <= 163840 - 64, "NSA LDS map");
constexpr float QSCALE = 0.125f * 1.4426950408889634f;

struct TileRegs { u32x4 k, v; };
__device__ __forceinline__ TileRegs tile_load(const h16* kbase, int kp, const h16* vbase, int vp, int tid) {
    TileRegs r;
    r.k = *(const u32x4*)(kbase + (size_t)(tid >> 3) * kp + 8 * (tid & 7));
    r.v = *(const u32x4*)(vbase + (size_t)(tid >> 3) * vp + 8 * (tid & 7));
    return r;
}
__device__ __forceinline__ void tile_store(LAS unsigned char* lds, int buf  , const TileRegs& r, int tid) {
    LAS h16* kt = (LAS h16*)(lds + L_KT) + buf * 64 * KP;
    *(LAS u32x4*)(kt + (tid >> 3) * KP + 8 * (tid & 7)) = r.k;
    LAS h16* vt = (LAS h16*)(lds + L_VT) + buf * 64 * KP;
    *(LAS u32x4*)(vt + (tid >> 3) * KP + 8 * (tid & 7)) = r.v;
}
__device__ __forceinline__ void tile_load_async(TileRegs& r, const h16* kbase, int kp, const h16* vbase, int vp, int tid) {
    const h16* ka = kbase + (size_t)(tid >> 3) * kp + 8 * (tid & 7); const h16* va = vbase + (size_t)(tid >> 3) * vp + 8 * (tid & 7);
    asm volatile("global_load_dwordx4 %0, %1, off" : "=v"(r.k) : "v"(ka) : "memory");
    asm volatile("global_load_dwordx4 %0, %1, off" : "=v"(r.v) : "v"(va) : "memory");
}
template <int N> __device__ __forceinline__ void tile_wait(TileRegs& r) {
    if (N == 2) asm volatile("s_waitcnt vmcnt(2)" : "+v"(r.k), "+v"(r.v) :: "memory"); else asm volatile("s_waitcnt vmcnt(0)" : "+v"(r.k), "+v"(r.v) :: "memory");
}
__device__ __forceinline__ float max_x16(float v) { return fmaxf(v, __shfl_xor(v, 16)); }
__device__ __forceinline__ float max_x32(float v) { return fmaxf(v, __shfl_xor(v, 32)); }
__device__ __forceinline__ float sum_x16(float v) { return v + __shfl_xor(v, 16); }
__device__ __forceinline__ float sum_x32(float v) { return v + __shfl_xor(v, 32); }
template <int CTRL> __device__ __forceinline__ float dpp_mv(float v) { return __builtin_bit_cast(float, __builtin_amdgcn_update_dpp(0, __builtin_bit_cast(int, v), CTRL, 0xF, 0xF, true)); }
__device__ __forceinline__ float sum_quad(float v) { v += __shfl_xor(v, 1); v += __shfl_xor(v, 2); return v; }
__device__ __forceinline__ f32x4 mfma16(f16x8 a, f16x8 b, f32x4 c) { return __builtin_amdgcn_mfma_f32_16x16x32_f16(a, b, c, 0, 0, 0); }

template <int QL, int QH>
__device__ __forceinline__ void qk_tiles(const LAS h16* kt_lds, const f16x8 (&qf)[2][2], int c, int g, f32x4 (&sc)[2][4]) {
    f16x8 kf[4][2];
#pragma unroll
    for (int kt = 0; kt < 4; ++kt) { kf[kt][0] = *(const LAS f16x8*)(kt_lds + (16 * kt + c) * KP + 8 * g); kf[kt][1] = *(const LAS f16x8*)(kt_lds + (16 * kt + c) * KP + 32 + 8 * g); }
#pragma unroll
    for (int kt = 0; kt < 4; ++kt)
#pragma unroll
        for (int qi = QL; qi < QH; ++qi) { f32x4 a = {0.f, 0.f, 0.f, 0.f}; a = mfma16(kf[kt][0], qf[qi][0], a); a = mfma16(kf[kt][1], qf[qi][1], a); sc[qi][kt] = a; }
}
template <int QL, int QH>
__device__ __forceinline__ void pv_tiles(const LAS h16* vt_lds, const f32x4 (&p)[2][4], int c, int g, f32x4 (&o)[4][2]) {
    f16x4 vlo[2][4], vhi[2][4];
#pragma unroll
    for (int kk = 0; kk < 2; ++kk)
#pragma unroll
        for (int dt = 0; dt < 4; ++dt) { vlo[kk][dt] = *(const LAS f16x4*)(vt_lds + (16 * dt + c) * KP + 32 * kk + 4 * g); vhi[kk][dt] = *(const LAS f16x4*)(vt_lds + (16 * dt + c) * KP + 32 * kk + 16 + 4 * g); }
#pragma unroll
    for (int kk = 0; kk < 2; ++kk) {
        f16x8 bf[2];
#pragma unroll
        for (int qi = QL; qi < QH; ++qi) { const f32x4 a = p[qi][2 * kk], b = p[qi][2 * kk + 1];
            bf[qi] = (f16x8){(_Float16)a[0], (_Float16)a[1], (_Float16)a[2], (_Float16)a[3], (_Float16)b[0], (_Float16)b[1], (_Float16)b[2], (_Float16)b[3]}; }
#pragma unroll
        for (int dt = 0; dt < 4; ++dt) {
            const f16x4 v0 = vlo[kk][dt], v1 = vhi[kk][dt];
            const f16x8 a = (f16x8){v0[0], v0[1], v0[2], v0[3], v1[0], v1[1], v1[2], v1[3]};
#pragma unroll
            for (int qi = QL; qi < QH; ++qi) o[dt][qi] = mfma16(a, bf[qi], o[dt][qi]);
        }
    }
}
__device__ __forceinline__ void apply_mask(f32x4 (&sc)[4], int mode, int lim) {
    if (mode == 1) {
#pragma unroll
        for (int kt = 0; kt < 4; ++kt)
#pragma unroll
            for (int r = 0; r < 4; ++r) sc[kt][r] = (16 * kt + r <= lim) ? sc[kt][r] : -1e30f;
    } else if (mode == 2) {
#pragma unroll
        for (int kt = 0; kt < 4; ++kt)
#pragma unroll
            for (int r = 0; r < 4; ++r) sc[kt][r] = (16 * kt + r > lim) ? sc[kt][r] : -1e30f;
    }
}
typedef float f32x2 __attribute__((ext_vector_type(2)));
__device__ __forceinline__ float max3f(float a, float b, float c) { float r; asm("v_max3_f32 %0, %1, %2, %3" : "=v"(r) : "v"(a), "v"(b), "v"(c)); return r; }
__device__ __forceinline__ void softmax_step(f32x4 (&sc)[4], bool row_on, float& m, float& l, float& f_out) {
    float mx = max3f(sc[0][0], sc[0][1], sc[0][2]);
    mx = max3f(mx, sc[0][3], sc[1][0]); mx = max3f(mx, sc[1][1], sc[1][2]); mx = max3f(mx, sc[1][3], sc[2][0]); mx = max3f(mx, sc[2][1], sc[2][2]);
    mx = max3f(mx, sc[2][3], sc[3][0]); mx = max3f(mx, sc[3][1], sc[3][2]); mx = fmaxf(mx, sc[3][3]);
    mx = row_on ? mx : -1e30f;
    mx = max_x16(mx); mx = max_x32(mx);
    const float mn = fmaxf(m, mx), f = __builtin_amdgcn_exp2f(m - mn), mu = row_on ? fmaxf(mn, -1e20f) : 1e30f;
    const f32x2 mu2 = {mu, mu};
    f32x2 sum2 = {0.f, 0.f};
#pragma unroll
    for (int kt = 0; kt < 4; ++kt) {
        f32x2 a = (f32x2){sc[kt][0], sc[kt][1]} - mu2, b = (f32x2){sc[kt][2], sc[kt][3]} - mu2;
        a.x = __builtin_amdgcn_exp2f(a.x); a.y = __builtin_amdgcn_exp2f(a.y); b.x = __builtin_amdgcn_exp2f(b.x); b.y = __builtin_amdgcn_exp2f(b.y);
        sc[kt] = (f32x4){a.x, a.y, b.x, b.y}; sum2 = sum2 + a; sum2 = sum2 + b;
    }
    l = l * f + (sum2.x + sum2.y); m = mn; f_out = f;
}

struct AttnArgs { const h16* QK32; const h16* P16; const h16* KC; const h16* VCT;   const h16* VTG;   const float* gate_b; const float* out_g; h16* O16; };

__device__ __forceinline__ void attn_item(const AttnArgs& A, int b, int qt, LAS unsigned char* lds) {
    int tid_ = threadIdx.x; asm volatile("" : "+v"(tid_)); const int tid = tid_, lane = tid & 63, w = tid >> 6, c = lane & 15, g = lane >> 4;
    const size_t tok0 = (size_t)b * S + 64 * qt;
    LAS float* impa = (LAS float*)(lds + L_IMPA); LAS float* impb = (LAS float*)(lds + L_IMPB);
    LAS unsigned char* maskb = lds + L_MASK;
    LAS f32x4* ofl = (LAS f32x4*)(lds + L_OF);
    const LAS h16* KT = (const LAS h16*)(lds + L_KT); const LAS h16* VT = (const LAS h16*)(lds + L_VT);
    int tl[2]; f16x8 qf[2][2];
    const int hh = c & 3;
#pragma unroll
    for (int qi = 0; qi < 2; ++qi) {
        tl[qi] = 8 * w + 4 * qi + (c >> 2);
        const h16* qp = A.QK32 + (tok0 + tl[qi]) * QKP + hh * 64 + 8 * g;
#pragma unroll
        for (int ks = 0; ks < 2; ++ks) qf[qi][ks] = *(const f16x8*)(qp + 32 * ks);
    }
    for (int i = tid; i < 64 * 65; i += 512) { impa[i] = 0.f; impb[i] = 0.f; }
    const int nblk_c = (4 * qt + 3 + 63) >> 6;
    int nvis[2];
#pragma unroll
    for (int qi = 0; qi < 2; ++qi) { const int s = 64 * qt + tl[qi]; nvis[qi] = (s >= 31) ? ((s - 31) / 16 + 1) : 0; }
    const h16* kcb = A.KC + (size_t)b * 256 * 64; const h16* vcb = A.VCT + (size_t)b * 64 * 256;
    float m_c[2] = {-1e30f, -1e30f}, l_c[2] = {0.f, 0.f};
    f32x4 ofin[4][2];
#pragma unroll
    for (int dt = 0; dt < 4; ++dt)
#pragma unroll
        for (int qi = 0; qi < 2; ++qi) ofin[dt][qi] = (f32x4){0.f, 0.f, 0.f, 0.f};
    float glog[2][3];
#pragma unroll
    for (int qi = 0; qi < 2; ++qi) { const h16* gp = A.P16 + (tok0 + tl[qi]) * PITCH + PC_GTS; glog[qi][0] = (float)gp[hh]; glog[qi][1] = (float)gp[4 + hh]; glog[qi][2] = (float)gp[8 + hh]; }
    {
        TileRegs r[4];
#pragma unroll
        for (int u = 0; u < 4; ++u) if (u < nblk_c) r[u] = tile_load(kcb + (size_t)u * 64 * 64, 64, vcb + u * 64, 256, tid);
#pragma unroll
        for (int u = 0; u < 4; ++u) if (u < nblk_c) tile_store(lds, u, r[u], tid);
    }
    __syncthreads();
#pragma unroll 1
    for (int pass = 0; pass < 2; ++pass) {
        float inv_l[2];
        if (pass == 1) {
#pragma unroll
            for (int qi = 0; qi < 2; ++qi) { float lt = l_c[qi]; lt = sum_x16(lt); lt = sum_x32(lt); inv_l[qi] = lt > 0.f ? 1.f / lt : 0.f; }
        }
#pragma unroll 1
        for (int blk = 0; blk < nblk_c; ++blk) {
            f32x4 sc[2][4];
            qk_tiles<0, 2>(KT + blk * 64 * KP, qf, c, g, sc);
#pragma unroll
            for (int qi = 0; qi < 2; ++qi) {
                apply_mask(sc[qi], 1, nvis[qi] - 1 - 64 * blk - 4 * g);
                if (pass == 0) { float f; softmax_step(sc[qi], true, m_c[qi], l_c[qi], f); }
                else {
                    const float mu = fmaxf(m_c[qi], -1e20f);
#pragma unroll
                    for (int kt = 0; kt < 4; ++kt) {
#pragma unroll
                        for (int r = 0; r < 4; ++r) sc[qi][kt][r] = __builtin_amdgcn_exp2f(sc[qi][kt][r] - mu) * inv_l[qi];
                        float e0 = (sc[qi][kt][0] + sc[qi][kt][1]) + (sc[qi][kt][2] + sc[qi][kt][3]), e1 = sc[qi][kt][3];
                        e0 = sum_quad(e0); e1 = sum_quad(e1);
                        const int jj = 16 * blk + 4 * kt + g;
                        if (hh == 0) { impa[tl[qi] * 65 + jj] = e0; if (jj + 1 < 64) impb[tl[qi] * 65 + jj + 1] = e1; }
                    }
                }
            }
            if (pass == 1) pv_tiles<0, 2>(VT + blk * 64 * KP, sc, c, g, ofin);
        }
    }
    __syncthreads();
    {
        const int t = tid >> 3, jg = tid & 7;
        unsigned long long key[8];
#pragma unroll
        for (int i = 0; i < 8; ++i) { const int j = 8 * jg + i; const float imp = impa[t * 65 + j] + impb[t * 65 + j];
            const bool forced = (j == 0) || (j == qt) || (j == qt - 1); const float scv = forced ? 1e9f : (j <= qt ? imp : -1e30f);
            const unsigned fb = __builtin_bit_cast(unsigned, scv), ob = (fb & 0x80000000u) ? ~fb : (fb | 0x80000000u);
            key[i] = ((unsigned long long)ob << 32) | (unsigned)(63 - j); }
        __syncthreads();
        LAS unsigned long long* keys = (LAS unsigned long long*)(lds + L_IMPA);
#pragma unroll
        for (int i = 0; i < 8; ++i) keys[t * 65 + 8 * jg + i] = key[i];
        __syncthreads();
        int rank[8];
#pragma unroll
        for (int i = 0; i < 8; ++i) rank[i] = 0;
        for (int j2 = 0; j2 < 64; ++j2) { const unsigned long long k2 = keys[t * 65 + j2];
#pragma unroll
            for (int i = 0; i < 8; ++i) rank[i] += (k2 > key[i]) ? 1 : 0; }
        unsigned bits = 0;
#pragma unroll
        for (int i = 0; i < 8; ++i) bits |= ((rank[i] < 16 && (8 * jg + i) <= qt) ? 1u : 0u) << i;
        maskb[t * 8 + jg] = (unsigned char)bits;
    }
    __syncthreads();
    unsigned mlo[2], mhi[2];
#pragma unroll
    for (int qi = 0; qi < 2; ++qi) { const LAS unsigned* mp = (const LAS unsigned*)(lds + L_MASK) + 2 * tl[qi]; mlo[qi] = mp[0]; mhi[qi] = mp[1]; }
    float gsel[2], gwin[2];
#pragma unroll
    for (int qi = 0; qi < 2; ++qi) {
        const float g0 = __builtin_amdgcn_rcpf(1.f + __expf(-(glog[qi][0] + A.gate_b[hh])));
        gsel[qi] = __builtin_amdgcn_rcpf(1.f + __expf(-(glog[qi][1] + A.gate_b[4 + hh])));
        gwin[qi] = __builtin_amdgcn_rcpf(1.f + __expf(-(glog[qi][2] + A.gate_b[8 + hh])));
#pragma unroll
        for (int dt = 0; dt < 4; ++dt) ofl[(dt * 2 + qi) * 512 + tid] = ofin[dt][qi] * g0;
    }
    const h16* Pb = A.P16 + (size_t)b * S * PITCH;
    const int jw0 = qt >= 8 ? qt - 8 : 0;
#pragma unroll 1
    for (int br = 0; br < 2; ++br) {
        const bool win = br == 1;
        const int j0 = win ? jw0 : 0, nsteps = qt - j0 + 1, kcol = win ? PC_KW : PC_KS;
        const h16* Vb = A.VTG + ((size_t)b * 2 + br) * 64 * S;
        float m_b[2] = {-1e30f, -1e30f}, l_b[2] = {0.f, 0.f};
        f32x4 o_b[4][2];
#pragma unroll
        for (int dt = 0; dt < 4; ++dt)
#pragma unroll
            for (int qi = 0; qi < 2; ++qi) o_b[dt][qi] = (f32x4){0.f, 0.f, 0.f, 0.f};
        TileRegs R[4];
#define NSA_LOADG(G0) do { _Pragma("unroll") for (int u = 0; u < 4; ++u) if ((G0) + u < nsteps) R[u] = tile_load(Pb + (size_t)(j0 + (G0) + u) * 64 * PITCH + kcol, PITCH, Vb + 64 * (j0 + (G0) + u), S, tid); } while (0)
#define NSA_STOREG(G0) do { _Pragma("unroll") for (int u = 0; u < 4; ++u) if ((G0) + u < nsteps) tile_store(lds, u, R[u], tid); } while (0)
        NSA_LOADG(0); NSA_STOREG(0);
        __syncthreads();
#pragma unroll 1
        for (int g0 = 0; g0 < nsteps; g0 += 4) {
            NSA_LOADG(g0 + 4);
#pragma unroll
            for (int u = 0; u < 4; ++u) {
                if (g0 + u < nsteps) {
                    const int jb = j0 + g0 + u;
                    const bool selb0 = win ? true : ((jb < 32) ? ((mlo[0] >> jb) & 1u) : ((mhi[0] >> (jb - 32)) & 1u));
                    const bool selb1 = win ? true : ((jb < 32) ? ((mlo[1] >> jb) & 1u) : ((mhi[1] >> (jb - 32)) & 1u));
                    const bool a0 = __any(selb0), a1 = __any(selb1);
                    const int mode = (jb == qt) ? 1 : ((win && jb == qt - 8) ? 2 : 0);
#define NSA_STEP(QL, QH) do { f32x4 sc[2][4]; \
                        qk_tiles<QL, QH>(KT + u * 64 * KP, qf, c, g, sc); \
                        _Pragma("unroll") for (int qi = QL; qi < QH; ++qi) { \
                            apply_mask(sc[qi], mode, tl[qi] - 4 * g); \
                            float f; softmax_step(sc[qi], qi ? selb1 : selb0, m_b[qi], l_b[qi], f); \
                            if (__any(f != 1.f)) { _Pragma("unroll") for (int dt = 0; dt < 4; ++dt) o_b[dt][qi] = o_b[dt][qi] * f; } } \
                        pv_tiles<QL, QH>(VT + u * 64 * KP, sc, c, g, o_b); } while (0)
                    if (a0 && a1) NSA_STEP(0, 2); else if (a0) NSA_STEP(0, 1); else if (a1) NSA_STEP(1, 2);
#undef NSA_STEP
                }
            }
            __syncthreads();
            if (g0 + 4 < nsteps) { NSA_STOREG(g0 + 4); __syncthreads(); }
        }
#undef NSA_LOADG
#undef NSA_STOREG
#pragma unroll
        for (int qi = 0; qi < 2; ++qi) {
            float lb = l_b[qi]; lb = sum_x16(lb); lb = sum_x32(lb);
            const float cb = (win ? gwin[qi] : gsel[qi]) / lb;
#pragma unroll
            for (int dt = 0; dt < 4; ++dt) ofl[(dt * 2 + qi) * 512 + tid] = ofl[(dt * 2 + qi) * 512 + tid] + o_b[dt][qi] * cb;
        }
    }
#pragma unroll
    for (int qi = 0; qi < 2; ++qi) {
        float ss = 0.f;
#pragma unroll
        for (int dt = 0; dt < 4; ++dt) ofin[dt][qi] = ofl[(dt * 2 + qi) * 512 + tid];
#pragma unroll
        for (int dt = 0; dt < 4; ++dt)
            ss += (ofin[dt][qi][0] * ofin[dt][qi][0] + ofin[dt][qi][1] * ofin[dt][qi][1]) + (ofin[dt][qi][2] * ofin[dt][qi][2] + ofin[dt][qi][3] * ofin[dt][qi][3]);
        ss = sum_x16(ss); ss = sum_x32(ss); ss = sum_quad(ss);
        const float rstd = rsqrtf(ss * (1.f / 256.f) + 1e-6f);
        h16* op = A.O16 + (tok0 + tl[qi]) * D + hh * 64;
#pragma unroll
        for (int dt = 0; dt < 4; ++dt) { const int d0 = 16 * dt + 4 * g; const f32x4 gg = *(const f32x4*)(A.out_g + hh * 64 + d0);
            u32x2 wv; wv.x = pg8::pk_f16(ofin[dt][qi][0] * rstd * gg[0], ofin[dt][qi][1] * rstd * gg[1]); wv.y = pg8::pk_f16(ofin[dt][qi][2] * rstd * gg[2], ofin[dt][qi][3] * rstd * gg[3]);
            *(u32x2*)(op + d0) = wv; }
    }
    __syncthreads();
}

struct CmpArgs { const h16* QK32; const h16* P16; const h16* W1T;   const float* bias;   const float* w2k; const float* w2v; h16* KC; h16* VC; };
constexpr int TP = 72;
__device__ __forceinline__ void compress_item(const CmpArgs& A, int b, int kv, int ng, LAS unsigned char* lds) {
    int tid_ = threadIdx.x; asm volatile("" : "+v"(tid_)); const int tid = tid_, lane = tid & 63, w = tid >> 6, c = lane & 15, g = lane >> 4;
    LAS h16* TOK = (LAS h16*)lds;
    LAS float* RED = (LAS float*)(lds + 272 * TP * 2);
    LAS float* HID = RED + 2 * 16 * 64;
    const int t0 = 256 * ng;
    for (int e = tid; e < 272 * 8; e += 512) {
        const int t = e >> 3, ch = e & 7; const int tok = t0 + t;
        u32x4 v = {0u, 0u, 0u, 0u};
        if (tok < S) {
            if (kv == 0) v = *(const u32x4*)(A.QK32 + ((size_t)b * S + tok) * QKP + 256 + 8 * ch);
            else v = *(const u32x4*)(A.P16 + ((size_t)b * S + tok) * PITCH + PC_VC + 8 * ch);
        }
        *(LAS u32x4*)(TOK + t * TP + 8 * ch) = v;
    }
    __syncthreads();
    {
        const int nt = w & 3, kh = w >> 2;
        const h16* wb = A.W1T + ((size_t)kv * 64 + 16 * nt + c) * 2048 + 8 * g;
        f32x4 acc = {0.f, 0.f, 0.f, 0.f};
#pragma unroll 1
        for (int k8 = 32 * kh; k8 < 32 * kh + 32; k8 += 8) {
            f16x8 bw[8];
#pragma unroll
            for (int u = 0; u < 8; ++u) bw[u] = *(const f16x8*)(wb + 32 * (k8 + u));
#pragma unroll
            for (int u = 0; u < 8; ++u) { const int ks = k8 + u;
                const f16x8 a = *(const LAS f16x8*)(TOK + (16 * c + (ks >> 1)) * TP + 32 * (ks & 1) + 8 * g);
                acc = mfma16(a, bw[u], acc); }
        }
#pragma unroll
        for (int r = 0; r < 4; ++r) RED[(kh * 16 + 4 * g + r) * 64 + 16 * nt + c] = acc[r];
    }
    __syncthreads();
    for (int e = tid; e < 1024; e += 512) { const int n = e >> 6, j = e & 63; const float x = RED[n * 64 + j] + RED[(16 + n) * 64 + j] + A.bias[kv * 64 + j];
        HID[n * 64 + j] = 0.5f * x * (1.f + tanhf(0.7978845608028654f * (x + 0.044715f * x * x * x))); }
    __syncthreads();
    const float* w2 = kv == 0 ? A.w2k : A.w2v; h16* outp = kv == 0 ? A.KC : A.VC;
    for (int e = tid; e < 1024; e += 512) { const int n = e >> 6, j = e & 63; float s = 0.f;
        for (int i = 0; i < 64; ++i) s += HID[n * 64 + i] * w2[i * 64 + j];
        const int nn = 16 * ng + n;
        const h16 ov = (nn < NCMP) ? (h16)s : (h16)0.f;
        if (kv == 0) outp[((size_t)b * 256 + nn) * 64 + j] = ov; else outp[((size_t)b * 64 + j) * 256 + nn] = ov; }
    __syncthreads();
}
}
namespace mls {
using nsa::f16x8; using nsa::f32x4; using nsa::u32x4; using nsa::u32x2; using nsa::mfma16;
constexpr int KP = 72;
#define LDS_BAR() do { asm volatile("s_waitcnt lgkmcnt(0)" ::: "memory"); __builtin_amdgcn_s_barrier(); asm volatile("" ::: "memory"); } while (0)
constexpr size_t WS_KVB = WS_Y32;
constexpr size_t WS_KSUM = WS_Y32 + 48 * MiB;
constexpr size_t WS_MUB = WS_KSUM + 1 * MiB;
constexpr size_t WS_GT = 505 * MiB;
struct Args { const h16* P16; const float *conv_w, *conv_b, *ig_b, *fg_b, *norm_g; float* KVB; float* KSUM; float* MUB; h16* O16; float* GT; const h16* CW16; };

__device__ __forceinline__ void mm64(const LAS h16* A, const LAS h16* Bt, int w, int c, int g, f32x4 (&acc)[2]) {
    const int mi = w >> 1;
    const f16x8 a0 = *(const LAS f16x8*)(A + (16 * mi + c) * KP + 8 * g), a1 = *(const LAS f16x8*)(A + (16 * mi + c) * KP + 32 + 8 * g);
#pragma unroll
    for (int n = 0; n < 2; ++n) { const int ni = 2 * (w & 1) + n;
        const f16x8 b0 = *(const LAS f16x8*)(Bt + (16 * ni + c) * KP + 8 * g), b1 = *(const LAS f16x8*)(Bt + (16 * ni + c) * KP + 32 + 8 * g);
        acc[n] = mfma16(a0, b0, acc[n]); acc[n] = mfma16(a1, b1, acc[n]); }
}
__device__ __forceinline__ float half_lo(unsigned u) { return (float)__builtin_bit_cast(_Float16, (unsigned short)(u & 0xffffu)); }
__device__ __forceinline__ float half_hi(unsigned u) { return (float)__builtin_bit_cast(_Float16, (unsigned short)(u >> 16)); }
struct ConvTaps { u32x4 x[4]; };
__device__ __forceinline__ void conv_load(ConvTaps& T, const h16* Pbatch, int tloc, int col) {
#pragma unroll
    for (int i = 0; i < 4; ++i) { const int tt = tloc - 3 + i; T.x[i] = (u32x4){0u, 0u, 0u, 0u}; if (tt >= 0) T.x[i] = *(const u32x4*)(Pbatch + (size_t)tt * PITCH + col); }
}
typedef _Float16 h16x2 __attribute__((ext_vector_type(2)));
__device__ __forceinline__ void conv_apply(const ConvTaps& T, const h16* cw16, float scale, float (&out)[8]) {
    float acc[8];
    { const u32x4 bw = *(const u32x4*)(cw16 + 4 * 768); acc[0] = half_lo(bw.x); acc[1] = half_hi(bw.x); acc[2] = half_lo(bw.y); acc[3] = half_hi(bw.y); acc[4] = half_lo(bw.z); acc[5] = half_hi(bw.z); acc[6] = half_lo(bw.w); acc[7] = half_hi(bw.w); }
#pragma unroll
    for (int i = 0; i < 4; ++i) { const u32x4 x = T.x[i], wv = *(const u32x4*)(cw16 + i * 768);
        acc[0] += half_lo(x.x) * half_lo(wv.x); acc[1] += half_hi(x.x) * half_hi(wv.x); acc[2] += half_lo(x.y) * half_lo(wv.y); acc[3] += half_hi(x.y) * half_hi(wv.y);
        acc[4] += half_lo(x.z) * half_lo(wv.z); acc[5] += half_hi(x.z) * half_hi(wv.z); acc[6] += half_lo(x.w) * half_lo(wv.w); acc[7] += half_hi(x.w) * half_hi(wv.w); }
#pragma unroll
    for (int e = 0; e < 8; ++e) out[e] = acc[e] * __builtin_amdgcn_rcpf(1.f + __expf(-acc[e])) * scale;
}
__device__ __forceinline__ void conv8(const h16* Pbatch, int tloc, int col, const h16* cw16, float scale, float (&out)[8]) {
    ConvTaps T; conv_load(T, Pbatch, tloc, col); conv_apply(T, cw16, scale, out);
}
__device__ __forceinline__ float log_sigmoid(float x) { return fminf(x, 0.f) - log1pf(__expf(-fabsf(x))); }

__device__ __forceinline__ void m1_item(const Args& A, int bh, int ck, LAS unsigned char* lds) {
    int tid_ = threadIdx.x; asm volatile("" : "+v"(tid_)); const int tid = tid_, lane = tid & 63, w = tid >> 6, c = lane & 15, g = lane >> 4;
    const int b = bh / H_ML, h = bh % H_ML;
    LAS h16* KT2 = (LAS h16*)lds;
    LAS h16* WVT = KT2 + 64 * KP;
    LAS float* WGT = (LAS float*)(lds + 2 * 64 * KP * 2);
    const h16* Pb = A.P16 + (size_t)b * S * PITCH;
    const int tloc = 64 * ck + lane;
    if (w == 0) {
        const h16* pr = Pb + (size_t)tloc * PITCH;
        const float li = (float)pr[PC_IG + h] + A.ig_b[h];
        const float lf = log_sigmoid((float)pr[PC_FG + h] + A.fg_b[h]);
        float bs = lf;
#pragma unroll
        for (int o = 1; o < 64; o <<= 1) { const float t = __shfl_up(bs, o); if (lane >= o) bs += t; }
        const float gt = __shfl(bs, 63);
        const float u = gt - bs + li;
        const float mu = wave_max(u);
        WGT[lane] = __expf(u - mu);
        if (lane == 0) { A.MUB[bh * 64 + ck] = mu; A.MUB[3072 + bh * 64 + ck] = gt; }
        const float as = li - bs; float pm = as;
#pragma unroll
        for (int o = 1; o < 64; o <<= 1) { const float t = __shfl_up(pm, o); if (lane >= o) pm = fmaxf(pm, t); }
        float* gto = A.GT + ((size_t)bh * 64 + ck) * 192; gto[lane] = bs; gto[64 + lane] = as; gto[128 + lane] = pm;
    }
    float kc[8];
    conv8(Pb, tloc, PC_MK + h * 64 + 8 * w, A.CW16 + 384 + h * 64 + 8 * w, 0.125f, kc);
    LDS_BAR();
    const float wg = WGT[lane];
    const u32x4 vv = *(const u32x4*)(Pb + (size_t)tloc * PITCH + PC_MV + h * 64 + 8 * w);
    const float v8[8] = {half_lo(vv.x), half_hi(vv.x), half_lo(vv.y), half_hi(vv.y), half_lo(vv.z), half_hi(vv.z), half_lo(vv.w), half_hi(vv.w)};
#pragma unroll
    for (int e = 0; e < 8; ++e) { KT2[(8 * w + e) * KP + lane] = (h16)kc[e]; WVT[(8 * w + e) * KP + lane] = (h16)(v8[e] * wg); }
    LDS_BAR();
    f32x4 acc[2] = {{0.f, 0.f, 0.f, 0.f}, {0.f, 0.f, 0.f, 0.f}};
    mm64(WVT, KT2, w, c, g, acc);
    float* kvo = A.KVB + ((size_t)bh * 64 + ck) * 4096;
#pragma unroll
    for (int n = 0; n < 2; ++n)
#pragma unroll
        for (int r = 0; r < 4; ++r) kvo[(16 * (w >> 1) + 4 * g + r) * 64 + 16 * (2 * (w & 1) + n) + c] = acc[n][r];
    if (w == 1) { float s = 0.f;
        for (int t = 0; t < 64; ++t) s += (float)KT2[lane * KP + t] * WGT[t];
        A.KSUM[((size_t)bh * 64 + ck) * 64 + lane] = s; }
    LDS_BAR();
}

__device__ __forceinline__ void m2_item(const Args& A, int bh, int qr) {
    int tid_ = threadIdx.x; asm volatile("" : "+v"(tid_)); const int tid = tid_;
    float* kv = A.KVB + (size_t)bh * 64 * 4096 + qr * 1024 + tid;
    float* ks = A.KSUM + (size_t)bh * 64 * 64 + tid;
    const bool don = (qr == 0 && tid < 64);
    float C0 = 0.f, C1 = 0.f, n = 0.f, m = 0.f;
#pragma unroll 1
    for (int c8 = 0; c8 < 64; c8 += 8) {
        float x0[8], x1[8], xn[8], mu[8], gt[8];
#pragma unroll
        for (int u = 0; u < 8; ++u) { x0[u] = kv[(size_t)(c8 + u) * 4096]; x1[u] = kv[(size_t)(c8 + u) * 4096 + 512]; xn[u] = don ? ks[(c8 + u) * 64] : 0.f;
            mu[u] = A.MUB[bh * 64 + c8 + u]; gt[u] = A.MUB[3072 + bh * 64 + c8 + u]; }
#pragma unroll
        for (int u = 0; u < 8; ++u) { const int ck = c8 + u;
            const float mn = fmaxf(gt[u] + m, mu[u]), dec = __expf(gt[u] + m - mn), wl = __expf(mu[u] - mn);
            kv[(size_t)ck * 4096] = C0; kv[(size_t)ck * 4096 + 512] = C1;
            if (don) ks[ck * 64] = n;
            if (qr == 0 && tid == 0) A.MUB[2 * 3072 + bh * 64 + ck] = m;
            C0 = dec * C0 + wl * x0[u]; C1 = dec * C1 + wl * x1[u]; n = dec * n + wl * xn[u]; m = mn; }
    }
}

struct M3Regs { ConvTaps q, k; u32x4 v, og; f32x4 c0, c1; float bs, as, pm, n0, m0; };
__device__ __forceinline__ void m3_load(M3Regs& R, const Args& A, int item, int tid) {
    const int bh = item >> 6, ck = item & 63, b = bh / H_ML, h = bh % H_ML, lane = tid & 63, w = tid >> 6;
    const h16* Pb = A.P16 + (size_t)b * S * PITCH; const int tloc = 64 * ck + lane;
    conv_load(R.q, Pb, tloc, PC_MQ + h * 64 + 8 * w); conv_load(R.k, Pb, tloc, PC_MK + h * 64 + 8 * w);
    R.v = *(const u32x4*)(Pb + (size_t)tloc * PITCH + PC_MV + h * 64 + 8 * w);
    const float* cp = A.KVB + ((size_t)bh * 64 + ck) * 4096 + (tid >> 3) * 64 + 8 * (tid & 7);
    R.c0 = *(const f32x4*)cp; R.c1 = *(const f32x4*)(cp + 4);
    R.og = *(const u32x4*)(A.P16 + ((size_t)b * S + 64 * ck + (tid >> 3)) * PITCH + PC_MO + h * 64 + 8 * (tid & 7));
    const float* gti = A.GT + ((size_t)bh * 64 + ck) * 192; R.bs = gti[lane]; R.as = gti[64 + lane]; R.pm = gti[128 + lane];
    R.n0 = A.KSUM[((size_t)bh * 64 + ck) * 64 + lane]; R.m0 = A.MUB[2 * 3072 + bh * 64 + ck];
}
__device__ __forceinline__ void m3_item(const Args& A, int item, int next_item, M3Regs& R, LAS unsigned char* lds) {
    int tid_ = threadIdx.x; asm volatile("" : "+v"(tid_)); const int tid = tid_, lane = tid & 63, w = tid >> 6, c = lane & 15, g = lane >> 4;
    const int bh = item >> 6, ck = item & 63, b = bh / H_ML, h = bh % H_ML;
    LAS h16* Q16 = (LAS h16*)lds;
    LAS h16* K16 = Q16 + 64 * KP;
    LAS h16* VT2 = K16 + 64 * KP;
    LAS h16* C016 = VT2 + 64 * KP;
    LAS h16* SM16 = C016 + 64 * KP;
    LAS float* HV = (LAS float*)(lds + 5 * 64 * KP * 2);
    LAS float* BJ = HV + 64 * 65; LAS float* AS = BJ + 64; LAS float* MJ = AS + 64; LAS float* WI = MJ + 64; LAS float* N0 = WI + 64; LAS float* DEN = N0 + 64;
    const float m0 = R.m0;
    if (w == 0) {
        const float bs = R.bs, mj = bs + fmaxf(m0, R.pm);
        BJ[lane] = bs; AS[lane] = R.as; MJ[lane] = mj; WI[lane] = __expf(bs + m0 - mj);
        N0[lane] = R.n0;
    }
    u32x4 og;
    {   float q8[8], k8[8];
        conv_apply(R.q, A.CW16 + h * 64 + 8 * w, 1.f, q8);
        conv_apply(R.k, A.CW16 + 384 + h * 64 + 8 * w, 0.125f, k8);
        u32x4 qo, ko;
        qo.x = pg8::pk_f16(q8[0], q8[1]); qo.y = pg8::pk_f16(q8[2], q8[3]); qo.z = pg8::pk_f16(q8[4], q8[5]); qo.w = pg8::pk_f16(q8[6], q8[7]);
        ko.x = pg8::pk_f16(k8[0], k8[1]); ko.y = pg8::pk_f16(k8[2], k8[3]); ko.z = pg8::pk_f16(k8[4], k8[5]); ko.w = pg8::pk_f16(k8[6], k8[7]);
        *(LAS u32x4*)(Q16 + lane * KP + 8 * w) = qo; *(LAS u32x4*)(K16 + lane * KP + 8 * w) = ko;
        const u32x4 vv = R.v;
        LAS unsigned short* vt = (LAS unsigned short*)VT2 + (8 * w) * KP + lane;
        vt[0 * KP] = (unsigned short)(vv.x & 0xffffu); vt[1 * KP] = (unsigned short)(vv.x >> 16); vt[2 * KP] = (unsigned short)(vv.y & 0xffffu); vt[3 * KP] = (unsigned short)(vv.y >> 16);
        vt[4 * KP] = (unsigned short)(vv.z & 0xffffu); vt[5 * KP] = (unsigned short)(vv.z >> 16); vt[6 * KP] = (unsigned short)(vv.w & 0xffffu); vt[7 * KP] = (unsigned short)(vv.w >> 16);
        const f32x4 c0 = R.c0, c1 = R.c1;
        u32x4 co; co.x = pg8::pk_f16(c0[0], c0[1]); co.y = pg8::pk_f16(c0[2], c0[3]); co.z = pg8::pk_f16(c1[0], c1[1]); co.w = pg8::pk_f16(c1[2], c1[3]);
        *(LAS u32x4*)(C016 + (tid >> 3) * KP + 8 * (tid & 7)) = co;
        og = R.og;
    }
    if (next_item >= 0) m3_load(R, A, next_item, tid);
    LDS_BAR();
    {
        f32x4 acc[2] = {{0.f, 0.f, 0.f, 0.f}, {0.f, 0.f, 0.f, 0.f}};
        mm64(Q16, K16, w, c, g, acc);
#pragma unroll
        for (int n = 0; n < 2; ++n)
#pragma unroll
            for (int r = 0; r < 4; ++r) { const int j = 16 * (w >> 1) + 4 * g + r, s = 16 * (2 * (w & 1) + n) + c;
                const float v = (s <= j) ? __expf(BJ[j] + AS[s] - MJ[j]) * acc[n][r] : 0.f;
                SM16[j * KP + s] = (h16)v; }
    }
    LDS_BAR();
    {
        const int j = tid >> 3, sg = tid & 7; float rs = 0.f, nq = 0.f;
#pragma unroll
        for (int e = 0; e < 8; ++e) { rs += (float)SM16[j * KP + 8 * sg + e]; nq += (float)Q16[j * KP + 8 * sg + e] * N0[8 * sg + e]; }
        rs += __shfl_xor(rs, 1); rs += __shfl_xor(rs, 2); rs += __shfl_xor(rs, 4);
        nq += __shfl_xor(nq, 1); nq += __shfl_xor(nq, 2); nq += __shfl_xor(nq, 4);
        if (sg == 0) DEN[j] = fmaxf(fabsf(WI[j] * nq + rs), __expf(-MJ[j]));
    }
    f32x4 a1[2] = {{0.f, 0.f, 0.f, 0.f}, {0.f, 0.f, 0.f, 0.f}}, a2[2] = {{0.f, 0.f, 0.f, 0.f}, {0.f, 0.f, 0.f, 0.f}};
    mm64(Q16, C016, w, c, g, a1);
    mm64(SM16, VT2, w, c, g, a2);
    LDS_BAR();
#pragma unroll
    for (int n = 0; n < 2; ++n)
#pragma unroll
        for (int r = 0; r < 4; ++r) { const int j = 16 * (w >> 1) + 4 * g + r, d = 16 * (2 * (w & 1) + n) + c;
            HV[j * 65 + d] = (WI[j] * a1[n][r] + a2[n][r]) * __builtin_amdgcn_rcpf(DEN[j]); }
    LDS_BAR();
    {   const int j = tid >> 3, sg = tid & 7; float hv[8], ss = 0.f;
#pragma unroll
        for (int e = 0; e < 8; ++e) { hv[e] = HV[j * 65 + 8 * sg + e]; ss += hv[e] * hv[e]; }
        ss += __shfl_xor(ss, 1); ss += __shfl_xor(ss, 2); ss += __shfl_xor(ss, 4);
        const float rstd = rsqrtf(ss * (1.f / 64.f) + 1e-6f);
        const size_t tok = (size_t)b * S + 64 * ck + j;
        const float o8[8] = {half_lo(og.x), half_hi(og.x), half_lo(og.y), half_hi(og.y), half_lo(og.z), half_hi(og.z), half_lo(og.w), half_hi(og.w)};
        const float* ng = A.norm_g + h * 64 + 8 * sg;
        float r8[8];
#pragma unroll
        for (int e = 0; e < 8; ++e) r8[e] = hv[e] * rstd * ng[e] * __builtin_amdgcn_rcpf(1.f + __expf(-o8[e]));
        u32x4 ov; ov.x = pg8::pk_f16(r8[0], r8[1]); ov.y = pg8::pk_f16(r8[2], r8[3]); ov.z = pg8::pk_f16(r8[4], r8[5]); ov.w = pg8::pk_f16(r8[6], r8[7]);
        *(u32x4*)(A.O16 + tok * D + C_ATT + C_RW + h * 64 + 8 * sg) = ov;
    }
    LDS_BAR();
}
}
namespace rwk {
using nsa::f16x8; using nsa::f16x4; using nsa::f32x4; using nsa::u32x4; using nsa::u32x2; using nsa::mfma16;
constexpr size_t WS_WE = 364 * MiB, WS_AA = 388 * MiB, WS_GG = 412 * MiB;
constexpr size_t WS_LRW = WS_LRW0; constexpr int LRW_L = LRW_L0;
__device__ __forceinline__ f32x4 mfma16k16(f16x4 a, f16x4 b, f32x4 c) { return __builtin_amdgcn_mfma_f32_16x16x16f16(a, b, c, 0, 0, 0); }
template <int CTRL> __device__ __forceinline__ float dpp_mov(float v) { return __builtin_bit_cast(float, __builtin_amdgcn_update_dpp(0, __builtin_bit_cast(int, v), CTRL, 0xF, 0xF, true)); }
__device__ __forceinline__ float wave_sum_fast(float v) {
    v += dpp_mov<0xB1>(v); v += dpp_mov<0x4E>(v); v += dpp_mov<0x141>(v); v += dpp_mov<0x140>(v);
    const int iv = __builtin_bit_cast(int, v);
    return (__builtin_bit_cast(float, __builtin_amdgcn_readlane(iv, 0)) + __builtin_bit_cast(float, __builtin_amdgcn_readlane(iv, 16))) +
           (__builtin_bit_cast(float, __builtin_amdgcn_readlane(iv, 32)) + __builtin_bit_cast(float, __builtin_amdgcn_readlane(iv, 48)));
}
__device__ __forceinline__ float hlo(unsigned u) { return (float)__builtin_bit_cast(_Float16, (unsigned short)(u & 0xffffu)); }
__device__ __forceinline__ float hhi(unsigned u) { return (float)__builtin_bit_cast(_Float16, (unsigned short)(u >> 16)); }

template <int MAT> __device__ __forceinline__ void prep_mat(const LAS h16* X, LAS h16* OT, const h16* WT, const float* biasp, h16* outp, int tile, int w, int c, int g) {
        constexpr int K = (MAT == 2) ? 128 : 64, xp = (MAT == 2) ? 136 : 72;


        f32x4 acc[3][4];
#pragma unroll
        for (int nt = 0; nt < 3; ++nt)
#pragma unroll
            for (int mt = 0; mt < 4; ++mt) acc[nt][mt] = (f32x4){0.f, 0.f, 0.f, 0.f};
        f16x8 af[K / 32][3];
#pragma unroll
        for (int ks = 0; ks < K / 32; ++ks)
#pragma unroll
            for (int nt = 0; nt < 3; ++nt) af[ks][nt] = *(const f16x8*)(WT + (size_t)(48 * w + 16 * nt + c) * K + 32 * ks + 8 * g);
#pragma unroll
        for (int ks = 0; ks < K / 32; ++ks) {
            f16x8 bf[4];
#pragma unroll
            for (int mt = 0; mt < 4; ++mt) bf[mt] = *(const LAS f16x8*)(X + (16 * mt + c) * xp + 32 * ks + 8 * g);
#pragma unroll
            for (int nt = 0; nt < 3; ++nt)
#pragma unroll
                for (int mt = 0; mt < 4; ++mt) acc[nt][mt] = mfma16(af[ks][nt], bf[mt], acc[nt][mt]);
        }

#pragma unroll
        for (int nt = 0; nt < 3; ++nt) { const int ch = 48 * w + 16 * nt + 4 * g;
            f32x4 bias = {0.f, 0.f, 0.f, 0.f}; if (MAT == 0) bias = *(const f32x4*)(biasp + ch); else if (MAT == 1) bias = *(const f32x4*)(biasp + ch);
#pragma unroll
            for (int mt = 0; mt < 4; ++mt) { float o[4];
#pragma unroll
                for (int r = 0; r < 4; ++r) { const float x = acc[nt][mt][r] + bias[r];
                    if (MAT == 0) { const float sp = fmaxf(-x, 0.f) + __logf(1.f + __expf(-fabsf(x))); o[r] = __expf(-sp - 0.5f); }
                    else if (MAT == 1) o[r] = __builtin_amdgcn_rcpf(1.f + __expf(-x)); else o[r] = x; }
                u32x2 ov; ov.x = pg8::pk_f16(o[0], o[1]); ov.y = pg8::pk_f16(o[2], o[3]);
                *(LAS u32x2*)(OT + (16 * mt + c) * 392 + ch) = ov; }
        }
        __syncthreads();
        {
            int tid2_ = threadIdx.x; asm volatile("" : "+v"(tid2_));
#pragma unroll
            for (int k = 0; k < 6; ++k) { const int e = tid2_ + 512 * k, row = e / 48, cc = e % 48;
                *(u32x4*)(outp + ((size_t)tile * 64 + row) * C_RW + 8 * cc) = *(const LAS u32x4*)(OT + row * 392 + 8 * cc); }
        }
        __syncthreads();
}
constexpr size_t WS_RN = 363 * MiB + 128 * 1024;
struct PrepArgs { const h16* P16; const float *mu, *w0, *a0, *kkp; const h16* LRW; h16 *WE, *AA, *GG; float* RN; };
__device__ __forceinline__ void prep_item(const PrepArgs& A, int tile, LAS unsigned char* lds) {
    int tid_ = threadIdx.x; asm volatile("" : "+v"(tid_)); const int tid = tid_, lane = tid & 63, w = tid >> 6, c = lane & 15, g = lane >> 4;
    LAS h16* XW = (LAS h16*)lds;
    LAS h16* XA = XW + 64 * 72;
    LAS h16* XG = XA + 64 * 72;
    {
        const int tk = tid >> 3, part = tid & 7; const size_t tok = (size_t)tile * 64 + tk; const bool hasp = (tok % S) != 0;
        const h16* pc = A.P16 + tok * PITCH; const h16* pp = pc - PITCH;
#pragma unroll
        for (int q = 0; q < 4; ++q) {
            const int col = (q == 0) ? PC_XW + 8 * part : (q == 1) ? PC_XA + 8 * part : PC_XG + 64 * (q - 2) + 8 * part;
            const int mcol = (q == 0) ? 1152 + 8 * part : (q == 1) ? 1216 + 8 * part : 1280 + 64 * (q - 2) + 8 * part;
            const u32x4 xc = *(const u32x4*)(pc + col); u32x4 xp = {0u, 0u, 0u, 0u}; if (hasp) xp = *(const u32x4*)(pp + col);
            const float cv[8] = {hlo(xc.x), hhi(xc.x), hlo(xc.y), hhi(xc.y), hlo(xc.z), hhi(xc.z), hlo(xc.w), hhi(xc.w)};
            const float pv[8] = {hlo(xp.x), hhi(xp.x), hlo(xp.y), hhi(xp.y), hlo(xp.z), hhi(xp.z), hlo(xp.w), hhi(xp.w)};
            float o[8];
#pragma unroll
            for (int e = 0; e < 8; ++e) { const float x = cv[e] + A.mu[mcol + e] * (pv[e] - cv[e]);
                o[e] = (q == 0) ? (1.f - 2.f * __builtin_amdgcn_rcpf(1.f + __expf(2.f * x))) : (q == 1) ? x : __builtin_amdgcn_rcpf(1.f + __expf(-x)); }
            u32x4 ov; ov.x = pg8::pk_f16(o[0], o[1]); ov.y = pg8::pk_f16(o[2], o[3]); ov.z = pg8::pk_f16(o[4], o[5]); ov.w = pg8::pk_f16(o[6], o[7]);
            if (q == 0) *(LAS u32x4*)(XW + tk * 72 + 8 * part) = ov; else if (q == 1) *(LAS u32x4*)(XA + tk * 72 + 8 * part) = ov; else *(LAS u32x4*)(XG + tk * 136 + 64 * (q - 2) + 8 * part) = ov;
        }
#pragma unroll
        for (int hd = 0; hd < H_RW; ++hd) {
            const int col = hd * 64 + 8 * part;
            const u32x4 xc = *(const u32x4*)(pc + PC_K + col); u32x4 xp = {0u, 0u, 0u, 0u}; if (hasp) xp = *(const u32x4*)(pp + PC_K + col);
            const float cv[8] = {hlo(xc.x), hhi(xc.x), hlo(xc.y), hhi(xc.y), hlo(xc.z), hhi(xc.z), hlo(xc.w), hhi(xc.w)};
            const float pv[8] = {hlo(xp.x), hhi(xp.x), hlo(xp.y), hhi(xp.y), hlo(xp.z), hhi(xp.z), hlo(xp.w), hhi(xp.w)};
            float ss = 0.f;
#pragma unroll
            for (int e = 0; e < 8; ++e) { const float kq = (cv[e] + A.mu[384 + col + e] * (pv[e] - cv[e])) * A.kkp[col + e]; ss += kq * kq; }
            ss += __shfl_xor(ss, 1); ss += __shfl_xor(ss, 2); ss += __shfl_xor(ss, 4);
            if (part == 0) A.RN[tok * 6 + hd] = rsqrtf(fmaxf(ss, 1e-24f));
        }
    }
    __syncthreads();
    LAS h16* OT = XG + 64 * 136;
    prep_mat<0>(XW, OT, A.LRW, A.w0, A.WE, tile, w, c, g);
    prep_mat<1>(XA, OT, A.LRW + 384 * 64, A.a0, A.AA, tile, w, c, g);
    prep_mat<2>(XG, OT, A.LRW + 2 * 384 * 64, nullptr, A.GG, tile, w, c, g);
}

struct ScanArgs { const h16* P16; const h16 *WE, *AA; const float* RN; const float *mu, *kk, *ka; h16* O16; };
constexpr int NS = 8, AP = 72, TP2 = 20;
constexpr int S_AT = 0, S_RT = 2304, S_BN = 4608, S_KN = 6912, S_BT = 9216, S_KT = 11776, S_VT = 14336, S_T = 16896, S_MAK = 17536, S_MRB = 18176, S_MRK = 18816, S_GL = 19456, S_N = S_BN  , SLOT = 19712;
constexpr int NCH = S / 16;
static_assert(NS * SLOT <= LDS_BYTES - 16, "scan slots fit the LDS allocation");
struct RawRegs { unsigned short r[16], k[16], v[16], e[16], a[16]; unsigned short pr, pk, pv; float rn; };
__device__ __forceinline__ void scan_load(const ScanArgs& A, int b, int h, int ck, int lane, RawRegs& R) {
    const int ch = h * 64 + lane; const size_t tok0 = (size_t)b * S + 16 * ck;
    const unsigned short* p0 = (const unsigned short*)A.P16 + tok0 * PITCH + ch;
    const unsigned short* we = (const unsigned short*)A.WE + tok0 * C_RW + ch; const unsigned short* aa = (const unsigned short*)A.AA + tok0 * C_RW + ch;
    R.pr = 0; R.pk = 0; R.pv = 0;
    if (ck > 0) { R.pr = p0[PC_R - PITCH]; R.pk = p0[PC_K - PITCH]; R.pv = p0[PC_V - PITCH]; }
#pragma unroll
    for (int t = 0; t < 16; ++t) { R.r[t] = p0[(size_t)t * PITCH + PC_R]; R.k[t] = p0[(size_t)t * PITCH + PC_K]; R.v[t] = p0[(size_t)t * PITCH + PC_V]; R.e[t] = we[t * C_RW]; R.a[t] = aa[t * C_RW]; }
    R.rn = A.RN[(tok0 + (lane & 15)) * 6 + h];
}
__device__ __forceinline__ float us2f(unsigned short u) { return (float)__builtin_bit_cast(_Float16, u); }
__device__ __forceinline__ void scan_item(const ScanArgs& A, int bh, LAS unsigned char* lds) {
    int tid_ = threadIdx.x; asm volatile("" : "+v"(tid_)); const int tid = tid_, lane = tid & 63, w = __builtin_amdgcn_readfirstlane(tid >> 6), c = lane & 15, g = lane >> 4;
    const int b = bh / H_RW, h = bh % H_RW, ch = h * 64 + lane;
    LAS unsigned char* sb = lds + w * SLOT;
    LAS h16* AT = (LAS h16*)(sb + S_AT); LAS h16* RT = (LAS h16*)(sb + S_RT); LAS h16* BN = (LAS h16*)(sb + S_BN); LAS h16* KN = (LAS h16*)(sb + S_KN);
    LAS h16* BT = (LAS h16*)(sb + S_BT); LAS h16* KT = (LAS h16*)(sb + S_KT); LAS h16* VT = (LAS h16*)(sb + S_VT);
    LAS h16* TM = (LAS h16*)(sb + S_T); LAS h16* MAK = (LAS h16*)(sb + S_MAK); LAS h16* MRB = (LAS h16*)(sb + S_MRB); LAS h16* MRK = (LAS h16*)(sb + S_MRK);
    LAS float* GL = (LAS float*)(sb + S_GL); LAS float* N32 = (LAS float*)(sb + S_N);
    const float mu_r = A.mu[ch], mu_k = A.mu[384 + ch], mu_v = A.mu[768 + ch], k_k = A.kk[ch], k_a = A.ka[ch];
    f32x4 X[4];
#pragma unroll
    for (int kt = 0; kt < 4; ++kt) X[kt] = (f32x4){0.f, 0.f, 0.f, 0.f};
    RawRegs R;
    scan_load(A, b, h, w, lane, R);
#pragma unroll 1
    for (int bt = 0; bt < NCH / NS; ++bt) {
        {
            float pr = us2f(R.pr), pk = us2f(R.pk), pv = us2f(R.pv);
            float cl = 0.f, G = 1.f;
            const int rnv = __builtin_bit_cast(int, R.rn);
#pragma unroll
            for (int t = 0; t < 16; ++t) {
                const float cr = us2f(R.r[t]), ckv = us2f(R.k[t]), cv = us2f(R.v[t]), e = us2f(R.e[t]), a = us2f(R.a[t]);
                const float r = cr + mu_r * (pr - cr), k = ckv + mu_k * (pk - ckv), v = cv + mu_v * (pv - cv);
                pr = cr; pk = ckv; pv = cv;
                const float Gm1 = G; cl -= e; G = __expf(cl); const float iG = __builtin_amdgcn_rcpf(G);
                const float rn = __builtin_bit_cast(float, __builtin_amdgcn_readlane(rnv, t));
                const float kkn = k * k_k * rn;
                const float k2 = k * (1.f + (a - 1.f) * k_a), be = kkn * a;
                const h16 at = (h16)(-kkn * Gm1), bt_ = (h16)(be * iG), kt_ = (h16)(k2 * iG), rt = (h16)(r * G);
                AT[t * AP + lane] = at; RT[t * AP + lane] = rt; BN[t * AP + lane] = bt_; KN[t * AP + lane] = kt_;
                BT[lane * TP2 + t] = bt_; KT[lane * TP2 + t] = kt_; VT[lane * TP2 + t] = (h16)v;
            }
            GL[lane] = G;
            if (bt + 1 < NCH / NS) scan_load(A, b, h, NS * (bt + 1) + w, lane, R);
            asm volatile("s_waitcnt lgkmcnt(0)" ::: "memory");
            f32x4 mab = {0.f, 0.f, 0.f, 0.f}, mak = mab, mrb = mab, mrk = mab;
#pragma unroll
            for (int ks = 0; ks < 2; ++ks) {
                const f16x8 fa = *(const LAS f16x8*)(AT + c * AP + 32 * ks + 8 * g), fr = *(const LAS f16x8*)(RT + c * AP + 32 * ks + 8 * g);
                const f16x8 fb = *(const LAS f16x8*)(BN + c * AP + 32 * ks + 8 * g), fk = *(const LAS f16x8*)(KN + c * AP + 32 * ks + 8 * g);
                mab = mfma16(fa, fb, mab); mak = mfma16(fa, fk, mak); mrb = mfma16(fr, fb, mrb); mrk = mfma16(fr, fk, mrk);
            }
            asm volatile("s_waitcnt lgkmcnt(0)" ::: "memory");
#pragma unroll
            for (int r = 0; r < 4; ++r) { const int t = 4 * g + r;
                N32[t * 16 + c] = (c < t) ? mab[r] : 0.f;
                MAK[t * TP2 + c] = (h16)((c < t) ? mak[r] : 0.f); MRB[t * TP2 + c] = (h16)((c <= t) ? mrb[r] : 0.f); MRK[t * TP2 + c] = (h16)((c <= t) ? mrk[r] : 0.f); }
            asm volatile("s_waitcnt lgkmcnt(0)" ::: "memory");
            {
                float Tc[16];
#pragma unroll
                for (int t = 0; t < 16; ++t) {
                    float acc = (t == c) ? 1.f : 0.f;
#pragma unroll
                    for (int s4 = 0; s4 < (t + 3) / 4; ++s4) { const f32x4 nr = *(const LAS f32x4*)(N32 + t * 16 + 4 * s4);
#pragma unroll
                        for (int e = 0; e < 4; ++e) if (4 * s4 + e < t) acc += nr[e] * Tc[4 * s4 + e]; }
                    Tc[t] = acc;
                }
                if (g == 0) {
#pragma unroll
                    for (int t = 0; t < 16; ++t) TM[t * TP2 + c] = (h16)Tc[t];
                }
            }
        }
        asm volatile("s_waitcnt lgkmcnt(0)" ::: "memory"); __builtin_amdgcn_s_barrier(); asm volatile("" ::: "memory");
        if (w < 4) {
#pragma unroll 1
            for (int sl = 0; sl < NS; ++sl) {
                const int ck = NS * bt + sl;
                const LAS unsigned char* cb = lds + sl * SLOT;
                const LAS h16* cAT = (const LAS h16*)(cb + S_AT); const LAS h16* cRT = (const LAS h16*)(cb + S_RT);
                const LAS h16* cBT = (const LAS h16*)(cb + S_BT); const LAS h16* cKT = (const LAS h16*)(cb + S_KT); const LAS h16* cVT = (const LAS h16*)(cb + S_VT);
                const LAS h16* cTM = (const LAS h16*)(cb + S_T); const LAS h16* cMAK = (const LAS h16*)(cb + S_MAK); const LAS h16* cMRB = (const LAS h16*)(cb + S_MRB); const LAS h16* cMRK = (const LAS h16*)(cb + S_MRK);
                const LAS float* cGL = (const LAS float*)(cb + S_GL);
                f16x8 xf[2];
#pragma unroll
                for (int ks = 0; ks < 2; ++ks) { const f32x4 x0 = X[2 * ks], x1 = X[2 * ks + 1];
                    xf[ks] = (f16x8){(_Float16)x0[0], (_Float16)x0[1], (_Float16)x0[2], (_Float16)x0[3], (_Float16)x1[0], (_Float16)x1[1], (_Float16)x1[2], (_Float16)x1[3]}; }
                const f16x4 vf = *(const LAS f16x4*)(cVT + (16 * w + c) * TP2 + 4 * g);
                const f16x4 makf = *(const LAS f16x4*)(cMAK + c * TP2 + 4 * g), tf = *(const LAS f16x4*)(cTM + c * TP2 + 4 * g);
                const f16x4 mrbf = *(const LAS f16x4*)(cMRB + c * TP2 + 4 * g), mrkf = *(const LAS f16x4*)(cMRK + c * TP2 + 4 * g);
                f16x8 af[2], rf[2];
#pragma unroll
                for (int ks = 0; ks < 2; ++ks) {
                    const f16x4 a0 = *(const LAS f16x4*)(cAT + c * AP + 32 * ks + 4 * g), a1 = *(const LAS f16x4*)(cAT + c * AP + 32 * ks + 16 + 4 * g);
                    const f16x4 r0 = *(const LAS f16x4*)(cRT + c * AP + 32 * ks + 4 * g), r1 = *(const LAS f16x4*)(cRT + c * AP + 32 * ks + 16 + 4 * g);
                    af[ks] = (f16x8){a0[0], a0[1], a0[2], a0[3], a1[0], a1[1], a1[2], a1[3]}; rf[ks] = (f16x8){r0[0], r0[1], r0[2], r0[3], r1[0], r1[1], r1[2], r1[3]};
                }
                f32x4 gw = {0.f, 0.f, 0.f, 0.f};
                gw = mfma16k16(makf, vf, gw); gw = mfma16(af[0], xf[0], gw); gw = mfma16(af[1], xf[1], gw);
                const f16x4 gwf = (f16x4){(_Float16)gw[0], (_Float16)gw[1], (_Float16)gw[2], (_Float16)gw[3]};
                f32x4 u = {0.f, 0.f, 0.f, 0.f}; u = mfma16k16(tf, gwf, u);
                const f16x4 uf = (f16x4){(_Float16)u[0], (_Float16)u[1], (_Float16)u[2], (_Float16)u[3]};
                f32x4 yy = {0.f, 0.f, 0.f, 0.f};
                yy = mfma16k16(mrkf, vf, yy); yy = mfma16k16(mrbf, uf, yy); yy = mfma16(rf[0], xf[0], yy); yy = mfma16(rf[1], xf[1], yy);
#pragma unroll
                for (int kt = 0; kt < 4; ++kt) {
                    const f16x4 btf = *(const LAS f16x4*)(cBT + (16 * kt + c) * TP2 + 4 * g), ktf = *(const LAS f16x4*)(cKT + (16 * kt + c) * TP2 + 4 * g);
                    const f32x4 gl = *(const LAS f32x4*)(cGL + 16 * kt + 4 * g);
                    f32x4 x = X[kt]; x = mfma16k16(btf, uf, x); x = mfma16k16(ktf, vf, x); X[kt] = x * gl;
                }
                h16* op = A.O16 + ((size_t)b * S + 16 * ck + 4 * g) * D + C_ATT + h * 64 + 16 * w + c;
#pragma unroll
                for (int r = 0; r < 4; ++r) op[(size_t)r * D] = (h16)yy[r];
            }
        }
        asm volatile("s_waitcnt lgkmcnt(0)" ::: "memory"); __builtin_amdgcn_s_barrier(); asm volatile("" ::: "memory");
    }
    asm volatile("s_waitcnt vmcnt(0)" ::: "memory");
    __syncthreads();
}

struct PostArgs { const h16* P16; const h16 *AA, *GG; const float *mu, *ka, *rk, *lnw, *lnb; h16* O16; };
struct PostRaw4 { u32x2 cr, ck, cv, qr, qk, qv, av, gv, yv; };
__device__ __forceinline__ float row_sum16(float v) { v += dpp_mov<0xB1>(v); v += dpp_mov<0x4E>(v); v += dpp_mov<0x141>(v); v += dpp_mov<0x140>(v); return v; }
__device__ __forceinline__ void post_head_load(PostRaw4& R, const PostArgs& A, size_t tok, int col) {
    const h16* pc = A.P16 + tok * PITCH + col; const bool hasp = (tok % S) != 0;
    R.cr = *(const u32x2*)(pc + PC_R); R.ck = *(const u32x2*)(pc + PC_K); R.cv = *(const u32x2*)(pc + PC_V);
    R.qr = (u32x2){0u, 0u}; R.qk = (u32x2){0u, 0u}; R.qv = (u32x2){0u, 0u};
    if (hasp) { R.qr = *(const u32x2*)(pc + PC_R - PITCH); R.qk = *(const u32x2*)(pc + PC_K - PITCH); R.qv = *(const u32x2*)(pc + PC_V - PITCH); }
    R.av = *(const u32x2*)(A.AA + tok * C_RW + col); R.gv = *(const u32x2*)(A.GG + tok * C_RW + col); R.yv = *(const u32x2*)(A.O16 + tok * D + C_ATT + col);
}
__device__ __forceinline__ void h4(const u32x2 w, float (&o)[4]) { o[0] = hlo(w.x); o[1] = hhi(w.x); o[2] = hlo(w.y); o[3] = hhi(w.y); }
__device__ __forceinline__ void post_part(const PostArgs& A, int b, int h, int part) {
    int tid_ = threadIdx.x; asm volatile("" : "+v"(tid_)); const int lane = tid_ & 63, w = tid_ >> 6, col = h * 64 + 4 * (lane & 15);
    float mur[4], muk[4], muv[4], kaw[4], rkw[4], lw[4], lb[4];
#pragma unroll
    for (int e = 0; e < 4; ++e) { mur[e] = A.mu[col + e]; muk[e] = A.mu[384 + col + e]; muv[e] = A.mu[768 + col + e]; kaw[e] = A.ka[col + e]; rkw[e] = A.rk[col + e]; lw[e] = A.lnw[col + e]; lb[e] = A.lnb[col + e]; }
    const size_t tok0 = (size_t)b * S + 512 * part + 64 * w + (lane >> 4);
    PostRaw4 R0, R1;
    post_head_load(R0, A, tok0, col);
#define RWK_POST4(R, TOK) do { \
        float fr[4], fk[4], fv[4], qr[4], qk[4], qv[4], av[4], gv[4], y[4]; \
        h4(R.cr, fr); h4(R.ck, fk); h4(R.cv, fv); h4(R.qr, qr); h4(R.qk, qk); h4(R.qv, qv); h4(R.av, av); h4(R.gv, gv); h4(R.yv, y); \
        float sb = 0.f, vv[4]; \
        _Pragma("unroll") for (int e = 0; e < 4; ++e) { const float r = fr[e] + mur[e] * (qr[e] - fr[e]), k = fk[e] + muk[e] * (qk[e] - fk[e]); vv[e] = fv[e] + muv[e] * (qv[e] - fv[e]); \
            sb += r * (k * (1.f + (av[e] - 1.f) * kaw[e])) * rkw[e]; } \
        const float mean = row_sum16((y[0] + y[1]) + (y[2] + y[3])) * (1.f / 64.f); \
        float dv[4], sv = 0.f; \
        _Pragma("unroll") for (int e = 0; e < 4; ++e) { dv[e] = y[e] - mean; sv += dv[e] * dv[e]; } \
        const float rs = rsqrtf(row_sum16(sv) * (1.f / 64.f) + 64e-5f); \
        const float bon = row_sum16(sb); \
        float o[4]; \
        _Pragma("unroll") for (int e = 0; e < 4; ++e) o[e] = (dv[e] * rs * lw[e] + lb[e] + bon * vv[e]) * gv[e]; \
        u32x2 ov; ov.x = pg8::pk_f16(o[0], o[1]); ov.y = pg8::pk_f16(o[2], o[3]); \
        *(u32x2*)(A.O16 + (TOK) * D + C_ATT + col) = ov; } while (0)
#pragma unroll 1
    for (int t0 = 0; t0 < 64; t0 += 8) {
        post_head_load(R1, A, tok0 + t0 + 4, col);
        RWK_POST4(R0, tok0 + t0);
        if (t0 + 8 < 64) post_head_load(R0, A, tok0 + t0 + 8, col);
        RWK_POST4(R1, tok0 + t0 + 4);
    }
#undef RWK_POST4
}
}
__device__ __forceinline__ void skinny_item(const h16* H, const h16* Wsm, h16* P16o, int tile, LAS unsigned char* lds) {
    int tid_ = threadIdx.x; asm volatile("" : "+v"(tid_)); const int tid = tid_, lane = tid & 63, w = tid >> 6, c = lane & 15, g = lane >> 4;
    LAS float* PART = (LAS float*)lds;
    nsa::f16x8 af[4][4], bf[4][2];
#pragma unroll
    for (int ks = 0; ks < 4; ++ks) { const int k0 = 128 * w + 32 * ks + 8 * g;
#pragma unroll
        for (int mt = 0; mt < 4; ++mt) af[ks][mt] = *(const nsa::f16x8*)(H + ((size_t)tile * 64 + 16 * mt + c) * D + k0);
#pragma unroll
        for (int nt = 0; nt < 2; ++nt) bf[ks][nt] = *(const nsa::f16x8*)(Wsm + (size_t)(16 * nt + c) * D + k0); }
    nsa::f32x4 acc[4][2];
#pragma unroll
    for (int mt = 0; mt < 4; ++mt)
#pragma unroll
        for (int nt = 0; nt < 2; ++nt) acc[mt][nt] = (nsa::f32x4){0.f, 0.f, 0.f, 0.f};
#pragma unroll
    for (int ks = 0; ks < 4; ++ks)
#pragma unroll
        for (int mt = 0; mt < 4; ++mt)
#pragma unroll
            for (int nt = 0; nt < 2; ++nt) acc[mt][nt] = nsa::mfma16(bf[ks][nt], af[ks][mt], acc[mt][nt]);
#pragma unroll
    for (int mt = 0; mt < 4; ++mt)
#pragma unroll
        for (int nt = 0; nt < 2; ++nt) *(LAS nsa::f32x4*)(PART + (w * 64 + 16 * mt + c) * 32 + 16 * nt + 4 * g) = acc[mt][nt];
    __syncthreads();
    {   const int tk = tid >> 3, c4 = (tid & 7) * 4;
        nsa::f32x4 s = {0.f, 0.f, 0.f, 0.f};
#pragma unroll
        for (int ww = 0; ww < 8; ++ww) s = s + *(const LAS nsa::f32x4*)(PART + (ww * 64 + tk) * 32 + c4);
        if (c4 < 24) { pg8::u32x2 o; o.x = pg8::pk_f16(s[0], s[1]); o.y = pg8::pk_f16(s[2], s[3]); *(pg8::u32x2*)(P16o + ((size_t)tile * 64 + tk) * PITCH + PC_GTS + c4) = o; }
    }
    __syncthreads();
}
#define XB_TMO      128
#define XB_XCNT(j)  (256  + 64 * (j))
#define XB_XSUB(j)  (1280 + 64 * (j))
#define XB_XGEN(j)  (2304 + 64 * (j))
#define XB_TOP      3328
#define XB_TOPGEN   3392
#define XCD_BAR_WORDS 3456
#define XB_SPIN_CAP (1u << 18)

__device__ __forceinline__ unsigned xb_ld(unsigned* p)              { return __hip_atomic_load(p, __ATOMIC_RELAXED, __HIP_MEMORY_SCOPE_AGENT); }
__device__ __forceinline__ unsigned xb_add(unsigned* p, unsigned v) { return __hip_atomic_fetch_add(p, v, __ATOMIC_RELAXED, __HIP_MEMORY_SCOPE_AGENT); }
__device__ __forceinline__ unsigned xb_xcc_id() { return (unsigned)__builtin_amdgcn_s_getreg((3 << 11) | 20) & 0xFu; }
#define XB_SPIN(cond, bar) do { unsigned _sp = 0; while (cond) { __builtin_amdgcn_s_sleep(1); \
    if ((++_sp & 255u) == 0u) { if (xb_ld(&(bar)[XB_TMO])) break; if (_sp > XB_SPIN_CAP) { atomicAdd(&(bar)[XB_TMO], 1u); break; } } } } while (0)

struct XcdBarrier {
    unsigned* bar; unsigned x;
    volatile LAS unsigned* st;
};

__device__ __forceinline__ XcdBarrier xcd_barrier_post(unsigned* bar, volatile LAS unsigned* st) {
    XcdBarrier b; b.bar = bar; b.x = xb_xcc_id(); b.st = st;
    if (threadIdx.x == 0) (void)xb_add(&bar[XB_XCNT(b.x)], 1u);
    return b;
}
__device__ __forceinline__ void xcd_barrier_complete(unsigned* bar, unsigned x, unsigned& nloc, unsigned& nx) {
    const unsigned G = gridDim.x * gridDim.y * gridDim.z;
    unsigned sum, cnt, mine, sp = 0u;
    for (;;) {
        sum = 0u; cnt = 0u; mine = 0u;
#pragma unroll
        for (unsigned j = 0; j < 16; ++j) { const unsigned c = xb_ld(&bar[XB_XCNT(j)]); sum += c; cnt += (c > 0u) ? 1u : 0u; mine = (j == x) ? c : mine; }
        if (sum == G) break;
        __builtin_amdgcn_s_sleep(1);
        if ((++sp & 255u) == 0u) { if (xb_ld(&bar[XB_TMO])) break; if (sp > XB_SPIN_CAP) { atomicAdd(&bar[XB_TMO], 1u); break; } }
    }
    nloc = mine > 0u ? mine : 1u; nx = cnt > 0u ? cnt : 1u;
}

__device__ __forceinline__ void xcd_barrier(const XcdBarrier& b) {
    asm volatile("s_waitcnt vmcnt(0)" ::: "memory");
    __syncthreads();
    if (threadIdx.x == 0) {
        unsigned* bar = b.bar;
        __builtin_amdgcn_s_waitcnt(0);
        unsigned nloc = b.st[0], nx = b.st[1];
        if (nloc == 0u) { xcd_barrier_complete(bar, b.x, nloc, nx); b.st[0] = nloc; b.st[1] = nx; }
        const unsigned old = xb_add(&bar[XB_XSUB(b.x)], 1u);
        const unsigned gen = old / nloc;
        if (old + 1u == (gen + 1u) * nloc) {
            __builtin_amdgcn_fence(__ATOMIC_RELEASE, "agent");
            asm volatile("s_waitcnt vmcnt(0)" ::: "memory");
            const unsigned og = xb_add(&bar[XB_TOP], 1u);
            const unsigned tg = og / nx;
            if (og + 1u == (tg + 1u) * nx) xb_add(&bar[XB_TOPGEN], 1u);
            else XB_SPIN(xb_ld(&bar[XB_TOPGEN]) == tg, bar);
            __builtin_amdgcn_fence(__ATOMIC_ACQUIRE, "agent");
            xb_add(&bar[XB_XGEN(b.x)], 1u);
            asm volatile("s_waitcnt vmcnt(0)" ::: "memory");
        } else {
            XB_SPIN(xb_ld(&bar[XB_XGEN(b.x)]) == gen, bar);
            __builtin_amdgcn_fence(__ATOMIC_ACQUIRE, "agent");
            asm volatile("s_waitcnt vmcnt(0)" ::: "memory");
        }
    }
    __syncthreads();
}
constexpr int N_PHASES = 20;
__global__ void __launch_bounds__(512, 2) mk_fwd(Args a) {
    extern __shared__ __attribute__((aligned(16))) unsigned char lds_raw[];
    LAS unsigned char* lds = (LAS unsigned char*)lds_raw;
    cg::grid_group grid = cg::this_grid();
    if (threadIdx.x < 4) ((LAS unsigned*)(lds + L_BARST))[threadIdx.x] = 0u;
    __syncthreads();
    const XcdBarrier xbar = xcd_barrier_post((unsigned*)(a.ws + WS_BAR), (volatile LAS unsigned*)(lds + L_BARST));
    unsigned char* ws = a.ws;
    float* MOD = (float*)(ws + WS_MOD); h16* QK32 = (h16*)(ws + WS_QK32); h16* P16 = (h16*)(ws + WS_P16); h16* H16 = (h16*)(ws + WS_H16);
    h16* Y16 = (h16*)(ws + WS_Y32); h16* ACT = (h16*)(ws + WS_ACT); float* X = a.out;
    h16* XB16 = (h16*)(ws + WS_XB16);
    const int lo = a.ph_lo, hi = a.ph_hi;
#define IN(k) (lo <= (k) && (k) < hi)
    if (lo > 1000) grid.sync();
#define SEAM(k) do { if (IN(k) && IN((k) + 1)) { \
        xcd_barrier(xbar); \
    } } while (0)
    if (IN(0)) { phase_prologue(a, lds); } SEAM(0);
    if (IN(1)) { phase_post<false, false, false, true, 2>(a.in[0], nullptr, nullptr, MOD, 0, nullptr, a.in[4], MOD, 0, D, H16); prologue_weights(a, lds, 1); } SEAM(1);
#define LAYER(l) do { \
    const float* modl = MOD + (size_t)(l) * NB * 6 * D; constexpr int pb = 2 + 9 * (l); \
    mls::Args ma{P16, a.in[29] + (l) * 4 * 768, a.in[30] + (l) * 768, a.in[31] + (l) * H_ML, a.in[32] + (l) * H_ML, a.in[33] + (l) * C_ML, (float*)(ws + mls::WS_KVB), (float*)(ws + mls::WS_KSUM), (float*)(ws + mls::WS_MUB), H16, (float*)(ws + mls::WS_GT), (const h16*)(ws + WS_CW16) + (size_t)(l) * 5 * 768}; \
    if (IN(pb + 0)) { for (int it = blockIdx.x; it < 512; it += gridDim.x) skinny_item(H16, (const h16*)(ws + WS_WSM) + (size_t)(l) * 32 * D, P16, it, lds); \
        pg8::Gemm g{H16, (const h16*)(ws + WS_WIN) + (size_t)(l) * NIN_PAD * D, M, NIN_PAD, D}; pg8::StaticOrder So; So.init(M, NIN_PAD, gridDim.x, blockIdx.x); \
        pg8::EpiProj E{QK32, P16, (h16*)(ws + WS_VTG)}; pg8::gemm_phase<pg8::EpiProj, pg8::StaticOrder, true, true>(lds, g, So, E); } SEAM(pb + 0); \
    if (IN(pb + 1)) { nsa::CmpArgs ca{QK32, P16, (const h16*)(ws + WS_W1C) + (size_t)(l) * 2 * 64 * 2048, (const float*)(ws + WS_CBIAS) + (l) * 128, a.in[13] + (l) * 4096, a.in[15] + (l) * 4096, (h16*)(ws + WS_KC16), (h16*)(ws + WS_VC16)}; \
        for (int it = blockIdx.x; it < 256; it += gridDim.x) nsa::compress_item(ca, it >> 5, (it >> 4) & 1, it & 15, lds); \
        for (int it = blockIdx.x; it < 3072; it += gridDim.x) mls::m1_item(ma, it >> 6, it & 63, lds); \
        rwk::PrepArgs rp{P16, a.in[18] + (l) * RW_IN, a.in[19] + (l) * C_RW, a.in[21] + (l) * C_RW, a.in[24] + (l) * C_RW, (const h16*)(ws + rwk::WS_LRW) + (size_t)(l) * rwk::LRW_L, (h16*)(ws + rwk::WS_WE), (h16*)(ws + rwk::WS_AA), (h16*)(ws + rwk::WS_GG), (float*)(ws + rwk::WS_RN)}; \
        for (int it = blockIdx.x; it < 512; it += gridDim.x) rwk::prep_item(rp, it, lds); } SEAM(pb + 1); \
    if (IN(pb + 2)) { nsa::AttnArgs aa{QK32, P16, (const h16*)(ws + WS_KC16), (const h16*)(ws + WS_VC16), (const h16*)(ws + WS_VTG), a.in[16] + (l) * 12, a.in[17] + (l) * 256, H16}; \
        rwk::ScanArgs rs{P16, (const h16*)(ws + rwk::WS_WE), (const h16*)(ws + rwk::WS_AA), (const float*)(ws + rwk::WS_RN), a.in[18] + (l) * RW_IN, a.in[24] + (l) * C_RW, a.in[25] + (l) * C_RW, H16}; \
        rwk::PostArgs rq{P16, (const h16*)(ws + rwk::WS_AA), (const h16*)(ws + rwk::WS_GG), a.in[18] + (l) * RW_IN, a.in[25] + (l) * C_RW, a.in[26] + (l) * C_RW, a.in[27] + (l) * C_RW, a.in[28] + (l) * C_RW, H16}; \
        if (blockIdx.x < 48) { rwk::scan_item(rs, blockIdx.x, lds);   \
            if (threadIdx.x == 0) { __builtin_amdgcn_fence(__ATOMIC_RELEASE, "agent"); asm volatile("s_waitcnt vmcnt(0)" ::: "memory"); \
                __hip_atomic_fetch_add((unsigned*)(ws + WS_QCTR) + 64 * (48 + (l) * 8 + (int)blockIdx.x / H_RW), 1u, __ATOMIC_RELAXED, __HIP_MEMORY_SCOPE_AGENT); } } \
        {     \
            volatile LAS unsigned* qs = (volatile LAS unsigned*)(lds + L_QSLOT); \
            for (int kq = 0; kq < 8; ++kq) {   \
            const int xq = (int)((xbar.x + (unsigned)kq) & 7u); unsigned* qh = (unsigned*)(ws + WS_QCTR) + 64 * ((l) * 8 + xq); unsigned* m2d = (unsigned*)(ws + WS_QCTR) + 64 * (32 + (l) * 8 + xq); unsigned* scd = (unsigned*)(ws + WS_QCTR) + 64 * (48 + (l) * 8 + xq); int it; \
            for (;;) { __syncthreads(); if (threadIdx.x == 0) *qs = atomicAdd(qh, 1u); __syncthreads(); it = (int)*qs; if (it >= 24 + 64) break; \
                if (it < 24) { mls::m2_item(ma, xq * 6 + (it >> 2), it & 3); asm volatile("s_waitcnt vmcnt(0)" ::: "memory"); __syncthreads(); \
                               if (threadIdx.x == 0) { __builtin_amdgcn_fence(__ATOMIC_RELEASE, "agent"); asm volatile("s_waitcnt vmcnt(0)" ::: "memory"); __hip_atomic_fetch_add(m2d, 1u, __ATOMIC_RELAXED, __HIP_MEMORY_SCOPE_AGENT); } } \
                else nsa::attn_item(aa, xq, 63 - (it - 24), lds); } \
            if (it < 24 + 64 + 384) {   \
                if (threadIdx.x == 0) { while (__hip_atomic_load(m2d, __ATOMIC_RELAXED, __HIP_MEMORY_SCOPE_AGENT) < 24u) __builtin_amdgcn_s_sleep(8); } \
                __syncthreads(); __builtin_amdgcn_fence(__ATOMIC_ACQUIRE, "agent"); asm volatile("s_waitcnt vmcnt(0)" ::: "memory"); \
                mls::M3Regs mr; mls::m3_load(mr, ma, xq * 384 + (it - 88), threadIdx.x); \
                while (it < 24 + 64 + 384) { __syncthreads(); if (threadIdx.x == 0) *qs = atomicAdd(qh, 1u); __syncthreads(); const int nx = (int)*qs; \
                    mls::m3_item(ma, xq * 384 + (it - 88), nx < 24 + 64 + 384 ? xq * 384 + (nx - 88) : -1, mr, lds); it = nx; } } \
            if (it < 472 + 48) {   \
                if (threadIdx.x == 0) { while (__hip_atomic_load(scd, __ATOMIC_RELAXED, __HIP_MEMORY_SCOPE_AGENT) < 6u) __builtin_amdgcn_s_sleep(8); } \
                __syncthreads(); __builtin_amdgcn_fence(__ATOMIC_ACQUIRE, "agent"); asm volatile("s_waitcnt vmcnt(0)" ::: "memory"); \
                while (it < 472 + 48) { rwk::post_part(rq, xq, (it - 472) >> 3, (it - 472) & 7); \
                    __syncthreads(); if (threadIdx.x == 0) *qs = atomicAdd(qh, 1u); __syncthreads(); it = (int)*qs; } } } } } SEAM(pb + 2); \
    if (IN(pb + 4)) { pg8::Gemm g{H16, (const h16*)(ws + WS_WOUT) + (size_t)(l) * D * D, M, D, D}; pg8::StaticOrder So; So.init(M, D, gridDim.x, blockIdx.x); \
        pg8::EpiF16 E{Y16, D}; pg8::gemm_phase<pg8::EpiF16, pg8::StaticOrder, true, true>(lds, g, So, E); } SEAM(pb + 4); \
    if (IN(pb + 5)) { phase_post<(l) != 0, true, true, true, 2>((l) == 0 ? (const void*)a.in[0] : (const void*)X, Y16, a.in[5] + (l) * D, modl, 2 * D, XB16, a.in[6] + (l) * D, modl, 3 * D, 4 * D, H16); } SEAM(pb + 5); \
    if (IN(pb + 6)) { pg8::Gemm g{H16, (const h16*)(ws + WS_W1) + (size_t)(l) * NFF2 * D, M, NFF2, D}; pg8::StaticOrder So; So.init(M, NFF2, gridDim.x, blockIdx.x); \
        pg8::EpiSwiglu E{ACT, DFF}; pg8::gemm_phase<pg8::EpiSwiglu, pg8::StaticOrder, true, true>(lds, g, So, E); } SEAM(pb + 6); \
    if (IN(pb + 7)) { pg8::Gemm g{ACT, (const h16*)(ws + WS_W2) + (size_t)(l) * D * DFF, M, D, DFF}; pg8::StaticOrder So; So.init(M, D, gridDim.x, blockIdx.x); \
        pg8::EpiF16 E{Y16, D}; pg8::gemm_phase<pg8::EpiF16, pg8::StaticOrder, true, true>(lds, g, So, E); } SEAM(pb + 7); \
    if (IN(pb + 8)) { constexpr bool last = ((l) == DEPTH - 1); \
        phase_post<true, !last, true, !last, 2>(XB16, Y16, a.in[7] + (l) * D, modl, 5 * D, X, last ? nullptr : a.in[4] + ((l) + 1) * D, MOD + (size_t)(last ? (l) : (l) + 1) * NB * 6 * D, 0, D, H16); } \
    if (!((l) == DEPTH - 1)) SEAM(pb + 8); \
    } while (0)
    LAYER(0);
    LAYER(1);
#undef LAYER
#undef SEAM
#undef IN
}

static int g_grid = 0;
static void launch_mk(const Args& a0, int lo, int hi, hipStream_t stream) {
    Args a = a0; a.ph_lo = lo; a.ph_hi = hi;
    void* args[] = {(void*)&a};
    hipError_t e = hipLaunchCooperativeKernel((const void*)mk_fwd, dim3(g_grid), dim3(512), args, LDS_BYTES, stream);
    if (e != hipSuccess) fprintf(stderr, "cooperative launch failed: %s (grid %d)\n", hipGetErrorString(e), g_grid);
}
extern "C" void kernel_launch(void* const* d_in, const int* in_sizes, int n_in, void* d_out, int out_size, void* d_ws, size_t ws_size, hipStream_t stream) {
    if (n_in != 37 || ws_size < WS_END2) { fprintf(stderr, "kernel_launch: unexpected n_in %d / ws %zu\n", n_in, ws_size); return; }
    if (!g_grid) {
        int dev = 0, cus = 0, per_cu = 0;
        hipGetDevice(&dev); hipDeviceGetAttribute(&cus, hipDeviceAttributeMultiprocessorCount, dev);
        hipFuncSetAttribute((const void*)mk_fwd, hipFuncAttributeMaxDynamicSharedMemorySize, LDS_BYTES);
        hipOccupancyMaxActiveBlocksPerMultiprocessor(&per_cu, (const void*)mk_fwd, 512, LDS_BYTES);
        if (per_cu < 1) { fprintf(stderr, "kernel_launch: occupancy query says %d blocks/CU\n", per_cu); per_cu = 1; }
        g_grid = cus * (per_cu > 1 ? 1 : per_cu);
    }
    const float* const* in = (const float* const*)d_in;
    Args a{};
    for (int i = 0; i < 37; ++i) a.in[i] = in[i];
    a.out = (float*)d_out; a.ws = (unsigned char*)d_ws;
    hipMemsetAsync((char*)d_ws + WS_BAR, 0, 32768, stream);
    launch_mk(a, 0, N_PHASES, stream);
}
```

```cpp
#include <hip/hip_runtime.h>
#include <cstdio>
#include <cstdint>

typedef _Float16 h16;

constexpr int D = 1024, NB = 8, S = 4096, M = NB * S, DEPTH = 2;
constexpr int HD = 64;
constexpr int C_ATT = 256, C_RW = 384, C_ML = 384;
constexpr int H_ATT = 4, H_RW = 6, H_ML = 6;
constexpr int NSA_IN = 652, RW_IN = 1408, ML_IN = 1548, D_IN = 3608;
constexpr int DFF = 2816;
constexpr int NCMP = 255, NSLC = 64;
constexpr int PITCH = 3296;
constexpr int PC_VC = 0, PC_KS = 64, PC_VS = 128, PC_KW = 192, PC_VW = 256;
constexpr int PC_R = 320, PC_K = 704, PC_V = 1088, PC_XW = 1472, PC_XA = 1536, PC_XG = 1600;
constexpr int PC_MQ = 1728, PC_MK = 2112, PC_MV = 2496, PC_MO = 2880;
constexpr int PC_GTS = 3264, PC_IG = 3276, PC_FG = 3282;
constexpr int QKP = 320;
constexpr float QSCALE_Q = 0.125f * 1.4426950408889634f;

constexpr size_t MiB = 1u << 20;
constexpr size_t WS_MOD = 0;
constexpr size_t WS_QK32 = 4 * MiB;
constexpr size_t WS_P16 = 44 * MiB;
constexpr size_t WS_H16 = 250 * MiB;
constexpr size_t WS_Y32 = 314 * MiB;
constexpr size_t WS_XB16 = 184 * MiB;
constexpr size_t WS_ACT = 4 * MiB;
constexpr size_t WS_END = 442 * MiB;

__device__ __forceinline__ float wave_sum(float v) {
#pragma unroll
    for (int o = 32; o > 0; o >>= 1) v += __shfl_xor(v, o);
    return v;
}
__device__ __forceinline__ float wave_max(float v) {
#pragma unroll
    for (int o = 32; o > 0; o >>= 1) v = fmaxf(v, __shfl_xor(v, o));
    return v;
}
__device__ __forceinline__ float sigmoidf_(float x) { return 1.f / (1.f + expf(-x)); }
__device__ __forceinline__ float siluf_(float x) { return x * sigmoidf_(x); }
__device__ __forceinline__ float softplusf_(float x) { return fmaxf(x, 0.f) + log1pf(expf(-fabsf(x))); }
__device__ __forceinline__ float gelu_tanh(float x) { return 0.5f * x * (1.f + tanhf(0.7978845608028654f * (x + 0.044715f * x * x * x))); }

#include <hip/hip_cooperative_groups.h>
namespace cg = cooperative_groups;

namespace pg8 {
#define PG8_LAS __attribute__((address_space(3)))
typedef short s16x8 __attribute__((ext_vector_type(8)));
typedef _Float16 f16x8 __attribute__((ext_vector_type(8)));
typedef float f32x4 __attribute__((ext_vector_type(4)));
typedef unsigned u32x4 __attribute__((ext_vector_type(4)));
typedef unsigned u32x2 __attribute__((ext_vector_type(2)));
constexpr int BM = 256, BK = 64, HALF = 128, HTB = HALF * BK * 2  , STAGE_BYTES = 8 * HTB, NXCD = 8, WGM = 8;

__host__ __device__ __forceinline__ int lds_byte(int r, int c) { const int st = (r >> 4) * 2 + (c >> 5), rr = r & 15, cc = c & 31, ob = rr * 64 + cc * 2; return st * 1024 + (ob ^ (((ob >> 9) & 1) << 5)); }
__host__ __device__ __forceinline__ void stage_rc(int b, int& R, int& C) { const int st = b / 1024, sb = b % 1024, swz = sb ^ (((sb >> 9) & 1) << 5); R = (st >> 1) * 16 + swz / 64; C = (st & 1) * 32 + (swz % 64) / 2; }
__host__ __device__ __forceinline__ int perm32(int rho) { const int n = rho >> 4, i = rho & 15; return 8 * (i >> 2) + 4 * n + (i & 3); }

struct Unit { int pm, pn; };
struct Gemm { const h16* A; const h16* Bt; int M, N, K; };

struct StaticOrder {
    int nM, nN, nwg, G, c;
    __host__ __device__ void init(int M, int N, int G_, int c_) { nM = M / BM; nN = N / BM; nwg = nM * nN; G = G_; c = c_; }
    __host__ __device__ bool next(int i, Unit& u) const {
        const long L = (long)i * G + c; if (L >= nwg) return false;
        int wgid = (int)L; { const int q = nwg / NXCD, r = nwg % NXCD, xcd = wgid % NXCD, off = wgid / NXCD; wgid = (xcd < r ? xcd * (q + 1) : r * (q + 1) + (xcd - r) * q) + off; }
        const int nig = WGM * nN, gid = wgid / nig, fm = gid * WGM, gsz = (nM - fm) < WGM ? (nM - fm) : WGM;
        u.pm = fm + ((wgid % nig) % gsz); u.pn = (wgid % nig) / gsz; return true;
    }
    __device__ __forceinline__ void a_ready(const Unit&) const {}
    __device__ __forceinline__ void done(const Unit&) const {}
};

__device__ __forceinline__ unsigned pk_f16(float lo, float hi) { typedef _Float16 h2 __attribute__((ext_vector_type(2))); h2 v = {(_Float16)lo, (_Float16)hi}; return __builtin_bit_cast(unsigned, v); }

struct EpiProj {
    static constexpr bool PERM = true, AFTER_DRAIN = false; static constexpr int NSTORE = 16;
    h16* QK; h16* P; h16* VT;
    __device__ __forceinline__ void operator()(const f32x4 (&acc)[2][2][4][2], const Unit& u, int wr, int wc, int fr, int fq) const {
        const int row0 = u.pm * BM + wr * 64 + fr;
#pragma unroll
        for (int bj = 0; bj < 2; ++bj) {
            const int colt = u.pn * BM + bj * HALF + wc * 32 + 8 * fq;
            if (colt < 320) {
                const float qs = colt < 256 ? QSCALE_Q : 1.f;
#pragma unroll
                for (int ai = 0; ai < 2; ++ai)
#pragma unroll
                    for (int m = 0; m < 4; ++m) { const f32x4 v0 = acc[ai][bj][m][0], v1 = acc[ai][bj][m][1];
                        u32x4 w; w.x = pk_f16(v0[0] * qs, v0[1] * qs); w.y = pk_f16(v0[2] * qs, v0[3] * qs); w.z = pk_f16(v1[0] * qs, v1[1] * qs); w.w = pk_f16(v1[2] * qs, v1[3] * qs);
                        *(u32x4*)(QK + (size_t)(row0 + ai * HALF + m * 16) * QKP + colt) = w; }
            } else if ((colt >= 448 && colt < 512) || (colt >= 576 && colt < 640)) {
                const int br = colt >= 576 ? 1 : 0, d0 = colt - (br ? 576 : 448);
#pragma unroll
                for (int ai = 0; ai < 2; ++ai)
#pragma unroll
                    for (int m = 0; m < 4; ++m) { const int row = row0 + ai * HALF + m * 16, bb = row / S, tl = row % S;
                        h16* vp = VT + (((size_t)bb * 2 + br) * 64 + d0) * S + tl;
#pragma unroll
                        for (int e = 0; e < 4; ++e) { vp[(size_t)e * S] = (h16)acc[ai][bj][m][0][e]; vp[(size_t)(4 + e) * S] = (h16)acc[ai][bj][m][1][e]; } }
            } else {
#pragma unroll
                for (int ai = 0; ai < 2; ++ai)
#pragma unroll
                    for (int m = 0; m < 4; ++m) { const f32x4 v0 = acc[ai][bj][m][0], v1 = acc[ai][bj][m][1];
                        u32x4 w; w.x = pk_f16(v0[0], v0[1]); w.y = pk_f16(v0[2], v0[3]); w.z = pk_f16(v1[0], v1[1]); w.w = pk_f16(v1[2], v1[3]);
                        *(u32x4*)(P + (size_t)(row0 + ai * HALF + m * 16) * PITCH + (colt - 320)) = w; }
            }
        }
    }
};
struct EpiF16 {
    static constexpr bool PERM = true, AFTER_DRAIN = false; static constexpr int NSTORE = 16;
    h16* C; int ldc;
    __device__ __forceinline__ void operator()(const f32x4 (&acc)[2][2][4][2], const Unit& u, int wr, int wc, int fr, int fq) const {
        const int row0 = u.pm * BM + wr * 64 + fr;
#pragma unroll
        for (int ai = 0; ai < 2; ++ai)
#pragma unroll
            for (int m = 0; m < 4; ++m)
#pragma unroll
                for (int bj = 0; bj < 2; ++bj) { const f32x4 v0 = acc[ai][bj][m][0], v1 = acc[ai][bj][m][1];
                    u32x4 w; w.x = pk_f16(v0[0], v0[1]); w.y = pk_f16(v0[2], v0[3]); w.z = pk_f16(v1[0], v1[1]); w.w = pk_f16(v1[2], v1[3]);
                    *(u32x4*)(C + (size_t)(row0 + ai * HALF + m * 16) * ldc + u.pn * BM + bj * HALF + wc * 32 + 8 * fq) = w; }
    }
};
struct EpiSwiglu {
    static constexpr bool PERM = true, AFTER_DRAIN = false; static constexpr int NSTORE = 8;
    h16* C; int ldc;
    __device__ __forceinline__ void operator()(const f32x4 (&acc)[2][2][4][2], const Unit& u, int wr, int wc, int fr, int fq) const {
        const int row0 = u.pm * BM + wr * 64 + fr;
#pragma unroll
        for (int ai = 0; ai < 2; ++ai)
#pragma unroll
            for (int m = 0; m < 4; ++m) { float o[8];
#pragma unroll
                for (int n = 0; n < 2; ++n)
#pragma unroll
                    for (int e = 0; e < 4; ++e) { const float gt = acc[ai][0][m][n][e]; o[4 * n + e] = gt * __builtin_amdgcn_rcpf(1.f + __expf(-gt)) * acc[ai][1][m][n][e]; }
                u32x4 w; w.x = pk_f16(o[0], o[1]); w.y = pk_f16(o[2], o[3]); w.z = pk_f16(o[4], o[5]); w.w = pk_f16(o[6], o[7]);
                *(u32x4*)(C + (size_t)(row0 + ai * HALF + m * 16) * ldc + u.pn * HALF + wc * 32 + 8 * fq) = w; }
    }
};

template <class Epi, class Sched, bool ALIGN_EPI = false, bool SP2 = false>
__device__ __forceinline__ void gemm_phase(PG8_LAS unsigned char* lds, const Gemm g, const Sched& S, const Epi& E) {
    int tid_ = threadIdx.x; asm volatile("" : "+v"(tid_)); const int tid = tid_, wid = __builtin_amdgcn_readfirstlane(tid >> 6), lane = tid & 63, wr = wid >> 2, wc = wid & 3, fr = lane & 15, fq = lane >> 4;
    const int K = g.K, nt = K / BK;
    unsigned voffA[2], voffB[2];
#pragma unroll
    for (int i = 0; i < 2; ++i) { int R, C; stage_rc(tid * 16 + i * 8192, R, C); const int Rb = Epi::PERM ? ((R & ~31) + perm32(R & 31)) : R;
        voffA[i] = (unsigned)(R * K + C) * 2u; voffB[i] = (unsigned)(Rb * K + C) * 2u; }
    const size_t kstep = (size_t)(BK * 2);
    const size_t hstep = (size_t)HALF * K * 2;
    const size_t tstep = 2 * hstep;
    const unsigned ldsw = (unsigned)wid * 1024u;
    const int aoff = lds_byte(wr * 64 + fr, fq * 8), boff = lds_byte(wc * 32 + fr, fq * 8);
#define PG8_SA(b, h) (((b) * 2 + (h)) * HTB)
#define PG8_SB(b, h) ((4 + (b) * 2 + (h)) * HTB)
#define PG8_STAGE(bufoff, gbase, voff) do { _Pragma("unroll") for (int _i = 0; _i < 2; ++_i) \
        __builtin_amdgcn_global_load_lds((const unsigned*)((const char*)(gbase) + (voff)[_i]), (PG8_LAS unsigned*)(lds + (bufoff) + ldsw + _i * 8192), 16, 0, 0); } while (0)
#define PG8_LDA(dst, b, h) do { _Pragma("unroll") for (int m = 0; m < 4; ++m) _Pragma("unroll") for (int k = 0; k < 2; ++k) dst[m][k] = *(const PG8_LAS s16x8*)(lds + PG8_SA(b, h) + aoff + m * 2048 + k * 1024); } while (0)
#define PG8_LDB(dst, b, h) do { _Pragma("unroll") for (int n = 0; n < 2; ++n) _Pragma("unroll") for (int k = 0; k < 2; ++k) dst[n][k] = *(const PG8_LAS s16x8*)(lds + PG8_SB(b, h) + boff + n * 2048 + k * 1024); } while (0)
#define PG8_MMA(ai, bj, At, Bt) do { __builtin_amdgcn_s_setprio(1); _Pragma("unroll") for (int m = 0; m < 4; ++m) _Pragma("unroll") for (int n = 0; n < 2; ++n) _Pragma("unroll") for (int k = 0; k < 2; ++k) \
        acc[ai][bj][m][n] = __builtin_amdgcn_mfma_f32_16x16x32_f16(__builtin_bit_cast(f16x8, Bt[n][k]), __builtin_bit_cast(f16x8, At[m][k]), acc[ai][bj][m][n], 0, 0, 0); __builtin_amdgcn_s_setprio(0); } while (0)
#define PG8_WAIT_V(n) asm volatile("s_waitcnt vmcnt(" #n ")" ::: "memory")
#define PG8_WAIT_VF(f, n) asm volatile("s_cmp_lg_u32 %0, 0\n\ts_cbranch_scc1 .Lpg8wv%=\n\ts_waitcnt vmcnt(8)\n.Lpg8wv%=:\n\ts_waitcnt vmcnt(%1)" :: "s"(f), "n"(n) : "memory", "scc")
#define PG8_WAIT_L(n) asm volatile("s_waitcnt lgkmcnt(" #n ")" ::: "memory")
#define PG8_BAR __builtin_amdgcn_s_barrier()
#define PG8_SCHED __builtin_amdgcn_sched_barrier(0)
    Unit cur, nxt; int ui = 0;
    if (!S.next(0, cur)) return;
    f32x4 acc[2][2][4][2];
#pragma unroll
    for (int a = 0; a < 2; ++a)
#pragma unroll
        for (int b = 0; b < 2; ++b)
#pragma unroll
            for (int m = 0; m < 4; ++m)
#pragma unroll
                for (int n = 0; n < 2; ++n) acc[a][b][m][n] = (f32x4){0.f, 0.f, 0.f, 0.f};
    s16x8 At[4][2], B0[2][2], B1[2][2];
    const char* cA = (const char*)g.A + (size_t)cur.pm * tstep; const char* cB = (const char*)g.Bt + (size_t)cur.pn * tstep;
    S.a_ready(cur);
    if constexpr (SP2) {
        PG8_STAGE(PG8_SB(0, 0), cB, voffB); PG8_STAGE(PG8_SB(0, 1), cB + hstep, voffB); PG8_STAGE(PG8_SA(0, 0), cA, voffA); PG8_STAGE(PG8_SA(0, 1), cA + hstep, voffA);
        if (wr == 1) PG8_BAR;
        PG8_WAIT_V(2); PG8_BAR;
        PG8_STAGE(PG8_SB(1, 0), cB + kstep, voffB); PG8_STAGE(PG8_SA(1, 0), cA + kstep, voffA); PG8_STAGE(PG8_SB(1, 1), cB + hstep + kstep, voffB);
        PG8_WAIT_V(6); PG8_BAR;
    } else {
        PG8_STAGE(PG8_SB(0, 0), cB, voffB); PG8_STAGE(PG8_SA(0, 0), cA, voffA); PG8_STAGE(PG8_SB(0, 1), cB + hstep, voffB); PG8_STAGE(PG8_SA(0, 1), cA + hstep, voffA);
        if (wr == 1) PG8_BAR;
        PG8_WAIT_V(4); PG8_BAR;
        PG8_STAGE(PG8_SB(1, 0), cB + kstep, voffB); PG8_STAGE(PG8_SA(1, 0), cA + kstep, voffA); PG8_STAGE(PG8_SB(1, 1), cB + hstep + kstep, voffB);
        PG8_WAIT_V(6); PG8_BAR;
    }
    for (;;) {
        const bool has_next = S.next(ui + 1, nxt);
        const char* nA = has_next ? (const char*)g.A + (size_t)nxt.pm * tstep : cA; const char* nB = has_next ? (const char*)g.Bt + (size_t)nxt.pn * tstep : cB;
        for (int t = 0; t < nt; t += 2) {
            const bool last = (t == nt - 2);
            const char* a1 = cA + (size_t)(t + 1) * kstep;
            const char* a2 = last ? nA : cA + (size_t)(t + 2) * kstep; const char* b2 = last ? nB : cB + (size_t)(t + 2) * kstep;
            const char* a3 = a2 + kstep; const char* b3 = b2 + kstep;
            if (last && has_next) S.a_ready(nxt);
            const int fe = __builtin_amdgcn_readfirstlane(((t == 0) && (ui > 0)) ? 1 : 0);
            if constexpr (SP2) {
            PG8_LDB(B0, 0, 0); PG8_LDB(B1, 0, 1); PG8_SCHED; PG8_LDA(At, 0, 0); PG8_STAGE(PG8_SA(1, 1), a1 + hstep, voffA);
            PG8_WAIT_VF(fe, 8 + Epi::NSTORE); PG8_WAIT_L(0); PG8_BAR; PG8_MMA(0, 0, At, B0); PG8_MMA(0, 1, At, B1); PG8_BAR; PG8_SCHED;
            PG8_LDA(At, 0, 1); PG8_STAGE(PG8_SB(0, 0), b2, voffB); PG8_STAGE(PG8_SB(0, 1), b2 + hstep, voffB); PG8_STAGE(PG8_SA(0, 0), a2, voffA);
            PG8_WAIT_VF(fe, 8 + Epi::NSTORE); PG8_WAIT_L(0); PG8_BAR; PG8_MMA(1, 0, At, B0); PG8_MMA(1, 1, At, B1); PG8_BAR; PG8_SCHED;
            PG8_LDB(B0, 1, 0); PG8_LDB(B1, 1, 1); PG8_SCHED; PG8_LDA(At, 1, 0); PG8_STAGE(PG8_SA(0, 1), a2 + hstep, voffA);
            PG8_WAIT_V(8); PG8_WAIT_L(0); PG8_BAR; PG8_MMA(0, 0, At, B0); PG8_MMA(0, 1, At, B1); PG8_BAR; PG8_SCHED;
            PG8_LDA(At, 1, 1); PG8_STAGE(PG8_SB(1, 0), b3, voffB); PG8_STAGE(PG8_SB(1, 1), b3 + hstep, voffB); PG8_STAGE(PG8_SA(1, 0), a3, voffA);
            PG8_WAIT_V(8); PG8_WAIT_L(0); PG8_BAR; PG8_MMA(1, 0, At, B0); PG8_MMA(1, 1, At, B1); PG8_BAR; PG8_SCHED;
            } else {
            PG8_LDB(B0, 0, 0); PG8_SCHED; PG8_LDA(At, 0, 0); PG8_STAGE(PG8_SA(1, 1), a1 + hstep, voffA);
            PG8_WAIT_L(8); PG8_BAR; PG8_WAIT_L(0); PG8_MMA(0, 0, At, B0); PG8_BAR; PG8_SCHED;
            PG8_LDB(B1, 0, 1); PG8_STAGE(PG8_SB(0, 0), b2, voffB);
            PG8_BAR; PG8_WAIT_L(0); PG8_MMA(0, 1, At, B1); PG8_BAR;
            PG8_LDA(At, 0, 1); PG8_STAGE(PG8_SA(0, 0), a2, voffA);
            PG8_BAR; PG8_WAIT_L(0); PG8_MMA(1, 0, At, B0); PG8_BAR; PG8_SCHED;
            PG8_STAGE(PG8_SB(0, 1), b2 + hstep, voffB);
            PG8_WAIT_V(6); PG8_BAR; PG8_MMA(1, 1, At, B1); PG8_BAR;
            PG8_LDB(B0, 1, 0); PG8_SCHED; PG8_LDA(At, 1, 0); PG8_STAGE(PG8_SA(0, 1), a2 + hstep, voffA);
            PG8_WAIT_L(8); PG8_BAR; PG8_WAIT_L(0); PG8_MMA(0, 0, At, B0); PG8_BAR; PG8_SCHED;
            PG8_LDB(B1, 1, 1); PG8_STAGE(PG8_SB(1, 0), b3, voffB);
            PG8_BAR; PG8_WAIT_L(0); PG8_MMA(0, 1, At, B1); PG8_BAR;
            PG8_LDA(At, 1, 1); PG8_STAGE(PG8_SA(1, 0), a3, voffA);
            PG8_BAR; PG8_WAIT_L(0); PG8_MMA(1, 0, At, B0); PG8_BAR; PG8_SCHED;
            PG8_STAGE(PG8_SB(1, 1), b3 + hstep, voffB);
            PG8_WAIT_V(6); PG8_BAR; PG8_MMA(1, 1, At, B1); PG8_BAR;
            }
        }
        if constexpr (ALIGN_EPI) { if (wr == 0) PG8_BAR; }
        if constexpr (!Epi::AFTER_DRAIN) { E(acc, cur, wr, wc, fr, fq); S.done(cur); }
        if (!has_next) break;
#pragma unroll
        for (int a = 0; a < 2; ++a)
#pragma unroll
            for (int b = 0; b < 2; ++b)
#pragma unroll
                for (int m = 0; m < 4; ++m)
#pragma unroll
                    for (int n = 0; n < 2; ++n) acc[a][b][m][n] = (f32x4){0.f, 0.f, 0.f, 0.f};
        cur = nxt; cA = nA; cB = nB; ++ui;
        if constexpr (ALIGN_EPI) { if (wr == 1) PG8_BAR; }
    }
    PG8_WAIT_V(0);
    if constexpr (!ALIGN_EPI) { if (wr == 0) PG8_BAR; }
    PG8_BAR;
#undef PG8_SA
#undef PG8_SB
#undef PG8_STAGE
#undef PG8_LDA
#undef PG8_LDB
#undef PG8_MMA
#undef PG8_WAIT_V
#undef PG8_WAIT_VF
#undef PG8_WAIT_L
#undef PG8_BAR
#undef PG8_SCHED
}
}
constexpr size_t WS_WIN = 442 * MiB;
constexpr size_t WS_WOUT = 457 * MiB;
constexpr size_t WS_W1 = 461 * MiB;
constexpr size_t WS_W2 = 483 * MiB;
constexpr size_t WS_VTG = 496 * MiB;
constexpr size_t WS_CW16 = 509 * MiB;
constexpr size_t WS_END2 = 510 * MiB;
constexpr size_t WS_CBIAS = 512 * 1024;
constexpr size_t WS_KC16 = 1 * MiB;
constexpr size_t WS_VC16 = 1 * MiB + 512 * 1024;
constexpr size_t WS_W1C = 3 * MiB;
constexpr size_t WS_LRW0 = 2 * MiB;
constexpr int LRW_L0 = 384 * 64 * 2 + 384 * 128;
constexpr int NIN_PAD = 3584, NFF2 = 2 * DFF;
constexpr size_t WS_WSM = 508 * MiB;
constexpr int LDS_BYTES = 163840;
constexpr size_t WS_BAR = 400 * 1024;
constexpr int L_BARST = LDS_BYTES - 16;
constexpr size_t WS_QCTR = WS_BAR + 14336;
constexpr int L_QSLOT = LDS_BYTES - 32;
#define LAS __attribute__((address_space(3)))

struct Args { const float* in[37]; float* out; unsigned char* ws; int ph_lo, ph_hi; };

__device__ __forceinline__ int win_src_col(int nd) {
    if (nd < 320) return nd;
    const int c = nd - 320;
    if (c < 320) return c + 320;
    if (c < 3264) return c + 332;
    if (c < 3276) return c - 2624;
    if (c < 3288) return c + 320;
    return -1;
}
__device__ __forceinline__ int wsm_src_col(int r) { return r < 12 ? 640 + r : (r < 18 ? 3596 + (r - 12) : (r < 24 ? 3602 + (r - 18) : -1)); }
__device__ __forceinline__ void transpose_item(const float* cp, int ns, int K, h16* WT, int k0, int n0, LAS float* scr, int lane) {
    float tv[32];
#pragma unroll
    for (int i = 0; i < 32; ++i) { const int kk = 2 * i + (lane >> 5); tv[i] = cp ? __builtin_nontemporal_load(cp + (size_t)(k0 + kk) * ns) : 0.f; }
#pragma unroll
    for (int i = 0; i < 32; ++i) { const int kk = 2 * i + (lane >> 5); scr[kk * 33 + (lane & 31)] = tv[i]; }
    asm volatile("s_waitcnt lgkmcnt(0)" ::: "memory");
    const int c = lane & 7;
#pragma unroll
    for (int j = 0; j < 4; ++j) { const int n = (lane >> 3) + 8 * j; const LAS float* s = scr + (8 * c) * 33 + n;
        pg8::u32x4 o; o.x = pg8::pk_f16(s[0 * 33], s[1 * 33]); o.y = pg8::pk_f16(s[2 * 33], s[3 * 33]); o.z = pg8::pk_f16(s[4 * 33], s[5 * 33]); o.w = pg8::pk_f16(s[6 * 33], s[7 * 33]);
        *(pg8::u32x4*)(WT + (size_t)(n0 + n) * K + k0 + 8 * c) = o; }
    asm volatile("s_waitcnt lgkmcnt(0)" ::: "memory");
}

__device__ __forceinline__ void prologue_weights(const Args& a, LAS unsigned char* lds, int part) {
    int tid_ = threadIdx.x; asm volatile("" : "+v"(tid_)); const int tid = tid_, lane = tid & 63, wave = __builtin_amdgcn_readfirstlane(tid >> 6);
    const int G = gridDim.x, gw = blockIdx.x * 8 + wave, NGW = G * 8;
    LAS float* scr = (LAS float*)(lds + wave * 16384);
    constexpr int I_IN = 16 * (NIN_PAD / 32), I_OUT = 16 * 32, I_W1 = 16 * (NFF2 / 32), I_W2 = (DFF / 64) * 32, I_L = I_IN + I_OUT + I_W1 + I_W2;
    for (int it = gw; it < 2 * I_L; it += NGW) {
        const int l = it / I_L; int r = it % I_L;
        if ((part == 0) != (l == 0 && r < I_IN)) continue;
        if (r < I_IN) { const int nblk = NIN_PAD / 32, kb = r / nblk, nb = r % nblk; const int sc = win_src_col(nb * 32 + (lane & 31));
            transpose_item(sc >= 0 ? a.in[8] + (size_t)l * D * D_IN + sc : nullptr, D_IN, D, (h16*)(a.ws + WS_WIN) + (size_t)l * NIN_PAD * D, kb * 64, nb * 32, scr, lane); continue; }
        r -= I_IN;
        if (r < I_OUT) { const int kb = r / 32, nb = r % 32;
            transpose_item(a.in[9] + (size_t)l * D * D + nb * 32 + (lane & 31), D, D, (h16*)(a.ws + WS_WOUT) + (size_t)l * D * D, kb * 64, nb * 32, scr, lane); continue; }
        r -= I_OUT;
        if (r < I_W1) { const int nblk = NFF2 / 32, kb = r / nblk, nb = r % nblk; const int nd = nb * 32 + (lane & 31);
            const float* src = (((nd >> 7) & 1) ? a.in[35] : a.in[34]) + (size_t)l * D * DFF + (128 * (nd >> 8) + (nd & 127));
            transpose_item(src, DFF, D, (h16*)(a.ws + WS_W1) + (size_t)l * NFF2 * D, kb * 64, nb * 32, scr, lane); continue; }
        r -= I_W1;
        { const int kb = r / 32, nb = r % 32;
            transpose_item(a.in[36] + (size_t)l * DFF * D + nb * 32 + (lane & 31), D, DFF, (h16*)(a.ws + WS_W2) + (size_t)l * D * DFF, kb * 64, nb * 32, scr, lane); }
    }
}
__device__ __forceinline__ void phase_prologue(const Args& a, LAS unsigned char* lds) {
    int tid_ = threadIdx.x; asm volatile("" : "+v"(tid_)); const int tid = tid_, lane = tid & 63, wave = __builtin_amdgcn_readfirstlane(tid >> 6);
    const int G = gridDim.x, gw = blockIdx.x * 8 + wave, NGW = G * 8;
    LAS float* scr = (LAS float*)(lds + wave * 16384);
    prologue_weights(a, lds, 0);
    for (int i = blockIdx.x * 512 + tid; i < 2 * 5 * 768; i += G * 512) {
        const int l = i / 3840, r = i % 3840; ((h16*)(a.ws + WS_CW16))[i] = (h16)(r < 3072 ? a.in[29][l * 3072 + r] : a.in[30][l * 768 + (r - 3072)]); }
    for (int it = gw; it < 2 * 16; it += NGW) {
        const int l = it >> 4, kb = it & 15; const int sc = wsm_src_col(lane & 31);
        transpose_item(sc >= 0 ? a.in[8] + (size_t)l * D * D_IN + sc : nullptr, D_IN, D, (h16*)(a.ws + WS_WSM) + (size_t)l * 32 * D, kb * 64, 0, scr, lane); }
    for (int it = gw; it < 4 * 64; it += NGW) {
        const int mat = it >> 6, r = it & 63, l = mat >> 1, kv = mat & 1, kb = r >> 1, nb = r & 1;
        transpose_item((kv ? a.in[14] : a.in[12]) + (size_t)l * 2048 * 64 + nb * 32 + (lane & 31), 64, 2048, (h16*)(a.ws + WS_W1C) + (size_t)mat * 64 * 2048, kb * 64, nb * 32, scr, lane);
    }
    for (int it = gw; it < 2 * 48; it += NGW) {
        const int l = it / 48, r = it % 48;
        h16* dst = (h16*)(a.ws + WS_LRW0) + (size_t)l * LRW_L0;
        if (r < 12) transpose_item(a.in[20] + (size_t)l * 64 * C_RW + r * 32 + (lane & 31), C_RW, 64, dst, 0, r * 32, scr, lane);
        else if (r < 24) transpose_item(a.in[22] + (size_t)l * 64 * C_RW + (r - 12) * 32 + (lane & 31), C_RW, 64, dst + 384 * 64, 0, (r - 12) * 32, scr, lane);
        else { const int kb = (r - 24) / 12, nb = (r - 24) % 12; transpose_item(a.in[23] + (size_t)l * 128 * C_RW + nb * 32 + (lane & 31), C_RW, 128, dst + 2 * 384 * 64, kb * 64, nb * 32, scr, lane); }
    }
    if (blockIdx.x >= G - 4) {
        const int u = G - 1 - (int)blockIdx.x, l = u >> 1, kv = u & 1; const float* pe = (kv ? a.in[11] : a.in[10]) + l * 2048 + wave * 256; const float* w1 = (kv ? a.in[14] : a.in[12]) + (size_t)l * 2048 * 64 + (size_t)wave * 256 * 64 + lane;
        float sacc = 0.f;
#pragma unroll 1
        for (int k = 0; k < 256; k += 16) { float wv[16];
#pragma unroll
            for (int j = 0; j < 16; ++j) wv[j] = w1[(size_t)(k + j) * 64];
#pragma unroll
            for (int j = 0; j < 16; ++j) sacc += pe[k + j] * wv[j]; }
        LAS float* bred = (LAS float*)(lds + 8 * 16384);
        bred[wave * 64 + lane] = sacc;
        __syncthreads();
        if (wave == 0) { float t = 0.f;
#pragma unroll
            for (int j = 0; j < 8; ++j) t += bred[j * 64 + lane];
            ((float*)(a.ws + WS_CBIAS))[u * 64 + lane] = t; }
    }
    __syncthreads();
    LAS float* cs = (LAS float*)lds;
    LAS float* red = (LAS float*)(lds + 32768);
    for (int i = tid; i < NB * D; i += 512) { const float v = a.in[1][i]; cs[i] = v / (1.f + __expf(-v)); }
    __syncthreads();
    float* MOD = (float*)(a.ws + WS_MOD);
    for (int u = blockIdx.x; u < 2 * 96; u += G) {
        const int l = u / 96, col = (u % 96) * 64 + (tid & 63), ks = tid >> 6;
        const float* w = a.in[2] + (size_t)l * D * 6 * D + col;
        float acc[8];
#pragma unroll
        for (int b = 0; b < 8; ++b) acc[b] = 0.f;
#pragma unroll 1
        for (int k = ks * 128; k < ks * 128 + 128; k += 16) { float wv[16];
#pragma unroll
            for (int j = 0; j < 16; ++j) wv[j] = w[(size_t)(k + j) * 6 * D];
#pragma unroll
            for (int j = 0; j < 16; ++j)
#pragma unroll
                for (int b = 0; b < 8; ++b) acc[b] += cs[b * D + k + j] * wv[j]; }
#pragma unroll
        for (int b = 0; b < 8; ++b) red[(ks * 8 + b) * 64 + (tid & 63)] = acc[b];
        __syncthreads();
        { const int b = tid >> 6; float s = a.in[3][l * 6 * D + col];
#pragma unroll
          for (int k2 = 0; k2 < 8; ++k2) s += red[(k2 * 8 + b) * 64 + (tid & 63)];
          MOD[((size_t)l * NB + b) * 6 * D + col] = s; }
        __syncthreads();
    }
}

template <bool XH> struct XRaw;
template <> struct XRaw<false> { pg8::f32x4 x[2][2]; };
template <> struct XRaw<true> { pg8::u32x4 x[2]; };
__device__ __forceinline__ void x_load(XRaw<false>& R, const void* base, size_t off) {
#pragma unroll
    for (int j = 0; j < 2; ++j) { const float* p = (const float*)base + off + j * 512; R.x[j][0] = __builtin_nontemporal_load((const pg8::f32x4*)p); R.x[j][1] = __builtin_nontemporal_load((const pg8::f32x4*)(p + 4)); }
}
__device__ __forceinline__ void x_load(XRaw<true>& R, const void* base, size_t off) {
#pragma unroll
    for (int j = 0; j < 2; ++j) R.x[j] = __builtin_nontemporal_load((const pg8::u32x4*)((const h16*)base + off + j * 512));
}
__device__ __forceinline__ float h_lo(unsigned w) { return (float)__builtin_bit_cast(_Float16, (unsigned short)(w & 0xffffu)); }
__device__ __forceinline__ float h_hi(unsigned w) { return (float)__builtin_bit_cast(_Float16, (unsigned short)(w >> 16)); }
__device__ __forceinline__ void h_unpack(const pg8::u32x4 w, float (&o)[8]) { o[0] = h_lo(w.x); o[1] = h_hi(w.x); o[2] = h_lo(w.y); o[3] = h_hi(w.y); o[4] = h_lo(w.z); o[5] = h_hi(w.z); o[6] = h_lo(w.w); o[7] = h_hi(w.w); }
__device__ __forceinline__ void x_unpack(const XRaw<false>& R, int j, float (&o)[8]) {
#pragma unroll
    for (int e = 0; e < 4; ++e) { o[e] = R.x[j][0][e]; o[4 + e] = R.x[j][1][e]; } }
__device__ __forceinline__ void x_unpack(const XRaw<true>& R, int j, float (&o)[8]) { h_unpack(R.x[j], o); }
template <bool XI, bool HASY> struct PostRaw { XRaw<XI> x; pg8::u32x4 y[2]; };
template <bool XI, bool HASY>
__device__ __forceinline__ void post_load(PostRaw<XI, HASY>& R, const void* xold, const h16* y, int tok, int lane) {
    const size_t off = (size_t)tok * D + lane * 8;
    if constexpr (HASY) {
#pragma unroll
        for (int j = 0; j < 2; ++j) R.y[j] = __builtin_nontemporal_load((const pg8::u32x4*)(y + off + j * 512)); }
    x_load(R.x, xold, off);
}
template <bool XI, bool XO, bool HASY, bool HASH>
__device__ __forceinline__ void post_row(const PostRaw<XI, HASY>& R, int tok, int lane, const float (&pa)[2][8], const float (&pb)[2][8], const float (&pc)[2][8], void* xnew, h16* H) {
    float v[2][8]; float s2 = 0.f;
    if constexpr (HASY) {
        float ss = 0.f;
#pragma unroll
        for (int j = 0; j < 2; ++j) { h_unpack(R.y[j], v[j]);
#pragma unroll
            for (int e = 0; e < 8; ++e) ss += v[j][e] * v[j][e]; }
        const float rstd = rsqrtf(wave_sum(ss) * (1.f / D) + 1e-6f);
#pragma unroll
        for (int j = 0; j < 2; ++j) { float xo[8]; x_unpack(R.x, j, xo);
#pragma unroll
            for (int e = 0; e < 8; ++e) { v[j][e] = xo[e] + pa[j][e] * (v[j][e] * rstd); s2 += v[j][e] * v[j][e]; }
            const size_t off = (size_t)tok * D + j * 512 + lane * 8;
            if constexpr (XO) { pg8::u32x4 w; w.x = pg8::pk_f16(v[j][0], v[j][1]); w.y = pg8::pk_f16(v[j][2], v[j][3]); w.z = pg8::pk_f16(v[j][4], v[j][5]); w.w = pg8::pk_f16(v[j][6], v[j][7]); *(pg8::u32x4*)((h16*)xnew + off) = w; }
            else { *(pg8::f32x4*)((float*)xnew + off) = (pg8::f32x4){v[j][0], v[j][1], v[j][2], v[j][3]}; *(pg8::f32x4*)((float*)xnew + off + 4) = (pg8::f32x4){v[j][4], v[j][5], v[j][6], v[j][7]}; } }
    } else {
#pragma unroll
        for (int j = 0; j < 2; ++j) { x_unpack(R.x, j, v[j]);
#pragma unroll
            for (int e = 0; e < 8; ++e) s2 += v[j][e] * v[j][e]; }
    }
    if constexpr (HASH) {
        const float r2 = rsqrtf(wave_sum(s2) * (1.f / D) + 1e-6f);
#pragma unroll
        for (int j = 0; j < 2; ++j) { pg8::u32x4 w;
            w.x = pg8::pk_f16(v[j][0] * r2 * pb[j][0] + pc[j][0], v[j][1] * r2 * pb[j][1] + pc[j][1]); w.y = pg8::pk_f16(v[j][2] * r2 * pb[j][2] + pc[j][2], v[j][3] * r2 * pb[j][3] + pc[j][3]);
            w.z = pg8::pk_f16(v[j][4] * r2 * pb[j][4] + pc[j][4], v[j][5] * r2 * pb[j][5] + pc[j][5]); w.w = pg8::pk_f16(v[j][6] * r2 * pb[j][6] + pc[j][6], v[j][7] * r2 * pb[j][7] + pc[j][7]);
            *(pg8::u32x4*)(H + (size_t)tok * D + j * 512 + lane * 8) = w; }
    }
}
template <bool XI, bool XO, bool HASY, bool HASH, int G>
__device__ __forceinline__ void phase_post(const void* xold, const h16* y, const float* gpost, const float* modl, int gt_off, void* xnew,
                                           const float* gnext, const float* modn, int sh_off, int sc_off, h16* H) {
    int tid_ = threadIdx.x; asm volatile("" : "+v"(tid_)); const int lane = tid_ & 63, gw = blockIdx.x * 8 + (tid_ >> 6), NGW = gridDim.x * 8;
    constexpr int CH = 16;
    static_assert(S % CH == 0 && CH % (2 * G) == 0, "chunking");
    for (int ch = gw; ch < M / CH; ch += NGW) {
        const int tok0 = ch * CH, b = tok0 / S;
        float pa[2][8], pb[2][8], pc[2][8];
#pragma unroll
        for (int j = 0; j < 2; ++j) { const int cc = j * 512 + lane * 8;
#pragma unroll
            for (int hf = 0; hf < 2; ++hf) {
                if constexpr (HASY) { const pg8::f32x4 gp = *(const pg8::f32x4*)(gpost + cc + 4 * hf), gt = *(const pg8::f32x4*)(modl + (size_t)b * 6 * D + gt_off + cc + 4 * hf);
#pragma unroll
                    for (int e = 0; e < 4; ++e) pa[j][4 * hf + e] = gt[e] * gp[e]; }
                if constexpr (HASH) { const float* mn = modn + (size_t)b * 6 * D;
                    const pg8::f32x4 gg = *(const pg8::f32x4*)(gnext + cc + 4 * hf), sc = *(const pg8::f32x4*)(mn + sc_off + cc + 4 * hf), sh = *(const pg8::f32x4*)(mn + sh_off + cc + 4 * hf);
#pragma unroll
                    for (int e = 0; e < 4; ++e) { pb[j][4 * hf + e] = gg[e] * (1.f + sc[e]); pc[j][4 * hf + e] = sh[e]; } }
            } }
        PostRaw<XI, HASY> R0[G], R1[G];
#pragma unroll
        for (int t = 0; t < G; ++t) post_load<XI, HASY>(R0[t], xold, y, tok0 + t, lane);
#pragma unroll 1
        for (int g = 0; g < CH / G; g += 2) {
#pragma unroll
            for (int t = 0; t < G; ++t) post_load<XI, HASY>(R1[t], xold, y, tok0 + (g + 1) * G + t, lane);
#pragma unroll
            for (int t = 0; t < G; ++t) { post_row<XI, XO, HASY, HASH>(R0[t], tok0 + g * G + t, lane, pa, pb, pc, xnew, H); }
            if (g + 2 < CH / G) {
#pragma unroll
                for (int t = 0; t < G; ++t) post_load<XI, HASY>(R0[t], xold, y, tok0 + (g + 2) * G + t, lane); }
#pragma unroll
            for (int t = 0; t < G; ++t) { post_row<XI, XO, HASY, HASH>(R1[t], tok0 + (g + 1) * G + t, lane, pa, pb, pc, xnew, H); }
        }
    }
}

namespace nsa {
typedef _Float16 f16x8 __attribute__((ext_vector_type(8)));
typedef _Float16 f16x4 __attribute__((ext_vector_type(4)));
typedef float f32x4 __attribute__((ext_vector_type(4)));
typedef unsigned u32x4 __attribute__((ext_vector_type(4)));
typedef unsigned u32x2 __attribute__((ext_vector_type(2)));
constexpr int KP = 72;
constexpr int L_KT = 0, L_VT = 36864  , L_OF = 73728, L_IMPA = L_OF  , L_IMPB = L_OF + 64 * 65 * 4, L_MASK = L_OF + 65536, L_END = L_MASK + 512;
static_assert(2 * 64 * 65 * 4 <= 65536 && L_END <= 163840 - 64, "NSA LDS map");
constexpr float QSCALE = 0.125f * 1.4426950408889634f;

struct TileRegs { u32x4 k, v; };
__device__ __forceinline__ TileRegs tile_load(const h16* kbase, int kp, const h16* vbase, int vp, int tid) {
    TileRegs r;
    r.k = *(const u32x4*)(kbase + (size_t)(tid >> 3) * kp + 8 * (tid & 7));
    r.v = *(const u32x4*)(vbase + (size_t)(tid >> 3) * vp + 8 * (tid & 7));
    return r;
}
__device__ __forceinline__ void tile_store(LAS unsigned char* lds, int buf  , const TileRegs& r, int tid) {
    LAS h16* kt = (LAS h16*)(lds + L_KT) + buf * 64 * KP;
    *(LAS u32x4*)(kt + (tid >> 3) * KP + 8 * (tid & 7)) = r.k;
    LAS h16* vt = (LAS h16*)(lds + L_VT) + buf * 64 * KP;
    *(LAS u32x4*)(vt + (tid >> 3) * KP + 8 * (tid & 7)) = r.v;
}
__device__ __forceinline__ void tile_load_async(TileRegs& r, const h16* kbase, int kp, const h16* vbase, int vp, int tid) {
    const h16* ka = kbase + (size_t)(tid >> 3) * kp + 8 * (tid & 7); const h16* va = vbase + (size_t)(tid >> 3) * vp + 8 * (tid & 7);
    asm volatile("global_load_dwordx4 %0, %1, off" : "=v"(r.k) : "v"(ka) : "memory");
    asm volatile("global_load_dwordx4 %0, %1, off" : "=v"(r.v) : "v"(va) : "memory");
}
template <int N> __device__ __forceinline__ void tile_wait(TileRegs& r) {
    if (N == 2) asm volatile("s_waitcnt vmcnt(2)" : "+v"(r.k), "+v"(r.v) :: "memory"); else asm volatile("s_waitcnt vmcnt(0)" : "+v"(r.k), "+v"(r.v) :: "memory");
}
__device__ __forceinline__ float max_x16(float v) { return fmaxf(v, __shfl_xor(v, 16)); }
__device__ __forceinline__ float max_x32(float v) { return fmaxf(v, __shfl_xor(v, 32)); }
__device__ __forceinline__ float sum_x16(float v) { return v + __shfl_xor(v, 16); }
__device__ __forceinline__ float sum_x32(float v) { return v + __shfl_xor(v, 32); }
template <int CTRL> __device__ __forceinline__ float dpp_mv(float v) { return __builtin_bit_cast(float, __builtin_amdgcn_update_dpp(0, __builtin_bit_cast(int, v), CTRL, 0xF, 0xF, true)); }
__device__ __forceinline__ float sum_quad(float v) { v += __shfl_xor(v, 1); v += __shfl_xor(v, 2); return v; }
__device__ __forceinline__ f32x4 mfma16(f16x8 a, f16x8 b, f32x4 c) { return __builtin_amdgcn_mfma_f32_16x16x32_f16(a, b, c, 0, 0, 0); }

template <int QL, int QH>
__device__ __forceinline__ void qk_tiles(const LAS h16* kt_lds, const f16x8 (&qf)[2][2], int c, int g, f32x4 (&sc)[2][4]) {
    f16x8 kf[4][2];
#pragma unroll
    for (int kt = 0; kt < 4; ++kt) { kf[kt][0] = *(const LAS f16x8*)(kt_lds + (16 * kt + c) * KP + 8 * g); kf[kt][1] = *(const LAS f16x8*)(kt_lds + (16 * kt + c) * KP + 32 + 8 * g); }
#pragma unroll
    for (int kt = 0; kt < 4; ++kt)
#pragma unroll
        for (int qi = QL; qi < QH; ++qi) { f32x4 a = {0.f, 0.f, 0.f, 0.f}; a = mfma16(kf[kt][0], qf[qi][0], a); a = mfma16(kf[kt][1], qf[qi][1], a); sc[qi][kt] = a; }
}
template <int QL, int QH>
__device__ __forceinline__ void pv_tiles(const LAS h16* vt_lds, const f32x4 (&p)[2][4], int c, int g, f32x4 (&o)[4][2]) {
    f16x4 vlo[2][4], vhi[2][4];
#pragma unroll
    for (int kk = 0; kk < 2; ++kk)
#pragma unroll
        for (int dt = 0; dt < 4; ++dt) { vlo[kk][dt] = *(const LAS f16x4*)(vt_lds + (16 * dt + c) * KP + 32 * kk + 4 * g); vhi[kk][dt] = *(const LAS f16x4*)(vt_lds + (16 * dt + c) * KP + 32 * kk + 16 + 4 * g); }
#pragma unroll
    for (int kk = 0; kk < 2; ++kk) {
        f16x8 bf[2];
#pragma unroll
        for (int qi = QL; qi < QH; ++qi) { const f32x4 a = p[qi][2 * kk], b = p[qi][2 * kk + 1];
            bf[qi] = (f16x8){(_Float16)a[0], (_Float16)a[1], (_Float16)a[2], (_Float16)a[3], (_Float16)b[0], (_Float16)b[1], (_Float16)b[2], (_Float16)b[3]}; }
#pragma unroll
        for (int dt = 0; dt < 4; ++dt) {
            const f16x4 v0 = vlo[kk][dt], v1 = vhi[kk][dt];
            const f16x8 a = (f16x8){v0[0], v0[1], v0[2], v0[3], v1[0], v1[1], v1[2], v1[3]};
#pragma unroll
            for (int qi = QL; qi < QH; ++qi) o[dt][qi] = mfma16(a, bf[qi], o[dt][qi]);
        }
    }
}
__device__ __forceinline__ void apply_mask(f32x4 (&sc)[4], int mode, int lim) {
    if (mode == 1) {
#pragma unroll
        for (int kt = 0; kt < 4; ++kt)
#pragma unroll
            for (int r = 0; r < 4; ++r) sc[kt][r] = (16 * kt + r <= lim) ? sc[kt][r] : -1e30f;
    } else if (mode == 2) {
#pragma unroll
        for (int kt = 0; kt < 4; ++kt)
#pragma unroll
            for (int r = 0; r < 4; ++r) sc[kt][r] = (16 * kt + r > lim) ? sc[kt][r] : -1e30f;
    }
}
typedef float f32x2 __attribute__((ext_vector_type(2)));
__device__ __forceinline__ float max3f(float a, float b, float c) { float r; asm("v_max3_f32 %0, %1, %2, %3" : "=v"(r) : "v"(a), "v"(b), "v"(c)); return r; }
__device__ __forceinline__ void softmax_step(f32x4 (&sc)[4], bool row_on, float& m, float& l, float& f_out) {
    float mx = max3f(sc[0][0], sc[0][1], sc[0][2]);
    mx = max3f(mx, sc[0][3], sc[1][0]); mx = max3f(mx, sc[1][1], sc[1][2]); mx = max3f(mx, sc[1][3], sc[2][0]); mx = max3f(mx, sc[2][1], sc[2][2]);
    mx = max3f(mx, sc[2][3], sc[3][0]); mx = max3f(mx, sc[3][1], sc[3][2]); mx = fmaxf(mx, sc[3][3]);
    mx = row_on ? mx : -1e30f;
    mx = max_x16(mx); mx = max_x32(mx);
    const float mn = fmaxf(m, mx), f = __builtin_amdgcn_exp2f(m - mn), mu = row_on ? fmaxf(mn, -1e20f) : 1e30f;
    const f32x2 mu2 = {mu, mu};
    f32x2 sum2 = {0.f, 0.f};
#pragma unroll
    for (int kt = 0; kt < 4; ++kt) {
        f32x2 a = (f32x2){sc[kt][0], sc[kt][1]} - mu2, b = (f32x2){sc[kt][2], sc[kt][3]} - mu2;
        a.x = __builtin_amdgcn_exp2f(a.x); a.y = __builtin_amdgcn_exp2f(a.y); b.x = __builtin_amdgcn_exp2f(b.x); b.y = __builtin_amdgcn_exp2f(b.y);
        sc[kt] = (f32x4){a.x, a.y, b.x, b.y}; sum2 = sum2 + a; sum2 = sum2 + b;
    }
    l = l * f + (sum2.x + sum2.y); m = mn; f_out = f;
}

struct AttnArgs { const h16* QK32; const h16* P16; const h16* KC; const h16* VCT;   const h16* VTG;   const float* gate_b; const float* out_g; h16* O16; };

__device__ __forceinline__ void attn_item(const AttnArgs& A, int b, int qt, LAS unsigned char* lds) {
    int tid_ = threadIdx.x; asm volatile("" : "+v"(tid_)); const int tid = tid_, lane = tid & 63, w = tid >> 6, c = lane & 15, g = lane >> 4;
    const size_t tok0 = (size_t)b * S + 64 * qt;
    LAS float* impa = (LAS float*)(lds + L_IMPA); LAS float* impb = (LAS float*)(lds + L_IMPB);
    LAS unsigned char* maskb = lds + L_MASK;
    LAS f32x4* ofl = (LAS f32x4*)(lds + L_OF);
    const LAS h16* KT = (const LAS h16*)(lds + L_KT); const LAS h16* VT = (const LAS h16*)(lds + L_VT);
    int tl[2]; f16x8 qf[2][2];
    const int hh = c & 3;
#pragma unroll
    for (int qi = 0; qi < 2; ++qi) {
        tl[qi] = 8 * w + 4 * qi + (c >> 2);
        const h16* qp = A.QK32 + (tok0 + tl[qi]) * QKP + hh * 64 + 8 * g;
#pragma unroll
        for (int ks = 0; ks < 2; ++ks) qf[qi][ks] = *(const f16x8*)(qp + 32 * ks);
    }
    for (int i = tid; i < 64 * 65; i += 512) { impa[i] = 0.f; impb[i] = 0.f; }
    const int nblk_c = (4 * qt + 3 + 63) >> 6;
    int nvis[2];
#pragma unroll
    for (int qi = 0; qi < 2; ++qi) { const int s = 64 * qt + tl[qi]; nvis[qi] = (s >= 31) ? ((s - 31) / 16 + 1) : 0; }
    const h16* kcb = A.KC + (size_t)b * 256 * 64; const h16* vcb = A.VCT + (size_t)b * 64 * 256;
    float m_c[2] = {-1e30f, -1e30f}, l_c[2] = {0.f, 0.f};
    f32x4 ofin[4][2];
#pragma unroll
    for (int dt = 0; dt < 4; ++dt)
#pragma unroll
        for (int qi = 0; qi < 2; ++qi) ofin[dt][qi] = (f32x4){0.f, 0.f, 0.f, 0.f};
    float glog[2][3];
#pragma unroll
    for (int qi = 0; qi < 2; ++qi) { const h16* gp = A.P16 + (tok0 + tl[qi]) * PITCH + PC_GTS; glog[qi][0] = (float)gp[hh]; glog[qi][1] = (float)gp[4 + hh]; glog[qi][2] = (float)gp[8 + hh]; }
    {
        TileRegs r[4];
#pragma unroll
        for (int u = 0; u < 4; ++u) if (u < nblk_c) r[u] = tile_load(kcb + (size_t)u * 64 * 64, 64, vcb + u * 64, 256, tid);
#pragma unroll
        for (int u = 0; u < 4; ++u) if (u < nblk_c) tile_store(lds, u, r[u], tid);
    }
    __syncthreads();
#pragma unroll 1
    for (int pass = 0; pass < 2; ++pass) {
        float inv_l[2];
        if (pass == 1) {
#pragma unroll
            for (int qi = 0; qi < 2; ++qi) { float lt = l_c[qi]; lt = sum_x16(lt); lt = sum_x32(lt); inv_l[qi] = lt > 0.f ? 1.f / lt : 0.f; }
        }
#pragma unroll 1
        for (int blk = 0; blk < nblk_c; ++blk) {
            f32x4 sc[2][4];
            qk_tiles<0, 2>(KT + blk * 64 * KP, qf, c, g, sc);
#pragma unroll
            for (int qi = 0; qi < 2; ++qi) {
                apply_mask(sc[qi], 1, nvis[qi] - 1 - 64 * blk - 4 * g);
                if (pass == 0) { float f; softmax_step(sc[qi], true, m_c[qi], l_c[qi], f); }
                else {
                    const float mu = fmaxf(m_c[qi], -1e20f);
#pragma unroll
                    for (int kt = 0; kt < 4; ++kt) {
#pragma unroll
                        for (int r = 0; r < 4; ++r) sc[qi][kt][r] = __builtin_amdgcn_exp2f(sc[qi][kt][r] - mu) * inv_l[qi];
                        float e0 = (sc[qi][kt][0] + sc[qi][kt][1]) + (sc[qi][kt][2] + sc[qi][kt][3]), e1 = sc[qi][kt][3];
                        e0 = sum_quad(e0); e1 = sum_quad(e1);
                        const int jj = 16 * blk + 4 * kt + g;
                        if (hh == 0) { impa[tl[qi] * 65 + jj] = e0; if (jj + 1 < 64) impb[tl[qi] * 65 + jj + 1] = e1; }
                    }
                }
            }
            if (pass == 1) pv_tiles<0, 2>(VT + blk * 64 * KP, sc, c, g, ofin);
        }
    }
    __syncthreads();
    {
        const int t = tid >> 3, jg = tid & 7;
        unsigned long long key[8];
#pragma unroll
        for (int i = 0; i < 8; ++i) { const int j = 8 * jg + i; const float imp = impa[t * 65 + j] + impb[t * 65 + j];
            const bool forced = (j == 0) || (j == qt) || (j == qt - 1); const float scv = forced ? 1e9f : (j <= qt ? imp : -1e30f);
            const unsigned fb = __builtin_bit_cast(unsigned, scv), ob = (fb & 0x80000000u) ? ~fb : (fb | 0x80000000u);
            key[i] = ((unsigned long long)ob << 32) | (unsigned)(63 - j); }
        __syncthreads();
        LAS unsigned long long* keys = (LAS unsigned long long*)(lds + L_IMPA);
#pragma unroll
        for (int i = 0; i < 8; ++i) keys[t * 65 + 8 * jg + i] = key[i];
        __syncthreads();
        int rank[8];
#pragma unroll
        for (int i = 0; i < 8; ++i) rank[i] = 0;
        for (int j2 = 0; j2 < 64; ++j2) { const unsigned long long k2 = keys[t * 65 + j2];
#pragma unroll
            for (int i = 0; i < 8; ++i) rank[i] += (k2 > key[i]) ? 1 : 0; }
        unsigned bits = 0;
#pragma unroll
        for (int i = 0; i < 8; ++i) bits |= ((rank[i] < 16 && (8 * jg + i) <= qt) ? 1u : 0u) << i;
        maskb[t * 8 + jg] = (unsigned char)bits;
    }
    __syncthreads();
    unsigned mlo[2], mhi[2];
#pragma unroll
    for (int qi = 0; qi < 2; ++qi) { const LAS unsigned* mp = (const LAS unsigned*)(lds + L_MASK) + 2 * tl[qi]; mlo[qi] = mp[0]; mhi[qi] = mp[1]; }
    float gsel[2], gwin[2];
#pragma unroll
    for (int qi = 0; qi < 2; ++qi) {
        const float g0 = __builtin_amdgcn_rcpf(1.f + __expf(-(glog[qi][0] + A.gate_b[hh])));
        gsel[qi] = __builtin_amdgcn_rcpf(1.f + __expf(-(glog[qi][1] + A.gate_b[4 + hh])));
        gwin[qi] = __builtin_amdgcn_rcpf(1.f + __expf(-(glog[qi][2] + A.gate_b[8 + hh])));
#pragma unroll
        for (int dt = 0; dt < 4; ++dt) ofl[(dt * 2 + qi) * 512 + tid] = ofin[dt][qi] * g0;
    }
    const h16* Pb = A.P16 + (size_t)b * S * PITCH;
    const int jw0 = qt >= 8 ? qt - 8 : 0;
#pragma unroll 1
    for (int br = 0; br < 2; ++br) {
        const bool win = br == 1;
        const int j0 = win ? jw0 : 0, nsteps = qt - j0 + 1, kcol = win ? PC_KW : PC_KS;
        const h16* Vb = A.VTG + ((size_t)b * 2 + br) * 64 * S;
        float m_b[2] = {-1e30f, -1e30f}, l_b[2] = {0.f, 0.f};
        f32x4 o_b[4][2];
#pragma unroll
        for (int dt = 0; dt < 4; ++dt)
#pragma unroll
            for (int qi = 0; qi < 2; ++qi) o_b[dt][qi] = (f32x4){0.f, 0.f, 0.f, 0.f};
        TileRegs R[4];
#define NSA_LOADG(G0) do { _Pragma("unroll") for (int u = 0; u < 4; ++u) if ((G0) + u < nsteps) R[u] = tile_load(Pb + (size_t)(j0 + (G0) + u) * 64 * PITCH + kcol, PITCH, Vb + 64 * (j0 + (G0) + u), S, tid); } while (0)
#define NSA_STOREG(G0) do { _Pragma("unroll") for (int u = 0; u < 4; ++u) if ((G0) + u < nsteps) tile_store(lds, u, R[u], tid); } while (0)
        NSA_LOADG(0); NSA_STOREG(0);
        __syncthreads();
#pragma unroll 1
        for (int g0 = 0; g0 < nsteps; g0 += 4) {
            NSA_LOADG(g0 + 4);
#pragma unroll
            for (int u = 0; u < 4; ++u) {
                if (g0 + u < nsteps) {
                    const int jb = j0 + g0 + u;
                    const bool selb0 = win ? true : ((jb < 32) ? ((mlo[0] >> jb) & 1u) : ((mhi[0] >> (jb - 32)) & 1u));
                    const bool selb1 = win ? true : ((jb < 32) ? ((mlo[1] >> jb) & 1u) : ((mhi[1] >> (jb - 32)) & 1u));
                    const bool a0 = __any(selb0), a1 = __any(selb1);
                    const int mode = (jb == qt) ? 1 : ((win && jb == qt - 8) ? 2 : 0);
#define NSA_STEP(QL, QH) do { f32x4 sc[2][4]; \
                        qk_tiles<QL, QH>(KT + u * 64 * KP, qf, c, g, sc); \
                        _Pragma("unroll") for (int qi = QL; qi < QH; ++qi) { \
                            apply_mask(sc[qi], mode, tl[qi] - 4 * g); \
                            float f; softmax_step(sc[qi], qi ? selb1 : selb0, m_b[qi], l_b[qi], f); \
                            if (__any(f != 1.f)) { _Pragma("unroll") for (int dt = 0; dt < 4; ++dt) o_b[dt][qi] = o_b[dt][qi] * f; } } \
                        pv_tiles<QL, QH>(VT + u * 64 * KP, sc, c, g, o_b); } while (0)
                    if (a0 && a1) NSA_STEP(0, 2); else if (a0) NSA_STEP(0, 1); else if (a1) NSA_STEP(1, 2);
#undef NSA_STEP
                }
            }
            __syncthreads();
            if (g0 + 4 < nsteps) { NSA_STOREG(g0 + 4); __syncthreads(); }
        }
#undef NSA_LOADG
#undef NSA_STOREG
#pragma unroll
        for (int qi = 0; qi < 2; ++qi) {
            float lb = l_b[qi]; lb = sum_x16(lb); lb = sum_x32(lb);
            const float cb = (win ? gwin[qi] : gsel[qi]) / lb;
#pragma unroll
            for (int dt = 0; dt < 4; ++dt) ofl[(dt * 2 + qi) * 512 + tid] = ofl[(dt * 2 + qi) * 512 + tid] + o_b[dt][qi] * cb;
        }
    }
#pragma unroll
    for (int qi = 0; qi < 2; ++qi) {
        float ss = 0.f;
#pragma unroll
        for (int dt = 0; dt < 4; ++dt) ofin[dt][qi] = ofl[(dt * 2 + qi) * 512 + tid];
#pragma unroll
        for (int dt = 0; dt < 4; ++dt)
            ss += (ofin[dt][qi][0] * ofin[dt][qi][0] + ofin[dt][qi][1] * ofin[dt][qi][1]) + (ofin[dt][qi][2] * ofin[dt][qi][2] + ofin[dt][qi][3] * ofin[dt][qi][3]);
        ss = sum_x16(ss); ss = sum_x32(ss); ss = sum_quad(ss);
        const float rstd = rsqrtf(ss * (1.f / 256.f) + 1e-6f);
        h16* op = A.O16 + (tok0 + tl[qi]) * D + hh * 64;
#pragma unroll
        for (int dt = 0; dt < 4; ++dt) { const int d0 = 16 * dt + 4 * g; const f32x4 gg = *(const f32x4*)(A.out_g + hh * 64 + d0);
            u32x2 wv; wv.x = pg8::pk_f16(ofin[dt][qi][0] * rstd * gg[0], ofin[dt][qi][1] * rstd * gg[1]); wv.y = pg8::pk_f16(ofin[dt][qi][2] * rstd * gg[2], ofin[dt][qi][3] * rstd * gg[3]);
            *(u32x2*)(op + d0) = wv; }
    }
    __syncthreads();
}

struct CmpArgs { const h16* QK32; const h16* P16; const h16* W1T;   const float* bias;   const float* w2k; const float* w2v; h16* KC; h16* VC; };
constexpr int TP = 72;
__device__ __forceinline__ void compress_item(const CmpArgs& A, int b, int kv, int ng, LAS unsigned char* lds) {
    int tid_ = threadIdx.x; asm volatile("" : "+v"(tid_)); const int tid = tid_, lane = tid & 63, w = tid >> 6, c = lane & 15, g = lane >> 4;
    LAS h16* TOK = (LAS h16*)lds;
    LAS float* RED = (LAS float*)(lds + 272 * TP * 2);
    LAS float* HID = RED + 2 * 16 * 64;
    const int t0 = 256 * ng;
    for (int e = tid; e < 272 * 8; e += 512) {
        const int t = e >> 3, ch = e & 7; const int tok = t0 + t;
        u32x4 v = {0u, 0u, 0u, 0u};
        if (tok < S) {
            if (kv == 0) v = *(const u32x4*)(A.QK32 + ((size_t)b * S + tok) * QKP + 256 + 8 * ch);
            else v = *(const u32x4*)(A.P16 + ((size_t)b * S + tok) * PITCH + PC_VC + 8 * ch);
        }
        *(LAS u32x4*)(TOK + t * TP + 8 * ch) = v;
    }
    __syncthreads();
    {
        const int nt = w & 3, kh = w >> 2;
        const h16* wb = A.W1T + ((size_t)kv * 64 + 16 * nt + c) * 2048 + 8 * g;
        f32x4 acc = {0.f, 0.f, 0.f, 0.f};
#pragma unroll 1
        for (int k8 = 32 * kh; k8 < 32 * kh + 32; k8 += 8) {
            f16x8 bw[8];
#pragma unroll
            for (int u = 0; u < 8; ++u) bw[u] = *(const f16x8*)(wb + 32 * (k8 + u));
#pragma unroll
            for (int u = 0; u < 8; ++u) { const int ks = k8 + u;
                const f16x8 a = *(const LAS f16x8*)(TOK + (16 * c + (ks >> 1)) * TP + 32 * (ks & 1) + 8 * g);
                acc = mfma16(a, bw[u], acc); }
        }
#pragma unroll
        for (int r = 0; r < 4; ++r) RED[(kh * 16 + 4 * g + r) * 64 + 16 * nt + c] = acc[r];
    }
    __syncthreads();
    for (int e = tid; e < 1024; e += 512) { const int n = e >> 6, j = e & 63; const float x = RED[n * 64 + j] + RED[(16 + n) * 64 + j] + A.bias[kv * 64 + j];
        HID[n * 64 + j] = 0.5f * x * (1.f + tanhf(0.7978845608028654f * (x + 0.044715f * x * x * x))); }
    __syncthreads();
    const float* w2 = kv == 0 ? A.w2k : A.w2v; h16* outp = kv == 0 ? A.KC : A.VC;
    for (int e = tid; e < 1024; e += 512) { const int n = e >> 6, j = e & 63; float s = 0.f;
        for (int i = 0; i < 64; ++i) s += HID[n * 64 + i] * w2[i * 64 + j];
        const int nn = 16 * ng + n;
        const h16 ov = (nn < NCMP) ? (h16)s : (h16)0.f;
        if (kv == 0) outp[((size_t)b * 256 + nn) * 64 + j] = ov; else outp[((size_t)b * 64 + j) * 256 + nn] = ov; }
    __syncthreads();
}
}
namespace mls {
using nsa::f16x8; using nsa::f32x4; using nsa::u32x4; using nsa::u32x2; using nsa::mfma16;
constexpr int KP = 72;
#define LDS_BAR() do { asm volatile("s_waitcnt lgkmcnt(0)" ::: "memory"); __builtin_amdgcn_s_barrier(); asm volatile("" ::: "memory"); } while (0)
constexpr size_t WS_KVB = WS_Y32;
constexpr size_t WS_KSUM = WS_Y32 + 48 * MiB;
constexpr size_t WS_MUB = WS_KSUM + 1 * MiB;
constexpr size_t WS_GT = 505 * MiB;
struct Args { const h16* P16; const float *conv_w, *conv_b, *ig_b, *fg_b, *norm_g; float* KVB; float* KSUM; float* MUB; h16* O16; float* GT; const h16* CW16; };

__device__ __forceinline__ void mm64(const LAS h16* A, const LAS h16* Bt, int w, int c, int g, f32x4 (&acc)[2]) {
    const int mi = w >> 1;
    const f16x8 a0 = *(const LAS f16x8*)(A + (16 * mi + c) * KP + 8 * g), a1 = *(const LAS f16x8*)(A + (16 * mi + c) * KP + 32 + 8 * g);
#pragma unroll
    for (int n = 0; n < 2; ++n) { const int ni = 2 * (w & 1) + n;
        const f16x8 b0 = *(const LAS f16x8*)(Bt + (16 * ni + c) * KP + 8 * g), b1 = *(const LAS f16x8*)(Bt + (16 * ni + c) * KP + 32 + 8 * g);
        acc[n] = mfma16(a0, b0, acc[n]); acc[n] = mfma16(a1, b1, acc[n]); }
}
__device__ __forceinline__ float half_lo(unsigned u) { return (float)__builtin_bit_cast(_Float16, (unsigned short)(u & 0xffffu)); }
__device__ __forceinline__ float half_hi(unsigned u) { return (float)__builtin_bit_cast(_Float16, (unsigned short)(u >> 16)); }
struct ConvTaps { u32x4 x[4]; };
__device__ __forceinline__ void conv_load(ConvTaps& T, const h16* Pbatch, int tloc, int col) {
#pragma unroll
    for (int i = 0; i < 4; ++i) { const int tt = tloc - 3 + i; T.x[i] = (u32x4){0u, 0u, 0u, 0u}; if (tt >= 0) T.x[i] = *(const u32x4*)(Pbatch + (size_t)tt * PITCH + col); }
}
typedef _Float16 h16x2 __attribute__((ext_vector_type(2)));
__device__ __forceinline__ void conv_apply(const ConvTaps& T, const h16* cw16, float scale, float (&out)[8]) {
    float acc[8];
    { const u32x4 bw = *(const u32x4*)(cw16 + 4 * 768); acc[0] = half_lo(bw.x); acc[1] = half_hi(bw.x); acc[2] = half_lo(bw.y); acc[3] = half_hi(bw.y); acc[4] = half_lo(bw.z); acc[5] = half_hi(bw.z); acc[6] = half_lo(bw.w); acc[7] = half_hi(bw.w); }
#pragma unroll
    for (int i = 0; i < 4; ++i) { const u32x4 x = T.x[i], wv = *(const u32x4*)(cw16 + i * 768);
        acc[0] += half_lo(x.x) * half_lo(wv.x); acc[1] += half_hi(x.x) * half_hi(wv.x); acc[2] += half_lo(x.y) * half_lo(wv.y); acc[3] += half_hi(x.y) * half_hi(wv.y);
        acc[4] += half_lo(x.z) * half_lo(wv.z); acc[5] += half_hi(x.z) * half_hi(wv.z); acc[6] += half_lo(x.w) * half_lo(wv.w); acc[7] += half_hi(x.w) * half_hi(wv.w); }
#pragma unroll
    for (int e = 0; e < 8; ++e) out[e] = acc[e] * __builtin_amdgcn_rcpf(1.f + __expf(-acc[e])) * scale;
}
__device__ __forceinline__ void conv8(const h16* Pbatch, int tloc, int col, const h16* cw16, float scale, float (&out)[8]) {
    ConvTaps T; conv_load(T, Pbatch, tloc, col); conv_apply(T, cw16, scale, out);
}
__device__ __forceinline__ float log_sigmoid(float x) { return fminf(x, 0.f) - __logf(1.f + __expf(-fabsf(x))); }

template <int CTRL, int RM> __device__ __forceinline__ float dpp_id(float idv, float v) { return __builtin_bit_cast(float, __builtin_amdgcn_update_dpp(__builtin_bit_cast(int, idv), __builtin_bit_cast(int, v), CTRL, RM, 0xF, false)); }
__device__ __forceinline__ float scan_sum64(float v) {
    v += dpp_id<0x111, 0xF>(0.f, v); v += dpp_id<0x112, 0xF>(0.f, v); v += dpp_id<0x114, 0xF>(0.f, v); v += dpp_id<0x118, 0xF>(0.f, v);
    v += dpp_id<0x142, 0xA>(0.f, v); v += dpp_id<0x143, 0xC>(0.f, v); return v; }
__device__ __forceinline__ float scan_max64(float v) { const float ni = -3.0e38f;
    v = fmaxf(v, dpp_id<0x111, 0xF>(ni, v)); v = fmaxf(v, dpp_id<0x112, 0xF>(ni, v)); v = fmaxf(v, dpp_id<0x114, 0xF>(ni, v)); v = fmaxf(v, dpp_id<0x118, 0xF>(ni, v));
    v = fmaxf(v, dpp_id<0x142, 0xA>(ni, v)); v = fmaxf(v, dpp_id<0x143, 0xC>(ni, v)); return v; }
__device__ __forceinline__ float lane63(float v) { return __builtin_bit_cast(float, __builtin_amdgcn_readlane(__builtin_bit_cast(int, v), 63)); }
__device__ __forceinline__ void m1_item(const Args& A, int bh, int ck, LAS unsigned char* lds) {
    int tid_ = threadIdx.x; asm volatile("" : "+v"(tid_)); const int tid = tid_, lane = tid & 63, w = tid >> 6, c = lane & 15, g = lane >> 4;
    const int b = bh / H_ML, h = bh % H_ML;
    LAS h16* KT2 = (LAS h16*)lds;
    LAS h16* WVT = KT2 + 64 * KP;
    LAS float* WGT = (LAS float*)(lds + 2 * 64 * KP * 2);
    const h16* Pb = A.P16 + (size_t)b * S * PITCH;
    const int tloc = 64 * ck + lane;
    if (w == 0) {
        const h16* pr = Pb + (size_t)tloc * PITCH;
        const float li = (float)pr[PC_IG + h] + A.ig_b[h];
        const float lf = log_sigmoid((float)pr[PC_FG + h] + A.fg_b[h]);
        const float bs = scan_sum64(lf);
        const float gt = lane63(bs);
        const float u = gt - bs + li;
        const float mu = lane63(scan_max64(u));
        WGT[lane] = __expf(u - mu);
        if (lane == 0) { A.MUB[bh * 64 + ck] = mu; A.MUB[3072 + bh * 64 + ck] = gt; }
        const float as = li - bs; const float pm = scan_max64(as);
        float* gto = A.GT + ((size_t)bh * 64 + ck) * 192; gto[lane] = bs; gto[64 + lane] = as; gto[128 + lane] = pm;
    }
    float kc[8];
    conv8(Pb, tloc, PC_MK + h * 64 + 8 * w, A.CW16 + 384 + h * 64 + 8 * w, 0.125f, kc);
    LDS_BAR();
    const float wg = WGT[lane];
    const u32x4 vv = *(const u32x4*)(Pb + (size_t)tloc * PITCH + PC_MV + h * 64 + 8 * w);
    const float v8[8] = {half_lo(vv.x), half_hi(vv.x), half_lo(vv.y), half_hi(vv.y), half_lo(vv.z), half_hi(vv.z), half_lo(vv.w), half_hi(vv.w)};
#pragma unroll
    for (int e = 0; e < 8; ++e) { KT2[(8 * w + e) * KP + lane] = (h16)kc[e]; WVT[(8 * w + e) * KP + lane] = (h16)(v8[e] * wg); }
    LDS_BAR();
    f32x4 acc[2] = {{0.f, 0.f, 0.f, 0.f}, {0.f, 0.f, 0.f, 0.f}};
    mm64(WVT, KT2, w, c, g, acc);
    float* kvo = A.KVB + ((size_t)bh * 64 + ck) * 4096;
#pragma unroll
    for (int n = 0; n < 2; ++n)
#pragma unroll
        for (int r = 0; r < 4; ++r) kvo[(16 * (w >> 1) + 4 * g + r) * 64 + 16 * (2 * (w & 1) + n) + c] = acc[n][r];
    if (w == 1) { float s = 0.f;
        for (int t = 0; t < 64; ++t) s += (float)KT2[lane * KP + t] * WGT[t];
        A.KSUM[((size_t)bh * 64 + ck) * 64 + lane] = s; }
    LDS_BAR();
}

__device__ __forceinline__ void m2_item(const Args& A, int bh, int qr) {
    int tid_ = threadIdx.x; asm volatile("" : "+v"(tid_)); const int tid = tid_;
    float* kv = A.KVB + (size_t)bh * 64 * 4096 + qr * 1024 + tid;
    float* ks = A.KSUM + (size_t)bh * 64 * 64 + tid;
    const bool don = (qr == 0 && tid < 64);
    float C0 = 0.f, C1 = 0.f, n = 0.f, m = 0.f;
#pragma unroll 1
    for (int c8 = 0; c8 < 64; c8 += 8) {
        float x0[8], x1[8], xn[8], mu[8], gt[8];
#pragma unroll
        for (int u = 0; u < 8; ++u) { x0[u] = kv[(size_t)(c8 + u) * 4096]; x1[u] = kv[(size_t)(c8 + u) * 4096 + 512]; xn[u] = don ? ks[(c8 + u) * 64] : 0.f;
            mu[u] = A.MUB[bh * 64 + c8 + u]; gt[u] = A.MUB[3072 + bh * 64 + c8 + u]; }
#pragma unroll
        for (int u = 0; u < 8; ++u) { const int ck = c8 + u;
            const float mn = fmaxf(gt[u] + m, mu[u]), dec = __expf(gt[u] + m - mn), wl = __expf(mu[u] - mn);
            kv[(size_t)ck * 4096] = C0; kv[(size_t)ck * 4096 + 512] = C1;
            if (don) ks[ck * 64] = n;
            if (qr == 0 && tid == 0) A.MUB[2 * 3072 + bh * 64 + ck] = m;
            C0 = dec * C0 + wl * x0[u]; C1 = dec * C1 + wl * x1[u]; n = dec * n + wl * xn[u]; m = mn; }
    }
}

struct M3Regs { ConvTaps q, k; u32x4 v, og; f32x4 c0, c1; float bs, as, pm, n0, m0; };
__device__ __forceinline__ void m3_load(M3Regs& R, const Args& A, int item, int tid) {
    const int bh = item >> 6, ck = item & 63, b = bh / H_ML, h = bh % H_ML, lane = tid & 63, w = tid >> 6;
    const h16* Pb = A.P16 + (size_t)b * S * PITCH; const int tloc = 64 * ck + lane;
    conv_load(R.q, Pb, tloc, PC_MQ + h * 64 + 8 * w); conv_load(R.k, Pb, tloc, PC_MK + h * 64 + 8 * w);
    R.v = *(const u32x4*)(Pb + (size_t)tloc * PITCH + PC_MV + h * 64 + 8 * w);
    const float* cp = A.KVB + ((size_t)bh * 64 + ck) * 4096 + (tid >> 3) * 64 + 8 * (tid & 7);
    R.c0 = *(const f32x4*)cp; R.c1 = *(const f32x4*)(cp + 4);
    R.og = *(const u32x4*)(A.P16 + ((size_t)b * S + 64 * ck + (tid >> 3)) * PITCH + PC_MO + h * 64 + 8 * (tid & 7));
    const float* gti = A.GT + ((size_t)bh * 64 + ck) * 192; R.bs = gti[lane]; R.as = gti[64 + lane]; R.pm = gti[128 + lane];
    R.n0 = A.KSUM[((size_t)bh * 64 + ck) * 64 + lane]; R.m0 = A.MUB[2 * 3072 + bh * 64 + ck];
}
__device__ __forceinline__ void m3_item(const Args& A, int item, int next_item, M3Regs& R, LAS unsigned char* lds) {
    int tid_ = threadIdx.x; asm volatile("" : "+v"(tid_)); const int tid = tid_, lane = tid & 63, w = tid >> 6, c = lane & 15, g = lane >> 4;
    const int bh = item >> 6, ck = item & 63, b = bh / H_ML, h = bh % H_ML;
    LAS h16* Q16 = (LAS h16*)lds;
    LAS h16* K16 = Q16 + 64 * KP;
    LAS h16* VT2 = K16 + 64 * KP;
    LAS h16* C016 = VT2 + 64 * KP;
    LAS h16* SM16 = C016 + 64 * KP;
    LAS float* HV = (LAS float*)(lds + 5 * 64 * KP * 2);
    LAS float* BJ = HV + 64 * 65; LAS float* AS = BJ + 64; LAS float* MJ = AS + 64; LAS float* WI = MJ + 64; LAS float* N0 = WI + 64; LAS float* DEN = N0 + 64;
    const float m0 = R.m0;
    if (w == 0) {
        const float bs = R.bs, mj = bs + fmaxf(m0, R.pm);
        BJ[lane] = bs; AS[lane] = R.as; MJ[lane] = mj; WI[lane] = __expf(bs + m0 - mj);
        N0[lane] = R.n0;
    }
    u32x4 og;
    {   float q8[8], k8[8];
        conv_apply(R.q, A.CW16 + h * 64 + 8 * w, 1.f, q8);
        conv_apply(R.k, A.CW16 + 384 + h * 64 + 8 * w, 0.125f, k8);
        u32x4 qo, ko;
        qo.x = pg8::pk_f16(q8[0], q8[1]); qo.y = pg8::pk_f16(q8[2], q8[3]); qo.z = pg8::pk_f16(q8[4], q8[5]); qo.w = pg8::pk_f16(q8[6], q8[7]);
        ko.x = pg8::pk_f16(k8[0], k8[1]); ko.y = pg8::pk_f16(k8[2], k8[3]); ko.z = pg8::pk_f16(k8[4], k8[5]); ko.w = pg8::pk_f16(k8[6], k8[7]);
        *(LAS u32x4*)(Q16 + lane * KP + 8 * w) = qo; *(LAS u32x4*)(K16 + lane * KP + 8 * w) = ko;
        const u32x4 vv = R.v;
        LAS unsigned short* vt = (LAS unsigned short*)VT2 + (8 * w) * KP + lane;
        vt[0 * KP] = (unsigned short)(vv.x & 0xffffu); vt[1 * KP] = (unsigned short)(vv.x >> 16); vt[2 * KP] = (unsigned short)(vv.y & 0xffffu); vt[3 * KP] = (unsigned short)(vv.y >> 16);
        vt[4 * KP] = (unsigned short)(vv.z & 0xffffu); vt[5 * KP] = (unsigned short)(vv.z >> 16); vt[6 * KP] = (unsigned short)(vv.w & 0xffffu); vt[7 * KP] = (unsigned short)(vv.w >> 16);
        const f32x4 c0 = R.c0, c1 = R.c1;
        u32x4 co; co.x = pg8::pk_f16(c0[0], c0[1]); co.y = pg8::pk_f16(c0[2], c0[3]); co.z = pg8::pk_f16(c1[0], c1[1]); co.w = pg8::pk_f16(c1[2], c1[3]);
        *(LAS u32x4*)(C016 + (tid >> 3) * KP + 8 * (tid & 7)) = co;
        og = R.og;
    }
    if (next_item >= 0) m3_load(R, A, next_item, tid);
    LDS_BAR();
    {
        f32x4 acc[2] = {{0.f, 0.f, 0.f, 0.f}, {0.f, 0.f, 0.f, 0.f}};
        mm64(Q16, K16, w, c, g, acc);
#pragma unroll
        for (int n = 0; n < 2; ++n)
#pragma unroll
            for (int r = 0; r < 4; ++r) { const int j = 16 * (w >> 1) + 4 * g + r, s = 16 * (2 * (w & 1) + n) + c;
                const float v = (s <= j) ? __expf(BJ[j] + AS[s] - MJ[j]) * acc[n][r] : 0.f;
                SM16[j * KP + s] = (h16)v; }
    }
    LDS_BAR();
    {
        const int j = tid >> 3, sg = tid & 7; float rs = 0.f, nq = 0.f;
#pragma unroll
        for (int e = 0; e < 8; ++e) { rs += (float)SM16[j * KP + 8 * sg + e]; nq += (float)Q16[j * KP + 8 * sg + e] * N0[8 * sg + e]; }
        rs += __shfl_xor(rs, 1); rs += __shfl_xor(rs, 2); rs += __shfl_xor(rs, 4);
        nq += __shfl_xor(nq, 1); nq += __shfl_xor(nq, 2); nq += __shfl_xor(nq, 4);
        if (sg == 0) DEN[j] = fmaxf(fabsf(WI[j] * nq + rs), __expf(-MJ[j]));
    }
    f32x4 a1[2] = {{0.f, 0.f, 0.f, 0.f}, {0.f, 0.f, 0.f, 0.f}}, a2[2] = {{0.f, 0.f, 0.f, 0.f}, {0.f, 0.f, 0.f, 0.f}};
    mm64(Q16, C016, w, c, g, a1);
    mm64(SM16, VT2, w, c, g, a2);
    LDS_BAR();
#pragma unroll
    for (int n = 0; n < 2; ++n)
#pragma unroll
        for (int r = 0; r < 4; ++r) { const int j = 16 * (w >> 1) + 4 * g + r, d = 16 * (2 * (w & 1) + n) + c;
            HV[j * 65 + d] = (WI[j] * a1[n][r] + a2[n][r]) * __builtin_amdgcn_rcpf(DEN[j]); }
    LDS_BAR();
    {   const int j = tid >> 3, sg = tid & 7; float hv[8], ss = 0.f;
#pragma unroll
        for (int e = 0; e < 8; ++e) { hv[e] = HV[j * 65 + 8 * sg + e]; ss += hv[e] * hv[e]; }
        ss += __shfl_xor(ss, 1); ss += __shfl_xor(ss, 2); ss += __shfl_xor(ss, 4);
        const float rstd = rsqrtf(ss * (1.f / 64.f) + 1e-6f);
        const size_t tok = (size_t)b * S + 64 * ck + j;
        const float o8[8] = {half_lo(og.x), half_hi(og.x), half_lo(og.y), half_hi(og.y), half_lo(og.z), half_hi(og.z), half_lo(og.w), half_hi(og.w)};
        const float* ng = A.norm_g + h * 64 + 8 * sg;
        float r8[8];
#pragma unroll
        for (int e = 0; e < 8; ++e) r8[e] = hv[e] * rstd * ng[e] * __builtin_amdgcn_rcpf(1.f + __expf(-o8[e]));
        u32x4 ov; ov.x = pg8::pk_f16(r8[0], r8[1]); ov.y = pg8::pk_f16(r8[2], r8[3]); ov.z = pg8::pk_f16(r8[4], r8[5]); ov.w = pg8::pk_f16(r8[6], r8[7]);
        *(u32x4*)(A.O16 + tok * D + C_ATT + C_RW + h * 64 + 8 * sg) = ov;
    }
    LDS_BAR();
}
}
namespace rwk {
using nsa::f16x8; using nsa::f16x4; using nsa::f32x4; using nsa::u32x4; using nsa::u32x2; using nsa::mfma16;
constexpr size_t WS_WE = 364 * MiB, WS_AA = 388 * MiB, WS_GG = 412 * MiB;
constexpr size_t WS_LRW = WS_LRW0; constexpr int LRW_L = LRW_L0;
__device__ __forceinline__ f32x4 mfma16k16(f16x4 a, f16x4 b, f32x4 c) { return __builtin_amdgcn_mfma_f32_16x16x16f16(a, b, c, 0, 0, 0); }
template <int CTRL> __device__ __forceinline__ float dpp_mov(float v) { return __builtin_bit_cast(float, __builtin_amdgcn_update_dpp(0, __builtin_bit_cast(int, v), CTRL, 0xF, 0xF, true)); }
__device__ __forceinline__ float wave_sum_fast(float v) {
    v += dpp_mov<0xB1>(v); v += dpp_mov<0x4E>(v); v += dpp_mov<0x141>(v); v += dpp_mov<0x140>(v);
    const int iv = __builtin_bit_cast(int, v);
    return (__builtin_bit_cast(float, __builtin_amdgcn_readlane(iv, 0)) + __builtin_bit_cast(float, __builtin_amdgcn_readlane(iv, 16))) +
           (__builtin_bit_cast(float, __builtin_amdgcn_readlane(iv, 32)) + __builtin_bit_cast(float, __builtin_amdgcn_readlane(iv, 48)));
}
__device__ __forceinline__ float hlo(unsigned u) { return (float)__builtin_bit_cast(_Float16, (unsigned short)(u & 0xffffu)); }
__device__ __forceinline__ float hhi(unsigned u) { return (float)__builtin_bit_cast(_Float16, (unsigned short)(u >> 16)); }

template <int MAT> __device__ __forceinline__ void prep_mat(const LAS h16* X, LAS h16* OT, const h16* WT, const float* biasp, h16* outp, int tile, int w, int c, int g) {
        constexpr int K = (MAT == 2) ? 128 : 64, xp = (MAT == 2) ? 136 : 72;


        f32x4 acc[3][4];
#pragma unroll
        for (int nt = 0; nt < 3; ++nt)
#pragma unroll
            for (int mt = 0; mt < 4; ++mt) acc[nt][mt] = (f32x4){0.f, 0.f, 0.f, 0.f};
        f16x8 af[K / 32][3];
#pragma unroll
        for (int ks = 0; ks < K / 32; ++ks)
#pragma unroll
            for (int nt = 0; nt < 3; ++nt) af[ks][nt] = *(const f16x8*)(WT + (size_t)(48 * w + 16 * nt + c) * K + 32 * ks + 8 * g);
#pragma unroll
        for (int ks = 0; ks < K / 32; ++ks) {
            f16x8 bf[4];
#pragma unroll
            for (int mt = 0; mt < 4; ++mt) bf[mt] = *(const LAS f16x8*)(X + (16 * mt + c) * xp + 32 * ks + 8 * g);
#pragma unroll
            for (int nt = 0; nt < 3; ++nt)
#pragma unroll
                for (int mt = 0; mt < 4; ++mt) acc[nt][mt] = mfma16(af[ks][nt], bf[mt], acc[nt][mt]);
        }

#pragma unroll
        for (int nt = 0; nt < 3; ++nt) { const int ch = 48 * w + 16 * nt + 4 * g;
            f32x4 bias = {0.f, 0.f, 0.f, 0.f}; if (MAT == 0) bias = *(const f32x4*)(biasp + ch); else if (MAT == 1) bias = *(const f32x4*)(biasp + ch);
#pragma unroll
            for (int mt = 0; mt < 4; ++mt) { float o[4];
#pragma unroll
                for (int r = 0; r < 4; ++r) { const float x = acc[nt][mt][r] + bias[r];
                    if (MAT == 0) { const float sp = fmaxf(-x, 0.f) + __logf(1.f + __expf(-fabsf(x))); o[r] = __expf(-sp - 0.5f); }
                    else if (MAT == 1) o[r] = __builtin_amdgcn_rcpf(1.f + __expf(-x)); else o[r] = x; }
                u32x2 ov; ov.x = pg8::pk_f16(o[0], o[1]); ov.y = pg8::pk_f16(o[2], o[3]);
                *(LAS u32x2*)(OT + (16 * mt + c) * 56 + 16 * nt + 4 * g) = ov; }
        }
        asm volatile("s_waitcnt lgkmcnt(0)" ::: "memory");
        {
            int lane2_ = threadIdx.x & 63; asm volatile("" : "+v"(lane2_));
#pragma unroll
            for (int k = 0; k < 6; ++k) { const int e = lane2_ + 64 * k, row = e / 6, cc = e % 6;
                *(u32x4*)(outp + ((size_t)tile * 64 + row) * C_RW + 48 * w + 8 * cc) = *(const LAS u32x4*)(OT + row * 56 + 8 * cc); }
        }
        asm volatile("s_waitcnt lgkmcnt(0)" ::: "memory");
}
constexpr size_t WS_RN = 363 * MiB + 128 * 1024;
struct PrepArgs { const h16* P16; const float *mu, *w0, *a0, *kkp; const h16* LRW; h16 *WE, *AA, *GG; float* RN; };
__device__ __forceinline__ void prep_item(const PrepArgs& A, int tile, LAS unsigned char* lds) {
    int tid_ = threadIdx.x; asm volatile("" : "+v"(tid_)); const int tid = tid_, lane = tid & 63, w = tid >> 6, c = lane & 15, g = lane >> 4;
    LAS h16* XW = (LAS h16*)lds;
    LAS h16* XA = XW + 64 * 72;
    LAS h16* XG = XA + 64 * 72;
    {
        const int tk = tid >> 3, part = tid & 7; const size_t tok = (size_t)tile * 64 + tk; const bool hasp = (tok % S) != 0;
        const h16* pc = A.P16 + tok * PITCH; const h16* pp = pc - PITCH;
#pragma unroll
        for (int q = 0; q < 4; ++q) {
            const int col = (q == 0) ? PC_XW + 8 * part : (q == 1) ? PC_XA + 8 * part : PC_XG + 64 * (q - 2) + 8 * part;
            const int mcol = (q == 0) ? 1152 + 8 * part : (q == 1) ? 1216 + 8 * part : 1280 + 64 * (q - 2) + 8 * part;
            const u32x4 xc = *(const u32x4*)(pc + col); u32x4 xp = {0u, 0u, 0u, 0u}; if (hasp) xp = *(const u32x4*)(pp + col);
            const float cv[8] = {hlo(xc.x), hhi(xc.x), hlo(xc.y), hhi(xc.y), hlo(xc.z), hhi(xc.z), hlo(xc.w), hhi(xc.w)};
            const float pv[8] = {hlo(xp.x), hhi(xp.x), hlo(xp.y), hhi(xp.y), hlo(xp.z), hhi(xp.z), hlo(xp.w), hhi(xp.w)};
            float o[8];
#pragma unroll
            for (int e = 0; e < 8; ++e) { const float x = cv[e] + A.mu[mcol + e] * (pv[e] - cv[e]);
                o[e] = (q == 0) ? (1.f - 2.f * __builtin_amdgcn_rcpf(1.f + __expf(2.f * x))) : (q == 1) ? x : __builtin_amdgcn_rcpf(1.f + __expf(-x)); }
            u32x4 ov; ov.x = pg8::pk_f16(o[0], o[1]); ov.y = pg8::pk_f16(o[2], o[3]); ov.z = pg8::pk_f16(o[4], o[5]); ov.w = pg8::pk_f16(o[6], o[7]);
            if (q == 0) *(LAS u32x4*)(XW + tk * 72 + 8 * part) = ov; else if (q == 1) *(LAS u32x4*)(XA + tk * 72 + 8 * part) = ov; else *(LAS u32x4*)(XG + tk * 136 + 64 * (q - 2) + 8 * part) = ov;
        }
#pragma unroll
        for (int hd = 0; hd < H_RW; ++hd) {
            const int col = hd * 64 + 8 * part;
            const u32x4 xc = *(const u32x4*)(pc + PC_K + col); u32x4 xp = {0u, 0u, 0u, 0u}; if (hasp) xp = *(const u32x4*)(pp + PC_K + col);
            const float cv[8] = {hlo(xc.x), hhi(xc.x), hlo(xc.y), hhi(xc.y), hlo(xc.z), hhi(xc.z), hlo(xc.w), hhi(xc.w)};
            const float pv[8] = {hlo(xp.x), hhi(xp.x), hlo(xp.y), hhi(xp.y), hlo(xp.z), hhi(xp.z), hlo(xp.w), hhi(xp.w)};
            float ss = 0.f;
#pragma unroll
            for (int e = 0; e < 8; ++e) { const float kq = (cv[e] + A.mu[384 + col + e] * (pv[e] - cv[e])) * A.kkp[col + e]; ss += kq * kq; }
            ss += __shfl_xor(ss, 1); ss += __shfl_xor(ss, 2); ss += __shfl_xor(ss, 4);
            if (part == 0) A.RN[tok * 6 + hd] = rsqrtf(fmaxf(ss, 1e-24f));
        }
    }
    __syncthreads();
    LAS h16* OT = XG + 64 * 136 + w * 64 * 56;
    prep_mat<0>(XW, OT, A.LRW, A.w0, A.WE, tile, w, c, g);
    prep_mat<1>(XA, OT, A.LRW + 384 * 64, A.a0, A.AA, tile, w, c, g);
    prep_mat<2>(XG, OT, A.LRW + 2 * 384 * 64, nullptr, A.GG, tile, w, c, g);
    __syncthreads();
}

struct ScanArgs { const h16* P16; const h16 *WE, *AA; const float* RN; const float *mu, *kk, *ka; h16* O16; };
constexpr int NS = 8, AP = 72, TP2 = 20;
constexpr int S_AT = 0, S_RT = 2304, S_BN = 4608, S_KN = 6912, S_BT = 9216, S_KT = 11776, S_VT = 14336, S_T = 16896, S_MAK = 17536, S_MRB = 18176, S_MRK = 18816, S_GL = 19456, S_N = S_BN  , SLOT = 19712;
constexpr int NCH = S / 16;
static_assert(NS * SLOT <= LDS_BYTES - 16, "scan slots fit the LDS allocation");
struct RawRegs { unsigned short r[16], k[16], v[16], e[16], a[16]; unsigned short pr, pk, pv; float rn; };
__device__ __forceinline__ void scan_load(const ScanArgs& A, int b, int h, int ck, int lane, RawRegs& R) {
    const int ch = h * 64 + lane; const size_t tok0 = (size_t)b * S + 16 * ck;
    const unsigned short* p0 = (const unsigned short*)A.P16 + tok0 * PITCH + ch;
    const unsigned short* we = (const unsigned short*)A.WE + tok0 * C_RW + ch; const unsigned short* aa = (const unsigned short*)A.AA + tok0 * C_RW + ch;
    R.pr = 0; R.pk = 0; R.pv = 0;
    if (ck > 0) { R.pr = p0[PC_R - PITCH]; R.pk = p0[PC_K - PITCH]; R.pv = p0[PC_V - PITCH]; }
#pragma unroll
    for (int t = 0; t < 16; ++t) { R.r[t] = p0[(size_t)t * PITCH + PC_R]; R.k[t] = p0[(size_t)t * PITCH + PC_K]; R.v[t] = p0[(size_t)t * PITCH + PC_V]; R.e[t] = we[t * C_RW]; R.a[t] = aa[t * C_RW]; }
    R.rn = A.RN[(tok0 + (lane & 15)) * 6 + h];
}
__device__ __forceinline__ float us2f(unsigned short u) { return (float)__builtin_bit_cast(_Float16, u); }
__device__ __forceinline__ void scan_item(const ScanArgs& A, int bh, LAS unsigned char* lds) {
    int tid_ = threadIdx.x; asm volatile("" : "+v"(tid_)); const int tid = tid_, lane = tid & 63, w = __builtin_amdgcn_readfirstlane(tid >> 6), c = lane & 15, g = lane >> 4;
    const int b = bh / H_RW, h = bh % H_RW, ch = h * 64 + lane;
    LAS unsigned char* sb = lds + w * SLOT;
    LAS h16* AT = (LAS h16*)(sb + S_AT); LAS h16* RT = (LAS h16*)(sb + S_RT); LAS h16* BN = (LAS h16*)(sb + S_BN); LAS h16* KN = (LAS h16*)(sb + S_KN);
    LAS h16* BT = (LAS h16*)(sb + S_BT); LAS h16* KT = (LAS h16*)(sb + S_KT); LAS h16* VT = (LAS h16*)(sb + S_VT);
    LAS h16* TM = (LAS h16*)(sb + S_T); LAS h16* MAK = (LAS h16*)(sb + S_MAK); LAS h16* MRB = (LAS h16*)(sb + S_MRB); LAS h16* MRK = (LAS h16*)(sb + S_MRK);
    LAS float* GL = (LAS float*)(sb + S_GL); LAS float* N32 = (LAS float*)(sb + S_N);
    const float mu_r = A.mu[ch], mu_k = A.mu[384 + ch], mu_v = A.mu[768 + ch], k_k = A.kk[ch], k_a = A.ka[ch];
    f32x4 X[4];
#pragma unroll
    for (int kt = 0; kt < 4; ++kt) X[kt] = (f32x4){0.f, 0.f, 0.f, 0.f};
    RawRegs R;
    scan_load(A, b, h, w, lane, R);
#pragma unroll 1
    for (int bt = 0; bt < NCH / NS; ++bt) {
        {
            float pr = us2f(R.pr), pk = us2f(R.pk), pv = us2f(R.pv);
            float cl = 0.f, G = 1.f;
            const int rnv = __builtin_bit_cast(int, R.rn);
#pragma unroll
            for (int t = 0; t < 16; ++t) {
                const float cr = us2f(R.r[t]), ckv = us2f(R.k[t]), cv = us2f(R.v[t]), e = us2f(R.e[t]), a = us2f(R.a[t]);
                const float r = cr + mu_r * (pr - cr), k = ckv + mu_k * (pk - ckv), v = cv + mu_v * (pv - cv);
                pr = cr; pk = ckv; pv = cv;
                const float Gm1 = G; cl -= e; G = __expf(cl); const float iG = __builtin_amdgcn_rcpf(G);
                const float rn = __builtin_bit_cast(float, __builtin_amdgcn_readlane(rnv, t));
                const float kkn = k * k_k * rn;
                const float k2 = k * (1.f + (a - 1.f) * k_a), be = kkn * a;
                const h16 at = (h16)(-kkn * Gm1), bt_ = (h16)(be * iG), kt_ = (h16)(k2 * iG), rt = (h16)(r * G);
                AT[t * AP + lane] = at; RT[t * AP + lane] = rt; BN[t * AP + lane] = bt_; KN[t * AP + lane] = kt_;
                BT[lane * TP2 + t] = bt_; KT[lane * TP2 + t] = kt_; VT[lane * TP2 + t] = (h16)v;
            }
            GL[lane] = G;
            if (bt + 1 < NCH / NS) scan_load(A, b, h, NS * (bt + 1) + w, lane, R);
            asm volatile("s_waitcnt lgkmcnt(0)" ::: "memory");
            f32x4 mab = {0.f, 0.f, 0.f, 0.f}, mak = mab, mrb = mab, mrk = mab;
#pragma unroll
            for (int ks = 0; ks < 2; ++ks) {
                const f16x8 fa = *(const LAS f16x8*)(AT + c * AP + 32 * ks + 8 * g), fr = *(const LAS f16x8*)(RT + c * AP + 32 * ks + 8 * g);
                const f16x8 fb = *(const LAS f16x8*)(BN + c * AP + 32 * ks + 8 * g), fk = *(const LAS f16x8*)(KN + c * AP + 32 * ks + 8 * g);
                mab = mfma16(fa, fb, mab); mak = mfma16(fa, fk, mak); mrb = mfma16(fr, fb, mrb); mrk = mfma16(fr, fk, mrk);
            }
            asm volatile("s_waitcnt lgkmcnt(0)" ::: "memory");
#pragma unroll
            for (int r = 0; r < 4; ++r) { const int t = 4 * g + r;
                N32[t * 16 + c] = (c < t) ? mab[r] : 0.f;
                MAK[t * TP2 + c] = (h16)((c < t) ? mak[r] : 0.f); MRB[t * TP2 + c] = (h16)((c <= t) ? mrb[r] : 0.f); MRK[t * TP2 + c] = (h16)((c <= t) ? mrk[r] : 0.f); }
            asm volatile("s_waitcnt lgkmcnt(0)" ::: "memory");
            {
                float Tc[16];
#pragma unroll
                for (int t = 0; t < 16; ++t) {
                    float acc = (t == c) ? 1.f : 0.f;
#pragma unroll
                    for (int s4 = 0; s4 < (t + 3) / 4; ++s4) { const f32x4 nr = *(const LAS f32x4*)(N32 + t * 16 + 4 * s4);
#pragma unroll
                        for (int e = 0; e < 4; ++e) if (4 * s4 + e < t) acc += nr[e] * Tc[4 * s4 + e]; }
                    Tc[t] = acc;
                }
                if (g == 0) {
#pragma unroll
                    for (int t = 0; t < 16; ++t) TM[t * TP2 + c] = (h16)Tc[t];
                }
            }
        }
        asm volatile("s_waitcnt lgkmcnt(0)" ::: "memory"); __builtin_amdgcn_s_barrier(); asm volatile("" ::: "memory");
        if (w < 4) {
#pragma unroll 1
            for (int sl = 0; sl < NS; ++sl) {
                const int ck = NS * bt + sl;
                const LAS unsigned char* cb = lds + sl * SLOT;
                const LAS h16* cAT = (const LAS h16*)(cb + S_AT); const LAS h16* cRT = (const LAS h16*)(cb + S_RT);
                const LAS h16* cBT = (const LAS h16*)(cb + S_BT); const LAS h16* cKT = (const LAS h16*)(cb + S_KT); const LAS h16* cVT = (const LAS h16*)(cb + S_VT);
                const LAS h16* cTM = (const LAS h16*)(cb + S_T); const LAS h16* cMAK = (const LAS h16*)(cb + S_MAK); const LAS h16* cMRB = (const LAS h16*)(cb + S_MRB); const LAS h16* cMRK = (const LAS h16*)(cb + S_MRK);
                const LAS float* cGL = (const LAS float*)(cb + S_GL);
                f16x8 xf[2];
#pragma unroll
                for (int ks = 0; ks < 2; ++ks) { const f32x4 x0 = X[2 * ks], x1 = X[2 * ks + 1];
                    xf[ks] = (f16x8){(_Float16)x0[0], (_Float16)x0[1], (_Float16)x0[2], (_Float16)x0[3], (_Float16)x1[0], (_Float16)x1[1], (_Float16)x1[2], (_Float16)x1[3]}; }
                const f16x4 vf = *(const LAS f16x4*)(cVT + (16 * w + c) * TP2 + 4 * g);
                const f16x4 makf = *(const LAS f16x4*)(cMAK + c * TP2 + 4 * g), tf = *(const LAS f16x4*)(cTM + c * TP2 + 4 * g);
                const f16x4 mrbf = *(const LAS f16x4*)(cMRB + c * TP2 + 4 * g), mrkf = *(const LAS f16x4*)(cMRK + c * TP2 + 4 * g);
                f16x8 af[2], rf[2];
#pragma unroll
                for (int ks = 0; ks < 2; ++ks) {
                    const f16x4 a0 = *(const LAS f16x4*)(cAT + c * AP + 32 * ks + 4 * g), a1 = *(const LAS f16x4*)(cAT + c * AP + 32 * ks + 16 + 4 * g);
                    const f16x4 r0 = *(const LAS f16x4*)(cRT + c * AP + 32 * ks + 4 * g), r1 = *(const LAS f16x4*)(cRT + c * AP + 32 * ks + 16 + 4 * g);
                    af[ks] = (f16x8){a0[0], a0[1], a0[2], a0[3], a1[0], a1[1], a1[2], a1[3]}; rf[ks] = (f16x8){r0[0], r0[1], r0[2], r0[3], r1[0], r1[1], r1[2], r1[3]};
                }
                f32x4 gw = {0.f, 0.f, 0.f, 0.f};
                gw = mfma16k16(makf, vf, gw); gw = mfma16(af[0], xf[0], gw); gw = mfma16(af[1], xf[1], gw);
                const f16x4 gwf = (f16x4){(_Float16)gw[0], (_Float16)gw[1], (_Float16)gw[2], (_Float16)gw[3]};
                f32x4 u = {0.f, 0.f, 0.f, 0.f}; u = mfma16k16(tf, gwf, u);
                const f16x4 uf = (f16x4){(_Float16)u[0], (_Float16)u[1], (_Float16)u[2], (_Float16)u[3]};
                f32x4 yy = {0.f, 0.f, 0.f, 0.f};
                yy = mfma16k16(mrkf, vf, yy); yy = mfma16k16(mrbf, uf, yy); yy = mfma16(rf[0], xf[0], yy); yy = mfma16(rf[1], xf[1], yy);
#pragma unroll
                for (int kt = 0; kt < 4; ++kt) {
                    const f16x4 btf = *(const LAS f16x4*)(cBT + (16 * kt + c) * TP2 + 4 * g), ktf = *(const LAS f16x4*)(cKT + (16 * kt + c) * TP2 + 4 * g);
                    const f32x4 gl = *(const LAS f32x4*)(cGL + 16 * kt + 4 * g);
                    f32x4 x = X[kt]; x = mfma16k16(btf, uf, x); x = mfma16k16(ktf, vf, x); X[kt] = x * gl;
                }
                h16* op = A.O16 + ((size_t)b * S + 16 * ck + 4 * g) * D + C_ATT + h * 64 + 16 * w + c;
#pragma unroll
                for (int r = 0; r < 4; ++r) op[(size_t)r * D] = (h16)yy[r];
            }
        }
        asm volatile("s_waitcnt lgkmcnt(0)" ::: "memory"); __builtin_amdgcn_s_barrier(); asm volatile("" ::: "memory");
    }
    asm volatile("s_waitcnt vmcnt(0)" ::: "memory");
    __syncthreads();
}

struct PostArgs { const h16* P16; const h16 *AA, *GG; const float *mu, *ka, *rk, *lnw, *lnb; h16* O16; };
struct PostRaw4 { u32x2 cr, ck, cv, qr, qk, qv, av, gv, yv; };
__device__ __forceinline__ float row_sum16(float v) { v += dpp_mov<0xB1>(v); v += dpp_mov<0x4E>(v); v += dpp_mov<0x141>(v); v += dpp_mov<0x140>(v); return v; }
__device__ __forceinline__ void post_head_load(PostRaw4& R, const PostArgs& A, size_t tok, int col) {
    const h16* pc = A.P16 + tok * PITCH + col; const bool hasp = (tok % S) != 0;
    R.cr = *(const u32x2*)(pc + PC_R); R.ck = *(const u32x2*)(pc + PC_K); R.cv = *(const u32x2*)(pc + PC_V);
    R.qr = (u32x2){0u, 0u}; R.qk = (u32x2){0u, 0u}; R.qv = (u32x2){0u, 0u};
    if (hasp) { R.qr = *(const u32x2*)(pc + PC_R - PITCH); R.qk = *(const u32x2*)(pc + PC_K - PITCH); R.qv = *(const u32x2*)(pc + PC_V - PITCH); }
    R.av = *(const u32x2*)(A.AA + tok * C_RW + col); R.gv = *(const u32x2*)(A.GG + tok * C_RW + col); R.yv = *(const u32x2*)(A.O16 + tok * D + C_ATT + col);
}
__device__ __forceinline__ void h4(const u32x2 w, float (&o)[4]) { o[0] = hlo(w.x); o[1] = hhi(w.x); o[2] = hlo(w.y); o[3] = hhi(w.y); }
__device__ __forceinline__ void post_part(const PostArgs& A, int b, int h, int part) {
    int tid_ = threadIdx.x; asm volatile("" : "+v"(tid_)); const int lane = tid_ & 63, w = tid_ >> 6, col = h * 64 + 4 * (lane & 15);
    float mur[4], muk[4], muv[4], kaw[4], rkw[4], lw[4], lb[4];
#pragma unroll
    for (int e = 0; e < 4; ++e) { mur[e] = A.mu[col + e]; muk[e] = A.mu[384 + col + e]; muv[e] = A.mu[768 + col + e]; kaw[e] = A.ka[col + e]; rkw[e] = A.rk[col + e]; lw[e] = A.lnw[col + e]; lb[e] = A.lnb[col + e]; }
    const size_t tok0 = (size_t)b * S + 512 * part + 64 * w + (lane >> 4);
    PostRaw4 R0, R1;
    post_head_load(R0, A, tok0, col);
#define RWK_POST4(R, TOK) do { \
        float fr[4], fk[4], fv[4], qr[4], qk[4], qv[4], av[4], gv[4], y[4]; \
        h4(R.cr, fr); h4(R.ck, fk); h4(R.cv, fv); h4(R.qr, qr); h4(R.qk, qk); h4(R.qv, qv); h4(R.av, av); h4(R.gv, gv); h4(R.yv, y); \
        float sb = 0.f, vv[4]; \
        _Pragma("unroll") for (int e = 0; e < 4; ++e) { const float r = fr[e] + mur[e] * (qr[e] - fr[e]), k = fk[e] + muk[e] * (qk[e] - fk[e]); vv[e] = fv[e] + muv[e] * (qv[e] - fv[e]); \
            sb += r * (k * (1.f + (av[e] - 1.f) * kaw[e])) * rkw[e]; } \
        const float mean = row_sum16((y[0] + y[1]) + (y[2] + y[3])) * (1.f / 64.f); \
        float dv[4], sv = 0.f; \
        _Pragma("unroll") for (int e = 0; e < 4; ++e) { dv[e] = y[e] - mean; sv += dv[e] * dv[e]; } \
        const float rs = rsqrtf(row_sum16(sv) * (1.f / 64.f) + 64e-5f); \
        const float bon = row_sum16(sb); \
        float o[4]; \
        _Pragma("unroll") for (int e = 0; e < 4; ++e) o[e] = (dv[e] * rs * lw[e] + lb[e] + bon * vv[e]) * gv[e]; \
        u32x2 ov; ov.x = pg8::pk_f16(o[0], o[1]); ov.y = pg8::pk_f16(o[2], o[3]); \
        *(u32x2*)(A.O16 + (TOK) * D + C_ATT + col) = ov; } while (0)
#pragma unroll 1
    for (int t0 = 0; t0 < 64; t0 += 8) {
        post_head_load(R1, A, tok0 + t0 + 4, col);
        RWK_POST4(R0, tok0 + t0);
        if (t0 + 8 < 64) post_head_load(R0, A, tok0 + t0 + 8, col);
        RWK_POST4(R1, tok0 + t0 + 4);
    }
#undef RWK_POST4
}
}
__device__ __forceinline__ void skinny_item(const h16* H, const h16* Wsm, h16* P16o, int tile, LAS unsigned char* lds) {
    int tid_ = threadIdx.x; asm volatile("" : "+v"(tid_)); const int tid = tid_, lane = tid & 63, w = tid >> 6, c = lane & 15, g = lane >> 4;
    LAS float* PART = (LAS float*)lds;
    nsa::f16x8 af[4][4], bf[4][2];
#pragma unroll
    for (int ks = 0; ks < 4; ++ks) { const int k0 = 128 * w + 32 * ks + 8 * g;
#pragma unroll
        for (int mt = 0; mt < 4; ++mt) af[ks][mt] = *(const nsa::f16x8*)(H + ((size_t)tile * 64 + 16 * mt + c) * D + k0);
#pragma unroll
        for (int nt = 0; nt < 2; ++nt) bf[ks][nt] = *(const nsa::f16x8*)(Wsm + (size_t)(16 * nt + c) * D + k0); }
    nsa::f32x4 acc[4][2];
#pragma unroll
    for (int mt = 0; mt < 4; ++mt)
#pragma unroll
        for (int nt = 0; nt < 2; ++nt) acc[mt][nt] = (nsa::f32x4){0.f, 0.f, 0.f, 0.f};
#pragma unroll
    for (int ks = 0; ks < 4; ++ks)
#pragma unroll
        for (int mt = 0; mt < 4; ++mt)
#pragma unroll
            for (int nt = 0; nt < 2; ++nt) acc[mt][nt] = nsa::mfma16(bf[ks][nt], af[ks][mt], acc[mt][nt]);
#pragma unroll
    for (int mt = 0; mt < 4; ++mt)
#pragma unroll
        for (int nt = 0; nt < 2; ++nt) *(LAS nsa::f32x4*)(PART + (w * 64 + 16 * mt + c) * 32 + 16 * nt + 4 * g) = acc[mt][nt];
    __syncthreads();
    {   const int tk = tid >> 3, c4 = (tid & 7) * 4;
        nsa::f32x4 s = {0.f, 0.f, 0.f, 0.f};
#pragma unroll
        for (int ww = 0; ww < 8; ++ww) s = s + *(const LAS nsa::f32x4*)(PART + (ww * 64 + tk) * 32 + c4);
        if (c4 < 24) { pg8::u32x2 o; o.x = pg8::pk_f16(s[0], s[1]); o.y = pg8::pk_f16(s[2], s[3]); *(pg8::u32x2*)(P16o + ((size_t)tile * 64 + tk) * PITCH + PC_GTS + c4) = o; }
    }
    __syncthreads();
}
#define XB_TMO      128
#define XB_XCNT(j)  (256  + 64 * (j))
#define XB_XSUB(j)  (1280 + 64 * (j))
#define XB_XGEN(j)  (2304 + 64 * (j))
#define XB_TOP      3328
#define XB_TOPGEN   3392
#define XCD_BAR_WORDS 3456
#define XB_SPIN_CAP (1u << 18)

__device__ __forceinline__ unsigned xb_ld(unsigned* p)              { return __hip_atomic_load(p, __ATOMIC_RELAXED, __HIP_MEMORY_SCOPE_AGENT); }
__device__ __forceinline__ unsigned xb_add(unsigned* p, unsigned v) { return __hip_atomic_fetch_add(p, v, __ATOMIC_RELAXED, __HIP_MEMORY_SCOPE_AGENT); }
__device__ __forceinline__ unsigned xb_xcc_id() { return (unsigned)__builtin_amdgcn_s_getreg((3 << 11) | 20) & 0xFu; }
#define XB_SPIN(cond, bar) do { unsigned _sp = 0; while (cond) { __builtin_amdgcn_s_sleep(1); \
    if ((++_sp & 255u) == 0u) { if (xb_ld(&(bar)[XB_TMO])) break; if (_sp > XB_SPIN_CAP) { atomicAdd(&(bar)[XB_TMO], 1u); break; } } } } while (0)

struct XcdBarrier {
    unsigned* bar; unsigned x;
    volatile LAS unsigned* st;
};

__device__ __forceinline__ XcdBarrier xcd_barrier_post(unsigned* bar, volatile LAS unsigned* st) {
    XcdBarrier b; b.bar = bar; b.x = xb_xcc_id(); b.st = st;
    if (threadIdx.x == 0) (void)xb_add(&bar[XB_XCNT(b.x)], 1u);
    return b;
}
__device__ __forceinline__ void xcd_barrier_complete(unsigned* bar, unsigned x, unsigned& nloc, unsigned& nx) {
    const unsigned G = gridDim.x * gridDim.y * gridDim.z;
    unsigned sum, cnt, mine, sp = 0u;
    for (;;) {
        sum = 0u; cnt = 0u; mine = 0u;
#pragma unroll
        for (unsigned j = 0; j < 16; ++j) { const unsigned c = xb_ld(&bar[XB_XCNT(j)]); sum += c; cnt += (c > 0u) ? 1u : 0u; mine = (j == x) ? c : mine; }
        if (sum == G) break;
        __builtin_amdgcn_s_sleep(1);
        if ((++sp & 255u) == 0u) { if (xb_ld(&bar[XB_TMO])) break; if (sp > XB_SPIN_CAP) { atomicAdd(&bar[XB_TMO], 1u); break; } }
    }
    nloc = mine > 0u ? mine : 1u; nx = cnt > 0u ? cnt : 1u;
}

__device__ __forceinline__ void xcd_barrier(const XcdBarrier& b) {
    asm volatile("s_waitcnt vmcnt(0)" ::: "memory");
    __syncthreads();
    if (threadIdx.x == 0) {
        unsigned* bar = b.bar;
        __builtin_amdgcn_s_waitcnt(0);
        unsigned nloc = b.st[0], nx = b.st[1];
        if (nloc == 0u) { xcd_barrier_complete(bar, b.x, nloc, nx); b.st[0] = nloc; b.st[1] = nx; }
        const unsigned old = xb_add(&bar[XB_XSUB(b.x)], 1u);
        const unsigned gen = old / nloc;
        if (old + 1u == (gen + 1u) * nloc) {
            __builtin_amdgcn_fence(__ATOMIC_RELEASE, "agent");
            asm volatile("s_waitcnt vmcnt(0)" ::: "memory");
            const unsigned og = xb_add(&bar[XB_TOP], 1u);
            const unsigned tg = og / nx;
            if (og + 1u == (tg + 1u) * nx) xb_add(&bar[XB_TOPGEN], 1u);
            else XB_SPIN(xb_ld(&bar[XB_TOPGEN]) == tg, bar);
            __builtin_amdgcn_fence(__ATOMIC_ACQUIRE, "agent");
            xb_add(&bar[XB_XGEN(b.x)], 1u);
            asm volatile("s_waitcnt vmcnt(0)" ::: "memory");
        } else {
            XB_SPIN(xb_ld(&bar[XB_XGEN(b.x)]) == gen, bar);
            __builtin_amdgcn_fence(__ATOMIC_ACQUIRE, "agent");
            asm volatile("s_waitcnt vmcnt(0)" ::: "memory");
        }
    }
    __syncthreads();
}
constexpr int N_PHASES = 20;
__global__ void __launch_bounds__(512, 2) mk_fwd(Args a) {
    extern __shared__ __attribute__((aligned(16))) unsigned char lds_raw[];
    LAS unsigned char* lds = (LAS unsigned char*)lds_raw;
    cg::grid_group grid = cg::this_grid();
    if (threadIdx.x < 4) ((LAS unsigned*)(lds + L_BARST))[threadIdx.x] = 0u;
    __syncthreads();
    const XcdBarrier xbar = xcd_barrier_post((unsigned*)(a.ws + WS_BAR), (volatile LAS unsigned*)(lds + L_BARST));
    unsigned char* ws = a.ws;
    float* MOD = (float*)(ws + WS_MOD); h16* QK32 = (h16*)(ws + WS_QK32); h16* P16 = (h16*)(ws + WS_P16); h16* H16 = (h16*)(ws + WS_H16);
    h16* Y16 = (h16*)(ws + WS_Y32); h16* ACT = (h16*)(ws + WS_ACT); float* X = a.out;
    h16* XB16 = (h16*)(ws + WS_XB16);
    const int lo = a.ph_lo, hi = a.ph_hi;
#define IN(k) (lo <= (k) && (k) < hi)
    if (lo > 1000) grid.sync();
#define SEAM(k) do { if (IN(k) && IN((k) + 1)) { \
        xcd_barrier(xbar); \
    } } while (0)
    if (IN(0)) { phase_prologue(a, lds); } SEAM(0);
    if (IN(1)) { phase_post<false, false, false, true, 2>(a.in[0], nullptr, nullptr, MOD, 0, nullptr, a.in[4], MOD, 0, D, H16); prologue_weights(a, lds, 1); } SEAM(1);
#define LAYER(l) do { \
    const float* modl = MOD + (size_t)(l) * NB * 6 * D; constexpr int pb = 2 + 9 * (l); \
    mls::Args ma{P16, a.in[29] + (l) * 4 * 768, a.in[30] + (l) * 768, a.in[31] + (l) * H_ML, a.in[32] + (l) * H_ML, a.in[33] + (l) * C_ML, (float*)(ws + mls::WS_KVB), (float*)(ws + mls::WS_KSUM), (float*)(ws + mls::WS_MUB), H16, (float*)(ws + mls::WS_GT), (const h16*)(ws + WS_CW16) + (size_t)(l) * 5 * 768}; \
    if (IN(pb + 0)) { for (int it = blockIdx.x; it < 512; it += gridDim.x) skinny_item(H16, (const h16*)(ws + WS_WSM) + (size_t)(l) * 32 * D, P16, it, lds); \
        pg8::Gemm g{H16, (const h16*)(ws + WS_WIN) + (size_t)(l) * NIN_PAD * D, M, NIN_PAD, D}; pg8::StaticOrder So; So.init(M, NIN_PAD, gridDim.x, blockIdx.x); \
        pg8::EpiProj E{QK32, P16, (h16*)(ws + WS_VTG)}; pg8::gemm_phase<pg8::EpiProj, pg8::StaticOrder, true, true>(lds, g, So, E); } SEAM(pb + 0); \
    if (IN(pb + 1)) { nsa::CmpArgs ca{QK32, P16, (const h16*)(ws + WS_W1C) + (size_t)(l) * 2 * 64 * 2048, (const float*)(ws + WS_CBIAS) + (l) * 128, a.in[13] + (l) * 4096, a.in[15] + (l) * 4096, (h16*)(ws + WS_KC16), (h16*)(ws + WS_VC16)}; \
        for (int it = blockIdx.x; it < 256; it += gridDim.x) nsa::compress_item(ca, it >> 5, (it >> 4) & 1, it & 15, lds); \
        for (int it = blockIdx.x; it < 3072; it += gridDim.x) mls::m1_item(ma, it >> 6, it & 63, lds); \
        rwk::PrepArgs rp{P16, a.in[18] + (l) * RW_IN, a.in[19] + (l) * C_RW, a.in[21] + (l) * C_RW, a.in[24] + (l) * C_RW, (const h16*)(ws + rwk::WS_LRW) + (size_t)(l) * rwk::LRW_L, (h16*)(ws + rwk::WS_WE), (h16*)(ws + rwk::WS_AA), (h16*)(ws + rwk::WS_GG), (float*)(ws + rwk::WS_RN)}; \
        for (int it = blockIdx.x; it < 512; it += gridDim.x) rwk::prep_item(rp, it, lds); } SEAM(pb + 1); \
    if (IN(pb + 2)) { nsa::AttnArgs aa{QK32, P16, (const h16*)(ws + WS_KC16), (const h16*)(ws + WS_VC16), (const h16*)(ws + WS_VTG), a.in[16] + (l) * 12, a.in[17] + (l) * 256, H16}; \
        rwk::ScanArgs rs{P16, (const h16*)(ws + rwk::WS_WE), (const h16*)(ws + rwk::WS_AA), (const float*)(ws + rwk::WS_RN), a.in[18] + (l) * RW_IN, a.in[24] + (l) * C_RW, a.in[25] + (l) * C_RW, H16}; \
        rwk::PostArgs rq{P16, (const h16*)(ws + rwk::WS_AA), (const h16*)(ws + rwk::WS_GG), a.in[18] + (l) * RW_IN, a.in[25] + (l) * C_RW, a.in[26] + (l) * C_RW, a.in[27] + (l) * C_RW, a.in[28] + (l) * C_RW, H16}; \
        if (blockIdx.x < 48) { rwk::scan_item(rs, blockIdx.x, lds);   \
            if (threadIdx.x == 0) { __builtin_amdgcn_fence(__ATOMIC_RELEASE, "agent"); asm volatile("s_waitcnt vmcnt(0)" ::: "memory"); \
                __hip_atomic_fetch_add((unsigned*)(ws + WS_QCTR) + 64 * (48 + (l) * 8 + (int)blockIdx.x / H_RW), 1u, __ATOMIC_RELAXED, __HIP_MEMORY_SCOPE_AGENT); } } \
        {     \
            volatile LAS unsigned* qs = (volatile LAS unsigned*)(lds + L_QSLOT); \
            for (int kq = 0; kq < 8; ++kq) {   \
            const int xq = (int)((xbar.x + (unsigned)kq) & 7u); unsigned* qh = (unsigned*)(ws + WS_QCTR) + 64 * ((l) * 8 + xq); unsigned* m2d = (unsigned*)(ws + WS_QCTR) + 64 * (32 + (l) * 8 + xq); unsigned* scd = (unsigned*)(ws + WS_QCTR) + 64 * (48 + (l) * 8 + xq); int it; \
            for (;;) { __syncthreads(); if (threadIdx.x == 0) *qs = atomicAdd(qh, 1u); __syncthreads(); it = (int)*qs; if (it >= 24 + 64) break; \
                if (it < 24) { mls::m2_item(ma, xq * 6 + (it >> 2), it & 3); asm volatile("s_waitcnt vmcnt(0)" ::: "memory"); __syncthreads(); \
                               if (threadIdx.x == 0) { __builtin_amdgcn_fence(__ATOMIC_RELEASE, "agent"); asm volatile("s_waitcnt vmcnt(0)" ::: "memory"); __hip_atomic_fetch_add(m2d, 1u, __ATOMIC_RELAXED, __HIP_MEMORY_SCOPE_AGENT); } } \
                else nsa::attn_item(aa, xq, 63 - (it - 24), lds); } \
            if (it < 24 + 64 + 384) {   \
                if (threadIdx.x == 0) { while (__hip_atomic_load(m2d, __ATOMIC_RELAXED, __HIP_MEMORY_SCOPE_AGENT) < 24u) __builtin_amdgcn_s_sleep(8); } \
                __syncthreads(); __builtin_amdgcn_fence(__ATOMIC_ACQUIRE, "agent"); asm volatile("s_waitcnt vmcnt(0)" ::: "memory"); \
                mls::M3Regs mr; mls::m3_load(mr, ma, xq * 384 + (it - 88), threadIdx.x); \
                while (it < 24 + 64 + 384) { __syncthreads(); if (threadIdx.x == 0) *qs = atomicAdd(qh, 1u); __syncthreads(); const int nx = (int)*qs; \
                    mls::m3_item(ma, xq * 384 + (it - 88), nx < 24 + 64 + 384 ? xq * 384 + (nx - 88) : -1, mr, lds); it = nx; } } \
            if (it < 472 + 48) {   \
                if (threadIdx.x == 0) { while (__hip_atomic_load(scd, __ATOMIC_RELAXED, __HIP_MEMORY_SCOPE_AGENT) < 6u) __builtin_amdgcn_s_sleep(8); } \
                __syncthreads(); __builtin_amdgcn_fence(__ATOMIC_ACQUIRE, "agent"); asm volatile("s_waitcnt vmcnt(0)" ::: "memory"); \
                while (it < 472 + 48) { rwk::post_part(rq, xq, (it - 472) >> 3, (it - 472) & 7); \
                    __syncthreads(); if (threadIdx.x == 0) *qs = atomicAdd(qh, 1u); __syncthreads(); it = (int)*qs; } } } } } SEAM(pb + 2); \
    if (IN(pb + 4)) { pg8::Gemm g{H16, (const h16*)(ws + WS_WOUT) + (size_t)(l) * D * D, M, D, D}; pg8::StaticOrder So; So.init(M, D, gridDim.x, blockIdx.x); \
        pg8::EpiF16 E{Y16, D}; pg8::gemm_phase<pg8::EpiF16, pg8::StaticOrder, true, true>(lds, g, So, E); } SEAM(pb + 4); \
    if (IN(pb + 5)) { phase_post<(l) != 0, true, true, true, 2>((l) == 0 ? (const void*)a.in[0] : (const void*)X, Y16, a.in[5] + (l) * D, modl, 2 * D, XB16, a.in[6] + (l) * D, modl, 3 * D, 4 * D, H16); } SEAM(pb + 5); \
    if (IN(pb + 6)) { pg8::Gemm g{H16, (const h16*)(ws + WS_W1) + (size_t)(l) * NFF2 * D, M, NFF2, D}; pg8::StaticOrder So; So.init(M, NFF2, gridDim.x, blockIdx.x); \
        pg8::EpiSwiglu E{ACT, DFF}; pg8::gemm_phase<pg8::EpiSwiglu, pg8::StaticOrder, true, true>(lds, g, So, E); } SEAM(pb + 6); \
    if (IN(pb + 7)) { pg8::Gemm g{ACT, (const h16*)(ws + WS_W2) + (size_t)(l) * D * DFF, M, D, DFF}; pg8::StaticOrder So; So.init(M, D, gridDim.x, blockIdx.x); \
        pg8::EpiF16 E{Y16, D}; pg8::gemm_phase<pg8::EpiF16, pg8::StaticOrder, true, true>(lds, g, So, E); } SEAM(pb + 7); \
    if (IN(pb + 8)) { constexpr bool last = ((l) == DEPTH - 1); \
        phase_post<true, !last, true, !last, 2>(XB16, Y16, a.in[7] + (l) * D, modl, 5 * D, X, last ? nullptr : a.in[4] + ((l) + 1) * D, MOD + (size_t)(last ? (l) : (l) + 1) * NB * 6 * D, 0, D, H16); } \
    if (!((l) == DEPTH - 1)) SEAM(pb + 8); \
    } while (0)
    LAYER(0);
    LAYER(1);
#undef LAYER
#undef SEAM
#undef IN
}

static int g_grid = 0;
static void launch_mk(const Args& a0, int lo, int hi, hipStream_t stream) {
    Args a = a0; a.ph_lo = lo; a.ph_hi = hi;
    void* args[] = {(void*)&a};
    hipError_t e = hipLaunchCooperativeKernel((const void*)mk_fwd, dim3(g_grid), dim3(512), args, LDS_BYTES, stream);
    if (e != hipSuccess) fprintf(stderr, "cooperative launch failed: %s (grid %d)\n", hipGetErrorString(e), g_grid);
}
extern "C" void kernel_launch(void* const* d_in, const int* in_sizes, int n_in, void* d_out, int out_size, void* d_ws, size_t ws_size, hipStream_t stream) {
    if (n_in != 37 || ws_size < WS_END2) { fprintf(stderr, "kernel_launch: unexpected n_in %d / ws %zu\n", n_in, ws_size); return; }
    if (!g_grid) {
        int dev = 0, cus = 0, per_cu = 0;
        hipGetDevice(&dev); hipDeviceGetAttribute(&cus, hipDeviceAttributeMultiprocessorCount, dev);
        hipFuncSetAttribute((const void*)mk_fwd, hipFuncAttributeMaxDynamicSharedMemorySize, LDS_BYTES);
        hipOccupancyMaxActiveBlocksPerMultiprocessor(&per_cu, (const void*)mk_fwd, 512, LDS_BYTES);
        if (per_cu < 1) { fprintf(stderr, "kernel_launch: occupancy query says %d blocks/CU\n", per_cu); per_cu = 1; }
        g_grid = cus * (per_cu > 1 ? 1 : per_cu);
    }
    const float* const* in = (const float* const*)d_in;
    Args a{};
    for (int i = 0; i < 37; ++i) a.in[i] = in[i];
    a.out = (float*)d_out; a.ws = (unsigned char*)d_ws;
    hipMemsetAsync((char*)d_ws + WS_BAR, 0, 32768, stream);
    launch_mk(a, 0, N_PHASES, stream);
}
```
